# Optimizing an MI355X kernel written in HIP

```python
import math
import jax, jax.numpy as jnp
from jax import lax
import numpy as np

D_MODEL = 1024
BATCH = 4
SEQ = 4096
DEPTH = 2

EPS = 1e-6
NEG = -1e30
Q_BLOCK = 128

M_HEADS = 4
M_DQK = 64
M_DV = 128
M_CHUNK = 64
M_CONV = 4
FORGET_BIAS = 3.0

N_HEADS = 8
N_GROUPS = 2
N_DH = 64
CMP_LEN = 32
CMP_STRIDE = 16
CMP_HID = 128
SLC_LEN = 64
SLC_TOPK = 16
WIN = 512
FORCE_BONUS = 1e4

L_HEADS = 8
Q_RANK = 384
KV_RANK = 256
D_NOPE = 64
D_ROPE = 32
D_V = 64
ROPE_BASE = 10000.0

BRANCH_W = 512
D_FF = -(-8 * D_MODEL // (3 * 256)) * 256

IN_SIZES = (2 * M_HEADS * M_DQK, M_HEADS * M_DV, M_HEADS * M_DV, 2 * M_HEADS,
            N_HEADS * N_DH, 6 * N_GROUPS * N_DH, 3 * N_HEADS,
            Q_RANK, KV_RANK + D_ROPE, 3 * D_MODEL)
D_IN = int(sum(IN_SIZES))
IN_SPLITS = tuple(int(s) for s in np.cumsum(IN_SIZES)[:-1])

kernel_name = "hybrid_mlstm_nsa_mla_gated_block"


def rmsnorm(x, g):
    xf = x.astype(jnp.float32)
    y = xf * lax.rsqrt(jnp.mean(xf * xf, axis=-1, keepdims=True) + EPS)
    return (y * g.astype(jnp.float32)).astype(x.dtype)


def masked_softmax(s, mask):
    s = jnp.where(mask, s.astype(jnp.float32), NEG)
    return jax.nn.softmax(s, axis=-1)


def causal_dwconv(x, w):
    return lax.conv_general_dilated(x, w[:, None, :].astype(x.dtype), window_strides=(1,),
                                    padding=[(w.shape[0] - 1, 0)],
                                    dimension_numbers=('NWC', 'WIO', 'NWC'),
                                    feature_group_count=x.shape[-1])


def rope(x, pos):
    half = x.shape[-1] // 2
    freq = ROPE_BASE ** (-jnp.arange(half, dtype=jnp.float32) / half)
    ang = pos.astype(jnp.float32)[..., None] * freq
    cos = jnp.cos(ang)[:, :, None, :]
    sin = jnp.sin(ang)[:, :, None, :]
    xf = x.astype(jnp.float32)
    x1, x2 = xf[..., :half], xf[..., half:]
    return jnp.concatenate([x1 * cos - x2 * sin, x1 * sin + x2 * cos], axis=-1).astype(x.dtype)


def to_chunks(a):
    B, S, H = a.shape[:3]
    a = a.reshape(B, S // M_CHUNK, M_CHUNK, H, *a.shape[3:])
    return jnp.moveaxis(jnp.moveaxis(a, 1, 0), 3, 2)


def mlstm(q, k, v, i_pre, f_pre):
    B, S, H, _ = q.shape
    f32 = jnp.float32
    qc = to_chunks(q.astype(f32) * (M_DQK ** -0.5))
    kc = to_chunks(k.astype(f32))
    vc = to_chunks(v.astype(f32))
    lic = to_chunks(i_pre.astype(f32))
    lfc = to_chunks(jax.nn.log_sigmoid(f_pre.astype(f32)))
    causal = jnp.tril(jnp.ones((M_CHUNK, M_CHUNK), bool))

    def step(carry, xs):
        C, n, m = carry
        q_, k_, v_, li, lf = xs
        b = jnp.cumsum(lf, axis=-1)
        logD = jnp.where(causal, b[..., :, None] - b[..., None, :] + li[..., None, :], -jnp.inf)
        inter = b + m[..., None]
        m_t = jnp.maximum(inter, jnp.max(logD, axis=-1))
        D = jnp.exp(logD - m_t[..., None])
        a_inter = jnp.exp(inter - m_t)
        s = jnp.einsum('bhtd,bhsd->bhts', q_, k_) * D
        num = a_inter[..., None] * jnp.einsum('bhvd,bhtd->bhtv', C, q_) + jnp.einsum('bhts,bhsv->bhtv', s, v_)
        den = a_inter * jnp.einsum('bhd,bhtd->bht', n, q_) + jnp.sum(s, axis=-1)
        h = num / jnp.maximum(jnp.abs(den), jnp.exp(-m_t))[..., None]
        bL = b[..., -1]
        logw = bL[..., None] - b + li
        m_new = jnp.maximum(bL + m, jnp.max(logw, axis=-1))
        w = jnp.exp(logw - m_new[..., None])
        decay = jnp.exp(bL + m - m_new)
        C_new = decay[..., None, None] * C + jnp.einsum('bhs,bhsv,bhsd->bhvd', w, v_, k_)
        n_new = decay[..., None] * n + jnp.einsum('bhs,bhsd->bhd', w, k_)
        return (C_new, n_new, m_new), h

    init = (jnp.zeros((B, H, M_DV, M_DQK), f32), jnp.zeros((B, H, M_DQK), f32), jnp.zeros((B, H), f32))
    _, hs = lax.scan(step, init, (qc, kc, vc, lic, lfc))
    return hs.transpose(1, 0, 3, 2, 4).reshape(B, S, H, M_DV).astype(q.dtype)


def compress_blocks(x, c_idx, pos, w1, w2):
    B = x.shape[0]
    nb = c_idx.shape[0]
    blk = x[:, c_idx] + pos[None, None, :, None, :]
    blk = jnp.swapaxes(blk, 2, 3).reshape(B, nb, N_GROUPS, CMP_LEN * N_DH)
    return jax.nn.silu(blk @ w1) @ w2


def nsa(q, kv, gate_pre, cmp_pos, cmp_w1, cmp_w2):
    B, S, H, dh = q.shape
    G, R = N_GROUPS, N_HEADS // N_GROUPS
    scale = dh ** -0.5
    qg = q.reshape(B, S, G, R, dh)
    k_cr, v_cr, k_slc, v_slc, k_win, v_win = [kv[:, :, i] for i in range(6)]
    t_all = jnp.arange(S)

    nb = (S - CMP_LEN) // CMP_STRIDE + 1
    c_start = np.arange(nb) * CMP_STRIDE
    c_idx = c_start[:, None] + np.arange(CMP_LEN)[None, :]
    k_cmp = compress_blocks(k_cr, c_idx, cmp_pos[0], cmp_w1[0], cmp_w2[0])
    v_cmp = compress_blocks(v_cr, c_idx, cmp_pos[1], cmp_w1[1], cmp_w2[1])
    c_mask = jnp.asarray(c_start + CMP_LEN - 1)[None, :] <= t_all[:, None]
    sc = jnp.einsum('bsgrd,bngd->bgrsn', qg, k_cmp) * scale
    p_cmp = masked_softmax(sc, c_mask) * (t_all >= CMP_LEN - 1)[:, None].astype(jnp.float32)
    o_cmp = jnp.einsum('bgrsn,bngd->bsgrd', p_cmp.astype(q.dtype), v_cmp)

    ns = S // SLC_LEN
    s_start = np.arange(ns) * SLC_LEN
    overlap = ((c_start[:, None] < s_start[None, :] + SLC_LEN) &
               (c_start[:, None] + CMP_LEN > s_start[None, :])).astype(np.float32)
    imp = jnp.einsum('bgrsn,nj->bgsj', p_cmp, jnp.asarray(overlap))
    cur = t_all // SLC_LEN
    jb = jnp.arange(ns)
    valid = jb[None, :] <= cur[:, None]
    forced = (jb[None, :] == 0) | (jb[None, :] == cur[:, None]) | (jb[None, :] == cur[:, None] - 1)
    score = jnp.where(valid, imp + FORCE_BONUS * forced.astype(jnp.float32), -1.0)
    top_val, sel_idx = lax.top_k(score, min(SLC_TOPK, ns))
    sel_ok = top_val > -0.5
    ks_blocks = k_slc.reshape(B, ns, SLC_LEN, G, dh).transpose(0, 3, 1, 2, 4)
    vs_blocks = v_slc.reshape(B, ns, SLC_LEN, G, dh).transpose(0, 3, 1, 2, 4)
    b_ix = jnp.arange(B)[:, None, None, None]
    g_ix = jnp.arange(G)[None, :, None, None]
    kw_pad = jnp.pad(k_win, ((0, 0), (WIN, 0), (0, 0), (0, 0)))
    vw_pad = jnp.pad(v_win, ((0, 0), (WIN, 0), (0, 0), (0, 0)))

    def block(qb):
        s0 = qb * Q_BLOCK
        qblk = lax.dynamic_slice_in_dim(qg, s0, Q_BLOCK, axis=1)
        t_pos = s0 + jnp.arange(Q_BLOCK)
        idx = lax.dynamic_slice_in_dim(sel_idx, s0, Q_BLOCK, axis=2)
        ok = lax.dynamic_slice_in_dim(sel_ok, s0, Q_BLOCK, axis=2)
        kk = idx.shape[-1]
        ksel = ks_blocks[b_ix, g_ix, idx].reshape(B, G, Q_BLOCK, kk * SLC_LEN, dh)
        vsel = vs_blocks[b_ix, g_ix, idx].reshape(B, G, Q_BLOCK, kk * SLC_LEN, dh)
        tok = idx[..., None] * SLC_LEN + jnp.arange(SLC_LEN)
        m_sel = (ok[..., None] & (tok <= t_pos[None, None, :, None, None])).reshape(B, G, Q_BLOCK, kk * SLC_LEN)
        s_sel = jnp.einsum('btgrd,bgtnd->bgtrn', qblk, ksel) * scale
        p_sel = masked_softmax(s_sel, m_sel[:, :, :, None, :])
        o_sel = jnp.einsum('bgtrn,bgtnd->btgrd', p_sel.astype(q.dtype), vsel)
        kwin = lax.dynamic_slice_in_dim(kw_pad, s0, WIN + Q_BLOCK, axis=1)
        vwin = lax.dynamic_slice_in_dim(vw_pad, s0, WIN + Q_BLOCK, axis=1)
        kpos = s0 - WIN + jnp.arange(WIN + Q_BLOCK)
        wm = (kpos[None, :] <= t_pos[:, None]) & (t_pos[:, None] - kpos[None, :] < WIN) & (kpos[None, :] >= 0)
        s_w = jnp.einsum('btgrd,bngd->bgrtn', qblk, kwin) * scale
        p_w = masked_softmax(s_w, wm)
        o_w = jnp.einsum('bgrtn,bngd->btgrd', p_w.astype(q.dtype), vwin)
        return o_sel, o_w

    o_sel, o_w = lax.map(block, jnp.arange(S // Q_BLOCK))
    o_sel = jnp.swapaxes(o_sel, 0, 1).reshape(B, S, G, R, dh)
    o_w = jnp.swapaxes(o_w, 0, 1).reshape(B, S, G, R, dh)
    g = jax.nn.sigmoid(gate_pre).reshape(B, S, G, R, 3)
    o = g[..., 0:1] * o_cmp + g[..., 1:2] * o_sel + g[..., 2:3] * o_w
    return o.reshape(B, S, H * dh)


def causal_attention(q, k, v, scale):
    B, S, H, _ = q.shape
    kpos = jnp.arange(S)

    def blk(qb):
        s0 = qb * Q_BLOCK
        qblk = lax.dynamic_slice_in_dim(q, s0, Q_BLOCK, axis=1)
        sc = jnp.einsum('bthd,bshd->bhts', qblk, k) * scale
        mask = kpos[None, :] <= (s0 + jnp.arange(Q_BLOCK))[:, None]
        p = masked_softmax(sc, mask)
        return jnp.einsum('bhts,bshd->bthd', p.astype(v.dtype), v)

    o = lax.map(blk, jnp.arange(S // Q_BLOCK))
    return jnp.swapaxes(o, 0, 1).reshape(B, S, H, v.shape[-1])


def mla(c_q, c_kv, positions, q_norm, kv_norm, w_uq, w_ukv):
    B, S, _ = c_q.shape
    c_kv, k_rope = jnp.split(c_kv, [KV_RANK], axis=-1)
    q = (rmsnorm(c_q, q_norm) @ w_uq).reshape(B, S, L_HEADS, D_NOPE + D_ROPE)
    kv = (rmsnorm(c_kv, kv_norm) @ w_ukv).reshape(B, S, L_HEADS, D_NOPE + D_V)
    q_nope, q_rope = jnp.split(q, [D_NOPE], axis=-1)
    k_nope, v = jnp.split(kv, [D_NOPE], axis=-1)
    q = jnp.concatenate([q_nope, rope(q_rope, positions)], axis=-1)
    k_rope = jnp.broadcast_to(rope(k_rope[:, :, None, :], positions), (B, S, L_HEADS, D_ROPE))
    k = jnp.concatenate([k_nope, k_rope], axis=-1)
    o = causal_attention(q, k, v, (D_NOPE + D_ROPE) ** -0.5)
    return o.reshape(B, S, L_HEADS * D_V)


def token_mixing(h, positions, w_in, m_conv, m_gate_bias, m_head_norm, cmp_pos, cmp_w1, cmp_w2,
                 q_norm, kv_norm, w_uq, w_ukv, w_branch, w_out):
    B, S, _ = h.shape
    z = h @ w_in
    a_qk, a_v, a_o, a_if, b_q, b_kv, b_g, c_q, c_kv, gates = jnp.split(z, IN_SPLITS, axis=-1)
    a_qk = jax.nn.silu(causal_dwconv(a_qk, m_conv))
    a_q, a_k = jnp.split(a_qk, 2, axis=-1)
    i_pre, f_pre = jnp.split(a_if + m_gate_bias, 2, axis=-1)
    h_a = mlstm(a_q.reshape(B, S, M_HEADS, M_DQK), a_k.reshape(B, S, M_HEADS, M_DQK),
                a_v.reshape(B, S, M_HEADS, M_DV), i_pre, f_pre)
    y_a = rmsnorm(h_a, m_head_norm).reshape(B, S, BRANCH_W) * jax.nn.sigmoid(a_o)
    y_b = nsa(b_q.reshape(B, S, N_HEADS, N_DH), b_kv.reshape(B, S, 6, N_GROUPS, N_DH),
              b_g.reshape(B, S, N_HEADS, 3), cmp_pos, cmp_w1, cmp_w2)
    y_c = mla(c_q, c_kv, positions, q_norm, kv_norm, w_uq, w_ukv)
    g = jax.nn.sigmoid(gates).reshape(B, S, 3, D_MODEL)
    merged = (g[:, :, 0] * (y_a @ w_branch[0]) + g[:, :, 1] * (y_b @ w_branch[1])
              + g[:, :, 2] * (y_c @ w_branch[2]))
    return merged @ w_out


def setup_inputs(seed: int = 0) -> dict:
    key = jax.random.key(seed)
    ks = jax.random.split(key, 20)
    f32 = jnp.float32

    def nrm(k, shape, fan):
        return jax.random.normal(k, shape, f32) * (fan ** -0.5)

    x = jax.random.normal(ks[0], (BATCH, SEQ, D_MODEL), f32)
    positions = (jnp.arange(SEQ, dtype=jnp.int32)[None, :]
                 + jax.random.randint(ks[1], (BATCH, 1), 0, 1024, dtype=jnp.int32))
    norm_gains = 1.0 + 0.05 * jax.random.normal(ks[2], (DEPTH, 4, D_MODEL), f32)
    w_in = nrm(ks[3], (DEPTH, D_MODEL, D_IN), D_MODEL)
    m_conv = nrm(ks[4], (DEPTH, M_CONV, 2 * M_HEADS * M_DQK), M_CONV)
    m_gate_bias = (0.01 * jax.random.normal(ks[5], (DEPTH, 2 * M_HEADS), f32)
                   + jnp.concatenate([jnp.zeros((M_HEADS,), f32), jnp.full((M_HEADS,), FORGET_BIAS, f32)]))
    m_head_norm = 1.0 + 0.05 * jax.random.normal(ks[6], (DEPTH, M_HEADS, M_DV), f32)
    nsa_cmp_pos = 0.02 * jax.random.normal(ks[7], (DEPTH, 2, CMP_LEN, N_DH), f32)
    nsa_cmp_w1 = nrm(ks[8], (DEPTH, 2, CMP_LEN * N_DH, CMP_HID), CMP_LEN * N_DH)
    nsa_cmp_w2 = nrm(ks[9], (DEPTH, 2, CMP_HID, N_DH), CMP_HID)
    mla_q_norm = 1.0 + 0.05 * jax.random.normal(ks[10], (DEPTH, Q_RANK), f32)
    mla_kv_norm = 1.0 + 0.05 * jax.random.normal(ks[11], (DEPTH, KV_RANK), f32)
    mla_w_uq = nrm(ks[12], (DEPTH, Q_RANK, L_HEADS * (D_NOPE + D_ROPE)), Q_RANK)
    mla_w_ukv = nrm(ks[13], (DEPTH, KV_RANK, L_HEADS * (D_NOPE + D_V)), KV_RANK)
    w_branch = nrm(ks[14], (DEPTH, 3, BRANCH_W, D_MODEL), BRANCH_W)
    w_out = nrm(ks[15], (DEPTH, D_MODEL, D_MODEL), D_MODEL)
    w_ffn_gate = nrm(ks[16], (DEPTH, D_MODEL, D_FF), D_MODEL)
    w_ffn_up = nrm(ks[17], (DEPTH, D_MODEL, D_FF), D_MODEL)
    w_ffn_down = nrm(ks[18], (DEPTH, D_FF, D_MODEL), D_FF)
    return {"x": x, "positions": positions, "norm_gains": norm_gains, "w_in": w_in,
            "m_conv": m_conv, "m_gate_bias": m_gate_bias, "m_head_norm": m_head_norm,
            "nsa_cmp_pos": nsa_cmp_pos, "nsa_cmp_w1": nsa_cmp_w1, "nsa_cmp_w2": nsa_cmp_w2,
            "mla_q_norm": mla_q_norm, "mla_kv_norm": mla_kv_norm, "mla_w_uq": mla_w_uq,
            "mla_w_ukv": mla_w_ukv, "w_branch": w_branch, "w_out": w_out,
            "w_ffn_gate": w_ffn_gate, "w_ffn_up": w_ffn_up, "w_ffn_down": w_ffn_down}


def reference(x, positions, norm_gains, w_in, m_conv, m_gate_bias, m_head_norm, nsa_cmp_pos,
              nsa_cmp_w1, nsa_cmp_w2, mla_q_norm, mla_kv_norm, mla_w_uq, mla_w_ukv, w_branch,
              w_out, w_ffn_gate, w_ffn_up, w_ffn_down):
    for l in range(DEPTH):
        h = rmsnorm(x, norm_gains[l, 0])
        mix = token_mixing(h, positions, w_in[l], m_conv[l], m_gate_bias[l], m_head_norm[l],
                           nsa_cmp_pos[l], nsa_cmp_w1[l], nsa_cmp_w2[l], mla_q_norm[l],
                           mla_kv_norm[l], mla_w_uq[l], mla_w_ukv[l], w_branch[l], w_out[l])
        x = x + rmsnorm(mix, norm_gains[l, 1])
        h = rmsnorm(x, norm_gains[l, 2])
        f = (jax.nn.silu(h @ w_ffn_gate[l]) * (h @ w_ffn_up[l])) @ w_ffn_down[l]
        x = x + rmsnorm(f, norm_gains[l, 3])
    return x
```

```cpp
#include <hip/hip_runtime.h>
#include <hip/hip_cooperative_groups.h>
#include <cstdio>
#include <cstdint>
namespace cg = cooperative_groups;

#define LAS __attribute__((address_space(3)))
typedef unsigned short bf16;
typedef short bf16x8 __attribute__((ext_vector_type(8)));
typedef float f32x4 __attribute__((ext_vector_type(4)));
typedef unsigned u32x4 __attribute__((ext_vector_type(4)));
typedef unsigned u32x2 __attribute__((ext_vector_type(2)));

constexpr int NB = 4, SEQ = 4096, T = NB * SEQ, DM = 1024, DIN = 6592, DFF = 2816;
constexpr float EPS = 1e-6f;
constexpr float LOG2E = 1.4426950408889634f;
constexpr float QSCALE_NSA = 0.125f * LOG2E;
constexpr float QSCALE_MLA = 0.10206207261596577f * LOG2E;
constexpr int NZ = 3584;

constexpr size_t MiB = 1u << 20;
constexpr size_t WS_ROPE = 1 * MiB, WS_SM = 3 * MiB, WS_SSQ = 5 * MiB, WS_SEL = 7 * MiB, WS_KCMP = 7 * MiB + 256 * 1024;
constexpr size_t WS_WIN = 9 * MiB, WS_WG = 16 * MiB, WS_WUQ = 22 * MiB, WS_WUKV = 22 * MiB + 640 * 1024, WS_WBR = 23 * MiB + 256 * 1024, WS_WOUT = 26 * MiB + 256 * 1024;
constexpr size_t WS_XB = 31 * MiB, WS_AV = 63 * MiB, WS_AO = 79 * MiB, WS_BQ = 95 * MiB, WS_BKV = 111 * MiB, WS_AQK = 135 * MiB, WS_CQKV = 151 * MiB;
constexpr size_t WS_QM = 171 * MiB, WS_KN = 195 * MiB, WS_VM = 211 * MiB, WS_KR = 227 * MiB, WS_CL = 228 * MiB;
constexpr size_t WS_P1 = 151 * MiB, WS_GT = 111 * MiB, WS_MERGED = 195 * MiB, WS_WGU = 63 * MiB, WS_WDN = 74 * MiB, WS_MIX = 95 * MiB, WS_U = 95 * MiB, WS_FD = 183 * MiB;
constexpr size_t WS_END = 247 * MiB;

constexpr int LDS_BYTES = 147456;

__device__ __forceinline__ unsigned f2bf(float f) { unsigned u = __builtin_bit_cast(unsigned, f); return (u + 0x7fffu + ((u >> 16) & 1u)) >> 16; }
__device__ __forceinline__ unsigned pk2(float lo, float hi) { return f2bf(lo) | (f2bf(hi) << 16); }
__device__ __forceinline__ float bf2f(unsigned short u) { return __builtin_bit_cast(float, (unsigned)u << 16); }
__device__ __forceinline__ float bflo(unsigned w) { return __builtin_bit_cast(float, w << 16); }
__device__ __forceinline__ float bfhi(unsigned w) { return __builtin_bit_cast(float, w & 0xffff0000u); }
__device__ __forceinline__ float wave_sum(float v) {
#pragma unroll
    for (int o = 1; o < 64; o <<= 1) v += __shfl_xor(v, o);
    return v;
}
__device__ __forceinline__ float wave_max(float v) {
#pragma unroll
    for (int o = 1; o < 64; o <<= 1) v = fmaxf(v, __shfl_xor(v, o));
    return v;
}
__device__ __forceinline__ float sigmoidf_(float x) { return 1.0f / (1.0f + __expf(-x)); }
__device__ __forceinline__ float siluf_(float x) { return x / (1.0f + __expf(-x)); }
__device__ __forceinline__ float logsigmoidf_(float x) { return x >= 0.f ? -log1pf(expf(-x)) : x - log1pf(expf(x)); }
__device__ __forceinline__ float rdlane(float v, int l) { return __builtin_bit_cast(float, __builtin_amdgcn_readlane(__builtin_bit_cast(int, v), l)); }

namespace pg8 {
constexpr int BM = 256, BK = 64, HALF = 128, HTB = HALF * BK * 2, STAGE_BYTES = 8 * HTB, NXCD = 8, WGM = 8;
__host__ __device__ __forceinline__ int lds_byte(int r, int c) { const int st = (r >> 4) * 2 + (c >> 5), rr = r & 15, cc = c & 31, ob = rr * 64 + cc * 2; return st * 1024 + (ob ^ (((ob >> 9) & 1) << 5)); }
__host__ __device__ __forceinline__ void stage_rc(int b, int& R, int& C) { const int st = b / 1024, sb = b % 1024, swz = sb ^ (((sb >> 9) & 1) << 5); R = (st >> 1) * 16 + swz / 64; C = (st & 1) * 32 + (swz % 64) / 2; }
__host__ __device__ __forceinline__ int perm32(int rho) { const int n = rho >> 4, i = rho & 15; return 8 * (i >> 2) + 4 * n + (i & 3); }

struct Unit { int pm, pn; };
struct Gemm { const bf16* A; const bf16* Bt; };

struct StaticOrder {
    int nM, nN, nwg, G, c;
    __host__ __device__ void init(int M, int N, int G_, int c_) { nM = M / BM; nN = N / BM; nwg = nM * nN; G = G_; c = c_; }
    __host__ __device__ bool next(int i, Unit& u) const {
        const long L = (long)i * G + c; if (L >= nwg) return false;
        int wgid = (int)L; { const int q = nwg / NXCD, r = nwg % NXCD, xcd = wgid % NXCD, off = wgid / NXCD; wgid = (xcd < r ? xcd * (q + 1) : r * (q + 1) + (xcd - r) * q) + off; }
        const int nig = WGM * nN, gid = wgid / nig, fm = gid * WGM, gsz = (nM - fm) < WGM ? (nM - fm) : WGM;
        u.pm = fm + ((wgid % nig) % gsz); u.pn = (wgid % nig) / gsz; return true;
    }
};

template <int GK, int LDA, int LDB, int KSTEPA, class Epi, class Sched>
__device__ __forceinline__ void gemm_phase(LAS unsigned char* lds, const Gemm g, const Sched& S, const Epi& E) {
    int tid_ = threadIdx.x; asm volatile("" : "+v"(tid_));
    const int tid = tid_, wid = __builtin_amdgcn_readfirstlane(tid >> 6), lane = tid & 63, wr = wid >> 2, wc = wid & 3, fr = lane & 15, fq = lane >> 4;
    constexpr int nt = GK / BK;
    unsigned voffA[2], voffB[2];
#pragma unroll
    for (int i = 0; i < 2; ++i) { int R, C; stage_rc(tid * 16 + i * 8192, R, C); const int Rb = Epi::PERM ? ((R & ~31) + perm32(R & 31)) : R;
        voffA[i] = (unsigned)(R * LDA + C) * 2u; voffB[i] = (unsigned)(Rb * LDB + C) * 2u; }
    constexpr size_t kstepA = (size_t)KSTEPA, kstepB = (size_t)(BK * 2);
    constexpr size_t hstepA = (size_t)HALF * LDA * 2, hstepB = (size_t)HALF * LDB * 2;
    constexpr size_t tstepA = 2 * hstepA, tstepB = 2 * hstepB;
    const unsigned ldsw = (unsigned)wid * 1024u;
    const int aoff = lds_byte(wr * 64 + fr, fq * 8), boff = lds_byte(wc * 32 + fr, fq * 8);
#define PG8_SA(b, h) (((b) * 2 + (h)) * HTB)
#define PG8_SB(b, h) ((4 + (b) * 2 + (h)) * HTB)
#define PG8_STAGE(bufoff, gbase, voff) do { _Pragma("unroll") for (int _i = 0; _i < 2; ++_i) \
        __builtin_amdgcn_global_load_lds((const unsigned*)((const char*)(gbase) + (voff)[_i]), (LAS unsigned*)(lds + (bufoff) + ldsw + _i * 8192), 16, 0, 0); } while (0)
#define PG8_LDA(dst, b, h) do { _Pragma("unroll") for (int m = 0; m < 4; ++m) _Pragma("unroll") for (int k = 0; k < 2; ++k) dst[m][k] = *(const LAS bf16x8*)(lds + PG8_SA(b, h) + aoff + m * 2048 + k * 1024); } while (0)
#define PG8_LDB(dst, b, h) do { _Pragma("unroll") for (int n = 0; n < 2; ++n) _Pragma("unroll") for (int k = 0; k < 2; ++k) dst[n][k] = *(const LAS bf16x8*)(lds + PG8_SB(b, h) + boff + n * 2048 + k * 1024); } while (0)
#define PG8_MMA(ai, bj, At, Bt) do { __builtin_amdgcn_s_setprio(1); _Pragma("unroll") for (int m = 0; m < 4; ++m) _Pragma("unroll") for (int n = 0; n < 2; ++n) _Pragma("unroll") for (int k = 0; k < 2; ++k) \
        acc[ai][bj][m][n] = __builtin_amdgcn_mfma_f32_16x16x32_bf16(Bt[n][k], At[m][k], acc[ai][bj][m][n], 0, 0, 0); __builtin_amdgcn_s_setprio(0); } while (0)
#define PG8_WAIT_V(n) asm volatile("s_waitcnt vmcnt(" #n ")" ::: "memory")
#define PG8_WAIT_L(n) asm volatile("s_waitcnt lgkmcnt(" #n ")" ::: "memory")
#define PG8_BAR __builtin_amdgcn_s_barrier()
#define PG8_SCHED __builtin_amdgcn_sched_barrier(0)
    Unit cur, nxt; int ui = 0;
    if (!S.next(0, cur)) return;
    f32x4 acc[2][2][4][2];
#pragma unroll
    for (int a = 0; a < 2; ++a)
#pragma unroll
        for (int b = 0; b < 2; ++b)
#pragma unroll
            for (int m = 0; m < 4; ++m)
#pragma unroll
                for (int n = 0; n < 2; ++n) acc[a][b][m][n] = (f32x4){0.f, 0.f, 0.f, 0.f};
    bf16x8 At[4][2], B0[2][2], B1[2][2];
    const char* cA = (const char*)g.A + (size_t)cur.pm * tstepA; const char* cB = (const char*)g.Bt + (size_t)cur.pn * tstepB;
    PG8_STAGE(PG8_SB(0, 0), cB, voffB); PG8_STAGE(PG8_SB(0, 1), cB + hstepB, voffB); PG8_STAGE(PG8_SA(0, 0), cA, voffA); PG8_STAGE(PG8_SA(0, 1), cA + hstepA, voffA);
    if (wr == 1) PG8_BAR;
    PG8_WAIT_V(2); PG8_BAR;
    PG8_STAGE(PG8_SB(1, 0), cB + kstepB, voffB); PG8_STAGE(PG8_SA(1, 0), cA + kstepA, voffA); PG8_STAGE(PG8_SB(1, 1), cB + hstepB + kstepB, voffB);
    PG8_WAIT_V(6); PG8_BAR;
    for (;;) {
        const bool has_next = S.next(ui + 1, nxt);
        const char* nA = has_next ? (const char*)g.A + (size_t)nxt.pm * tstepA : cA; const char* nB = has_next ? (const char*)g.Bt + (size_t)nxt.pn * tstepB : cB;
#pragma unroll 1
        for (int t = 0; t < nt; t += 2) {
            const bool last = (t == nt - 2);
            const char* a1 = cA + (size_t)(t + 1) * kstepA;
            const char* a2 = last ? nA : cA + (size_t)(t + 2) * kstepA; const char* b2 = last ? nB : cB + (size_t)(t + 2) * kstepB;
            const char* a3 = a2 + kstepA; const char* b3 = b2 + kstepB;
            PG8_LDB(B0, 0, 0); PG8_LDB(B1, 0, 1); PG8_SCHED; PG8_LDA(At, 0, 0); PG8_STAGE(PG8_SA(1, 1), a1 + hstepA, voffA);
            PG8_WAIT_V(8); PG8_WAIT_L(0); PG8_BAR; PG8_MMA(0, 0, At, B0); PG8_MMA(0, 1, At, B1); PG8_BAR; PG8_SCHED;
            PG8_LDA(At, 0, 1); PG8_STAGE(PG8_SB(0, 0), b2, voffB); PG8_STAGE(PG8_SB(0, 1), b2 + hstepB, voffB); PG8_STAGE(PG8_SA(0, 0), a2, voffA);
            PG8_WAIT_V(8); PG8_WAIT_L(0); PG8_BAR; PG8_MMA(1, 0, At, B0); PG8_MMA(1, 1, At, B1); PG8_BAR; PG8_SCHED;
            PG8_LDB(B0, 1, 0); PG8_LDB(B1, 1, 1); PG8_SCHED; PG8_LDA(At, 1, 0); PG8_STAGE(PG8_SA(0, 1), a2 + hstepA, voffA);
            PG8_WAIT_V(8); PG8_WAIT_L(0); PG8_BAR; PG8_MMA(0, 0, At, B0); PG8_MMA(0, 1, At, B1); PG8_BAR; PG8_SCHED;
            PG8_LDA(At, 1, 1); PG8_STAGE(PG8_SB(1, 0), b3, voffB); PG8_STAGE(PG8_SB(1, 1), b3 + hstepB, voffB); PG8_STAGE(PG8_SA(1, 0), a3, voffA);
            PG8_WAIT_V(8); PG8_WAIT_L(0); PG8_BAR; PG8_MMA(1, 0, At, B0); PG8_MMA(1, 1, At, B1); PG8_BAR; PG8_SCHED;
        }
        if (wr == 0) PG8_BAR;
        E(acc, cur, wr, wc, fr, fq);
        if (!has_next) break;
#pragma unroll
        for (int a = 0; a < 2; ++a)
#pragma unroll
            for (int b = 0; b < 2; ++b)
#pragma unroll
                for (int m = 0; m < 4; ++m)
#pragma unroll
                    for (int n = 0; n < 2; ++n) acc[a][b][m][n] = (f32x4){0.f, 0.f, 0.f, 0.f};
        cur = nxt; cA = nA; cB = nB; ++ui;
        if (wr == 1) PG8_BAR;
    }
    PG8_WAIT_V(0);
    PG8_BAR;
#undef PG8_SA
#undef PG8_SB
#undef PG8_STAGE
#undef PG8_LDA
#undef PG8_LDB
#undef PG8_MMA
#undef PG8_WAIT_V
#undef PG8_WAIT_L
#undef PG8_BAR
#undef PG8_SCHED
}
}
using pg8::Unit;
typedef const f32x4 (&AccRef)[2][2][4][2];

__device__ __forceinline__ u32x4 pack8(const f32x4 a, const f32x4 b) { u32x4 w; w.x = pk2(a[0], a[1]); w.y = pk2(a[2], a[3]); w.z = pk2(b[0], b[1]); w.w = pk2(b[2], b[3]); return w; }

struct EpiInProj {
    static constexpr bool PERM = true;
    bf16 *AQK, *AV, *AO, *BQ, *BKV, *CQKV, *KR; float *SM, *SSQ; const float* ROPE; const float* gbias;
    __device__ __forceinline__ void operator()(AccRef acc, const Unit& u, int wr, int wc, int fr, int fq) const {
        const int pn = u.pn;
#pragma unroll
        for (int ai = 0; ai < 2; ++ai)
#pragma unroll
            for (int m = 0; m < 4; ++m) {
                const int row = u.pm * 256 + ai * 128 + wr * 64 + m * 16 + fr;
#pragma unroll
                for (int bj = 0; bj < 2; ++bj) {
                    f32x4 v0 = acc[ai][bj][m][0], v1 = acc[ai][bj][m][1];
                    const int cg = bj * 128 + wc * 32;
                    const int c0 = cg + 8 * fq;
                    if (pn < 8) {
                        const int region = pn >> 1; const int col = (pn & 1) * 256 + c0;
                        bf16* base = region == 0 ? AQK : region == 1 ? AV : region == 2 ? AO : BQ;
                        if (region == 2) {
#pragma unroll
                            for (int e = 0; e < 4; ++e) { v0[e] = sigmoidf_(v0[e]); v1[e] = sigmoidf_(v1[e]); }
                        }
                        *(u32x4*)(base + (size_t)row * 512 + col) = pack8(v0, v1);
                    } else if (pn < 11) {
                        const int cc = (pn - 8) * 256 + c0; const int i = cc >> 7, gg = (cc >> 6) & 1, d = cc & 63; const int b = row >> 12, s = row & 4095;
                        *(u32x4*)(BKV + ((size_t)(((i * NB + b) * 2 + gg) * SEQ + s)) * 64 + d) = pack8(v0, v1);
                    } else {
                        const int gb = (pn - 11) * 256 + cg;
                        if (gb < 640) {
                            *(u32x4*)(CQKV + (size_t)row * 640 + gb + 8 * fq) = pack8(v0, v1);
                            float ss = 0.f;
#pragma unroll
                            for (int e = 0; e < 4; ++e) ss += v0[e] * v0[e] + v1[e] * v1[e];
                            ss += __shfl_xor(ss, 16); ss += __shfl_xor(ss, 32);
                            if (fq == 0) SSQ[(size_t)row * 24 + (gb >> 5)] = ss;
                        } else if (gb == 640) {
                            float o[8];
#pragma unroll
                            for (int e = 0; e < 8; ++e) {
                                const float v = e < 4 ? v0[e] : v1[e - 4]; const float p = __shfl_xor(v, 32);
                                const int i = (8 * fq + e) & 15; const float cs = ROPE[((size_t)row * 16 + i) * 2], sn = ROPE[((size_t)row * 16 + i) * 2 + 1];
                                o[e] = fq < 2 ? v * cs - p * sn : p * sn + v * cs;
                            }
                            u32x4 w; w.x = pk2(o[0], o[1]); w.y = pk2(o[2], o[3]); w.z = pk2(o[4], o[5]); w.w = pk2(o[6], o[7]);
                            *(u32x4*)(KR + (size_t)row * 32 + 8 * fq) = w;
                        } else if (gb == 672) {
                            float o[8];
#pragma unroll
                            for (int e = 0; e < 8; ++e) {
                                const float v = e < 4 ? v0[e] : v1[e - 4];
                                if (fq == 0) { const float x = v + gbias[e]; o[e] = e < 4 ? x : logsigmoidf_(x); }
                                else o[e] = sigmoidf_(v);
                            }
                            float* dst = SM + (size_t)row * 32 + 8 * fq;
                            *(f32x4*)dst = (f32x4){o[0], o[1], o[2], o[3]}; *(f32x4*)(dst + 4) = (f32x4){o[4], o[5], o[6], o[7]};
                        }
                    }
                }
                asm volatile("" ::: "memory");
            }
    }
};

struct EpiMlaQ {
    static constexpr bool PERM = true;
    bf16* QM; const float* SSQ; const float* ROPE;
    __device__ __forceinline__ void operator()(AccRef acc, const Unit& u, int wr, int wc, int fr, int fq) const {
#pragma unroll
        for (int ai = 0; ai < 2; ++ai)
#pragma unroll
            for (int m = 0; m < 4; ++m) {
                const int row = u.pm * 256 + ai * 128 + wr * 64 + m * 16 + fr;
                const f32x4* sp = (const f32x4*)(SSQ + (size_t)row * 24);
                const f32x4 s0 = sp[0], s1 = sp[1], s2 = sp[2];
                const float ss = (s0[0] + s0[1] + s0[2] + s0[3]) + (s1[0] + s1[1] + s1[2] + s1[3]) + (s2[0] + s2[1] + s2[2] + s2[3]);
                const float rstd = rsqrtf(ss * (1.0f / 384.0f) + EPS);
#pragma unroll
                for (int bj = 0; bj < 2; ++bj) {
                    const int cgi = u.pn * 8 + bj * 4 + wc;
                    f32x4 v0 = acc[ai][bj][m][0] * rstd, v1 = acc[ai][bj][m][1] * rstd;
                    if (cgi % 3 == 2) {
                        float o[8];
#pragma unroll
                        for (int e = 0; e < 8; ++e) {
                            const float v = e < 4 ? v0[e] : v1[e - 4]; const float p = __shfl_xor(v, 32);
                            const int i = (8 * fq + e) & 15; const float cs = ROPE[((size_t)row * 16 + i) * 2], sn = ROPE[((size_t)row * 16 + i) * 2 + 1];
                            o[e] = fq < 2 ? v * cs - p * sn : p * sn + v * cs;
                        }
                        v0 = (f32x4){o[0], o[1], o[2], o[3]}; v1 = (f32x4){o[4], o[5], o[6], o[7]};
                    }
                    *(u32x4*)(QM + (size_t)row * 768 + cgi * 32 + 8 * fq) = pack8(v0, v1);
                }
                asm volatile("" ::: "memory");
            }
    }
};
struct EpiMlaKV {
    static constexpr bool PERM = true;
    bf16 *KN, *VM; const float* SSQ;
    __device__ __forceinline__ void operator()(AccRef acc, const Unit& u, int wr, int wc, int fr, int fq) const {
#pragma unroll
        for (int ai = 0; ai < 2; ++ai)
#pragma unroll
            for (int m = 0; m < 4; ++m) {
                const int row = u.pm * 256 + ai * 128 + wr * 64 + m * 16 + fr;
                const f32x4* sp = (const f32x4*)(SSQ + (size_t)row * 24 + 12);
                const f32x4 s0 = sp[0], s1 = sp[1];
                const float ss = (s0[0] + s0[1] + s0[2] + s0[3]) + (s1[0] + s1[1] + s1[2] + s1[3]);
                const float rstd = rsqrtf(ss * (1.0f / 256.0f) + EPS);
                const int b = row >> 12, s = row & 4095;
#pragma unroll
                for (int bj = 0; bj < 2; ++bj) {
                    const int h = u.pn * 2 + bj; const int j = wc * 32 + 8 * fq;
                    const f32x4 v0 = acc[ai][bj][m][0] * rstd, v1 = acc[ai][bj][m][1] * rstd;
                    bf16* dst = (j < 64 ? KN : VM) + ((size_t)((b * 8 + h) * SEQ + s)) * 64 + (j & 63);
                    *(u32x4*)dst = pack8(v0, v1);
                }
                asm volatile("" ::: "memory");
            }
    }
};
struct EpiGate {
    static constexpr bool PERM = true;
    bf16* GT;
    __device__ __forceinline__ void operator()(AccRef acc, const Unit& u, int wr, int wc, int fr, int fq) const {
        int tid = threadIdx.x; asm volatile("" : "+v"(tid));
#pragma unroll
        for (int ai = 0; ai < 2; ++ai)
#pragma unroll
            for (int bj = 0; bj < 2; ++bj)
#pragma unroll
                for (int m = 0; m < 4; ++m) {
                    f32x4 v0 = acc[ai][bj][m][0], v1 = acc[ai][bj][m][1];
#pragma unroll
                    for (int e = 0; e < 4; ++e) { v0[e] = sigmoidf_(v0[e]); v1[e] = sigmoidf_(v1[e]); }
                    const int q = (ai * 2 + bj) * 4 + m;
                    *(u32x4*)(GT + ((size_t)q * 512 + tid) * 8) = pack8(v0, v1);
                    asm volatile("" ::: "memory");
                }
    }
};
struct EpiBranch {
    static constexpr bool PERM = true;
    const bf16* GT; bf16* MG; int first;
    __device__ __forceinline__ void operator()(AccRef acc, const Unit& u, int wr, int wc, int fr, int fq) const {
        int tid = threadIdx.x; asm volatile("" : "+v"(tid));
#pragma unroll
        for (int ai = 0; ai < 2; ++ai)
#pragma unroll
            for (int m = 0; m < 4; ++m) {
                const int row = u.pm * 256 + ai * 128 + wr * 64 + m * 16 + fr;
#pragma unroll
                for (int bj = 0; bj < 2; ++bj) {
                    const int col = u.pn * 256 + bj * 128 + wc * 32 + 8 * fq;
                    const int q = (ai * 2 + bj) * 4 + m;
                    const u32x4 gw = *(const u32x4*)(GT + ((size_t)q * 512 + tid) * 8);
                    f32x4 v0 = acc[ai][bj][m][0], v1 = acc[ai][bj][m][1];
                    v0[0] *= bflo(gw.x); v0[1] *= bfhi(gw.x); v0[2] *= bflo(gw.y); v0[3] *= bfhi(gw.y);
                    v1[0] *= bflo(gw.z); v1[1] *= bfhi(gw.z); v1[2] *= bflo(gw.w); v1[3] *= bfhi(gw.w);
                    bf16* dst = MG + (size_t)row * 1024 + col;
                    if (!first) {
                        const u32x4 ow = *(const u32x4*)dst;
                        v0[0] += bflo(ow.x); v0[1] += bfhi(ow.x); v0[2] += bflo(ow.y); v0[3] += bfhi(ow.y);
                        v1[0] += bflo(ow.z); v1[1] += bfhi(ow.z); v1[2] += bflo(ow.w); v1[3] += bfhi(ow.w);
                    }
                    *(u32x4*)dst = pack8(v0, v1);
                }
                asm volatile("" ::: "memory");
            }
    }
};
struct EpiF32 {
    static constexpr bool PERM = false;
    float* C; int ldc;
    __device__ __forceinline__ void operator()(AccRef acc, const Unit& u, int wr, int wc, int fr, int fq) const {
        const int row0 = u.pm * 256 + wr * 64 + fr, col0 = u.pn * 256 + wc * 32 + 4 * fq;
#pragma unroll
        for (int ai = 0; ai < 2; ++ai)
#pragma unroll
            for (int m = 0; m < 4; ++m) { float* rowp = C + (size_t)(row0 + ai * 128 + m * 16) * ldc + col0;
#pragma unroll
                for (int bj = 0; bj < 2; ++bj)
#pragma unroll
                    for (int n = 0; n < 2; ++n) *(f32x4*)(rowp + bj * 128 + n * 16) = acc[ai][bj][m][n]; }
    }
};
struct EpiSwiGLU {
    static constexpr bool PERM = true;
    bf16* U;
    __device__ __forceinline__ void operator()(AccRef acc, const Unit& u, int wr, int wc, int fr, int fq) const {
#pragma unroll
        for (int ai = 0; ai < 2; ++ai)
#pragma unroll
            for (int m = 0; m < 4; ++m) {
                const int row = u.pm * 256 + ai * 128 + wr * 64 + m * 16 + fr;
                f32x4 g0 = acc[ai][0][m][0], g1 = acc[ai][0][m][1]; const f32x4 u0 = acc[ai][1][m][0], u1 = acc[ai][1][m][1];
#pragma unroll
                for (int e = 0; e < 4; ++e) { g0[e] = siluf_(g0[e]) * u0[e]; g1[e] = siluf_(g1[e]) * u1[e]; }
                *(u32x4*)(U + (size_t)row * DFF + u.pn * 128 + wc * 32 + 8 * fq) = pack8(g0, g1);
                asm volatile("" ::: "memory");
            }
    }
};

struct ColSrc { const float* p; float cs; };
template <class Map>
__device__ __forceinline__ void tr_item(const Map& mp, int ldw, const float* kscale, bf16* WT, int ldt, int nblk, int item, LAS float* scr, int lane) {
    const int kb = item / nblk, nb = item % nblk, k0 = 64 * kb, n0 = 32 * nb;
    const ColSrc cs = mp(n0 + (lane & 31));
#pragma unroll 8
    for (int i = 0; i < 32; ++i) { const int kk = 2 * i + (lane >> 5); const int k = k0 + kk;
        float v = 0.f; if (cs.p) { v = cs.p[(size_t)k * ldw] * cs.cs; if (kscale) v *= kscale[k]; }
        scr[kk * 33 + (lane & 31)] = v; }
    asm volatile("s_waitcnt lgkmcnt(0)" ::: "memory");
    const int c = lane & 7;
#pragma unroll
    for (int j = 0; j < 4; ++j) { const int n = (lane >> 3) + 8 * j; const LAS float* s = scr + (8 * c) * 33 + n;
        u32x4 o; o.x = pk2(s[0 * 33], s[1 * 33]); o.y = pk2(s[2 * 33], s[3 * 33]); o.z = pk2(s[4 * 33], s[5 * 33]); o.w = pk2(s[6 * 33], s[7 * 33]);
        *(u32x4*)(WT + (size_t)(n0 + n) * ldt + k0 + 8 * c) = o; }
    asm volatile("s_waitcnt lgkmcnt(0)" ::: "memory");
}
struct MapIn {
    const float* W;
    __device__ __forceinline__ ColSrc operator()(int n) const {
        int src; float cs = 1.f;
        if (n < 1536) src = n;
        else if (n < 2048) { src = 1544 + (n - 1536); cs = QSCALE_NSA; }
        else if (n < 2816) src = 2056 + (n - 2048);
        else if (n < 3200) src = 2848 + (n - 2816);
        else if (n < 3488) src = 3232 + (n - 3200);
        else if (n < 3496) src = 1536 + (n - 3488);
        else if (n < 3520) src = 2824 + (n - 3496);
        else src = -1;
        ColSrc r; r.p = src >= 0 ? W + src : nullptr; r.cs = cs; return r;
    }
};
struct MapPlain { const float* W; int off; float cs; __device__ __forceinline__ ColSrc operator()(int n) const { ColSrc r; r.p = W + off + n; r.cs = cs; return r; } };
struct MapGU { const float* Wg; const float* Wu; __device__ __forceinline__ ColSrc operator()(int n) const { const int j = n >> 8, w = n & 255; ColSrc r; r.p = (w < 128 ? Wg : Wu) + 128 * j + (w & 127); r.cs = 1.f; return r; } };

__device__ __forceinline__ void row_resnorm(const float* xin, const float* delta, const float* gain, float* xout, bf16* xb, int lane) {
    f32x4 v[4];
#pragma unroll
    for (int j = 0; j < 4; ++j) v[j] = ((const f32x4*)xin)[lane + 64 * j];
    if (delta) {
        f32x4 d[4]; float s = 0.f;
#pragma unroll
        for (int j = 0; j < 4; ++j) { d[j] = ((const f32x4*)delta)[lane + 64 * j]; s += (d[j][0] * d[j][0] + d[j][1] * d[j][1]) + (d[j][2] * d[j][2] + d[j][3] * d[j][3]); }
        const float rstd = rsqrtf(wave_sum(s) * (1.0f / DM) + EPS);
#pragma unroll
        for (int j = 0; j < 4; ++j) { const f32x4 g = ((const f32x4*)gain)[lane + 64 * j]; v[j] = v[j] + g * d[j] * rstd; }
    }
    if (xout) {
#pragma unroll
        for (int j = 0; j < 4; ++j) ((f32x4*)xout)[lane + 64 * j] = v[j];
    }
    float s2 = 0.f;
#pragma unroll
    for (int j = 0; j < 4; ++j) s2 += (v[j][0] * v[j][0] + v[j][1] * v[j][1]) + (v[j][2] * v[j][2] + v[j][3] * v[j][3]);
    const float r2 = rsqrtf(wave_sum(s2) * (1.0f / DM) + EPS);
#pragma unroll
    for (int j = 0; j < 4; ++j) { u32x2 w; w.x = pk2(v[j][0] * r2, v[j][1] * r2); w.y = pk2(v[j][2] * r2, v[j][3] * r2); ((u32x2*)xb)[lane + 64 * j] = w; }
}

template <int NH, bool EXT>
__device__ __forceinline__ void nattn_block(const float* qs, const bf16* Kb, int ldk, const bf16* K2b, int ldk2, const bf16* Vb, int ldv,
                                            const bool (&valid)[NH], float (&m)[NH], float (&l)[NH], float (&o)[NH], int lane) {
    constexpr int QD = EXT ? 96 : 64;
    float s[NH];
#pragma unroll
    for (int h = 0; h < NH; ++h) s[h] = 0.f;
    const u32x4* kp = (const u32x4*)(Kb + (size_t)lane * ldk);
#pragma unroll
    for (int c = 0; c < 8; ++c) {
        asm volatile("" ::: "memory");
        const u32x4 kk = kp[c];
        const float kf[8] = {bflo(kk.x), bfhi(kk.x), bflo(kk.y), bfhi(kk.y), bflo(kk.z), bfhi(kk.z), bflo(kk.w), bfhi(kk.w)};
#pragma unroll
        for (int h = 0; h < NH; ++h)
#pragma unroll
            for (int e = 0; e < 8; ++e) s[h] += qs[h * QD + 8 * c + e] * kf[e];
    }
    if (EXT) {
        const u32x4* k2 = (const u32x4*)(K2b + (size_t)lane * ldk2);
#pragma unroll
        for (int c = 0; c < 4; ++c) {
            asm volatile("" ::: "memory");
            const u32x4 kk = k2[c];
            const float kf[8] = {bflo(kk.x), bfhi(kk.x), bflo(kk.y), bfhi(kk.y), bflo(kk.z), bfhi(kk.z), bflo(kk.w), bfhi(kk.w)};
#pragma unroll
            for (int h = 0; h < NH; ++h)
#pragma unroll
                for (int e = 0; e < 8; ++e) s[h] += qs[h * QD + 64 + 8 * c + e] * kf[e];
        }
    }
    float p[NH];
#pragma unroll
    for (int h = 0; h < NH; ++h) {
        const float sv = valid[h] ? s[h] : -INFINITY;
        const float bm = wave_max(sv);
        const float mn = fmaxf(m[h], bm);
        if (mn == -INFINITY) { p[h] = 0.f; continue; }
        const float alpha = exp2f(m[h] - mn);
        p[h] = valid[h] ? exp2f(s[h] - mn) : 0.f;
        l[h] = l[h] * alpha + wave_sum(p[h]); o[h] *= alpha; m[h] = mn;
    }
#pragma unroll 8
    for (int key = 0; key < 64; ++key) {
        const float vv = bf2f(Vb[(size_t)key * ldv + lane]);
#pragma unroll
        for (int h = 0; h < NH; ++h) o[h] += rdlane(p[h], key) * vv;
    }
}

struct Args { const void* in[19]; float* out; unsigned char* ws; };

struct Ctx {
    const float *x_in; const int* positions; float* XS;
    float *ROPE, *SM, *SSQ; unsigned long long* SEL; float* KCMP;
    bf16 *W_IN, *W_G, *W_UQ, *W_UKV, *W_BR, *W_OUT, *W_GU, *W_DN;
    bf16 *XB, *AV, *AO, *BQ, *BKV, *AQK, *CQKV, *QM, *KN, *VM, *KR, *P1, *GTall, *MERGED, *U; float *MIX, *FD;
    const float *gains, *w_in, *m_conv, *m_gbias, *m_hnorm, *cmp_pos, *cmp_w1, *cmp_w2, *q_norm, *kv_norm, *w_uq, *w_ukv, *w_branch, *w_out, *w_fg, *w_fu, *w_fd;
};
__device__ __forceinline__ Ctx make_ctx(const Args& args, int layer) {
    Ctx c; unsigned char* ws = args.ws;
    c.x_in = (const float*)args.in[0]; c.positions = (const int*)args.in[1]; c.XS = args.out;
    c.ROPE = (float*)(ws + WS_ROPE); c.SM = (float*)(ws + WS_SM); c.SSQ = (float*)(ws + WS_SSQ); c.SEL = (unsigned long long*)(ws + WS_SEL); c.KCMP = (float*)(ws + WS_KCMP);
    c.W_IN = (bf16*)(ws + WS_WIN); c.W_G = (bf16*)(ws + WS_WG); c.W_UQ = (bf16*)(ws + WS_WUQ); c.W_UKV = (bf16*)(ws + WS_WUKV);
    c.W_BR = (bf16*)(ws + WS_WBR); c.W_OUT = (bf16*)(ws + WS_WOUT); c.W_GU = (bf16*)(ws + WS_WGU); c.W_DN = (bf16*)(ws + WS_WDN);
    c.XB = (bf16*)(ws + WS_XB); c.AV = (bf16*)(ws + WS_AV); c.AO = (bf16*)(ws + WS_AO); c.BQ = (bf16*)(ws + WS_BQ); c.BKV = (bf16*)(ws + WS_BKV);
    c.AQK = (bf16*)(ws + WS_AQK); c.CQKV = (bf16*)(ws + WS_CQKV); c.QM = (bf16*)(ws + WS_QM); c.KN = (bf16*)(ws + WS_KN); c.VM = (bf16*)(ws + WS_VM);
    c.KR = (bf16*)(ws + WS_KR); c.P1 = (bf16*)(ws + WS_P1); c.GTall = (bf16*)(ws + WS_GT); c.MERGED = (bf16*)(ws + WS_MERGED);
    c.MIX = (float*)(ws + WS_MIX); c.U = (bf16*)(ws + WS_U); c.FD = (float*)(ws + WS_FD);
    c.gains = (const float*)args.in[2] + (size_t)layer * 4 * DM;
    c.w_in = (const float*)args.in[3] + (size_t)layer * DM * DIN;
    c.m_conv = (const float*)args.in[4] + (size_t)layer * 4 * 512;
    c.m_gbias = (const float*)args.in[5] + layer * 8;
    c.m_hnorm = (const float*)args.in[6] + layer * 512;
    c.cmp_pos = (const float*)args.in[7] + (size_t)layer * 2 * 2048;
    c.cmp_w1 = (const float*)args.in[8] + (size_t)layer * 2 * 2048 * 128;
    c.cmp_w2 = (const float*)args.in[9] + (size_t)layer * 2 * 128 * 64;
    c.q_norm = (const float*)args.in[10] + layer * 384;
    c.kv_norm = (const float*)args.in[11] + layer * 256;
    c.w_uq = (const float*)args.in[12] + (size_t)layer * 384 * 768;
    c.w_ukv = (const float*)args.in[13] + (size_t)layer * 256 * 1024;
    c.w_branch = (const float*)args.in[14] + (size_t)layer * 3 * 512 * 1024;
    c.w_out = (const float*)args.in[15] + (size_t)layer * DM * DM;
    c.w_fg = (const float*)args.in[16] + (size_t)layer * DM * DFF;
    c.w_fu = (const float*)args.in[17] + (size_t)layer * DM * DFF;
    c.w_fd = (const float*)args.in[18] + (size_t)layer * DFF * DM;
    return c;
}

#define PHASE_IDS int tid_o = threadIdx.x; asm volatile("" : "+v"(tid_o)); const int tid = tid_o, lane = tid & 63, wave = __builtin_amdgcn_readfirstlane(tid >> 6), gw = blk * 8 + wave; \
    LAS float* wscr = (LAS float*)(lds + wave * 16384); (void)wscr; (void)gw; (void)lane; (void)tid

enum { PH_P0 = 0, PH_A2, PH_B, PH_E, PH_F, PH_F2, PH_G, PH_H, PH_H2 };

template <int PH>
__device__ __forceinline__ void run_phase(const Args& args, int layer, unsigned char* lds_raw) {
    LAS unsigned char* lds = (LAS unsigned char*)lds_raw;
    const int G = gridDim.x, blk = blockIdx.x, NGW = G * 8;
    const Ctx c = make_ctx(args, layer);
    if constexpr (PH == PH_P0) {
        PHASE_IDS;
        constexpr int I_IN = (DM / 64) * (NZ / 32), I_G = (DM / 64) * (3072 / 32), I_UQ = (384 / 64) * (768 / 32), I_UKV = (256 / 64) * (1024 / 32);
        constexpr int I_BR = (512 / 64) * (1024 / 32), I_OUT = (DM / 64) * (DM / 32);
        constexpr int NIT = I_IN + I_G + I_UQ + I_UKV + 3 * I_BR + I_OUT;
#pragma unroll 1
        for (int it = gw; it < NIT; it += NGW) {
            int r = it;
            if (r < I_IN) { tr_item(MapIn{c.w_in}, DIN, c.gains, c.W_IN, DM, NZ / 32, r, wscr, lane); continue; } r -= I_IN;
            if (r < I_G) { tr_item(MapPlain{c.w_in, 3520, 1.f}, DIN, c.gains, c.W_G, DM, 3072 / 32, r, wscr, lane); continue; } r -= I_G;
            if (r < I_UQ) { tr_item(MapPlain{c.w_uq, 0, QSCALE_MLA}, 768, c.q_norm, c.W_UQ, 384, 768 / 32, r, wscr, lane); continue; } r -= I_UQ;
            if (r < I_UKV) { tr_item(MapPlain{c.w_ukv, 0, 1.f}, 1024, c.kv_norm, c.W_UKV, 256, 1024 / 32, r, wscr, lane); continue; } r -= I_UKV;
            if (r < 3 * I_BR) { const int br = r / I_BR; tr_item(MapPlain{c.w_branch + (size_t)br * 512 * 1024, 0, 1.f}, 1024, nullptr, c.W_BR + (size_t)br * 1024 * 512, 512, 1024 / 32, r % I_BR, wscr, lane); continue; } r -= 3 * I_BR;
            tr_item(MapPlain{c.w_out, 0, 1.f}, DM, nullptr, c.W_OUT, DM, DM / 32, r, wscr, lane);
        }
        if (layer == 0) {
#pragma unroll 1
            for (int i = blk * 512 + tid; i < T * 16; i += G * 512) {
                const int t = i >> 4, d = i & 15;
                const double f4 = (d & 3) == 0 ? 1.0 : (d & 3) == 1 ? 0.5623413251903491 : (d & 3) == 2 ? 0.31622776601683794 : 0.1778279410038923;
                const double f1 = (d >> 2) == 0 ? 1.0 : (d >> 2) == 1 ? 0.1 : (d >> 2) == 2 ? 0.01 : 0.001;
                const double ang = (double)c.positions[t] * (f4 * f1);
                const double q = rint(ang * 0.6366197723675814);
                const double y = fma(-q, 6.123233995736766e-17, fma(-q, 1.5707963267948966, ang));
                const double y2 = y * y;
                const double sy = y * (1.0 + y2 * (-1.0 / 6 + y2 * (1.0 / 120 + y2 * (-1.0 / 5040 + y2 * (1.0 / 362880 + y2 * (-1.0 / 39916800))))));
                const double cy = 1.0 + y2 * (-0.5 + y2 * (1.0 / 24 + y2 * (-1.0 / 720 + y2 * (1.0 / 40320 + y2 * (-1.0 / 3628800 + y2 * (1.0 / 479001600))))));
                const int qi = (int)q & 3;
                const double cs = qi == 0 ? cy : qi == 1 ? -sy : qi == 2 ? -cy : sy;
                const double sn = qi == 0 ? sy : qi == 1 ? cy : qi == 2 ? -sy : -cy;
                c.ROPE[2 * (size_t)i] = (float)cs; c.ROPE[2 * (size_t)i + 1] = (float)sn;
            }
#pragma unroll 1
            for (int m = gw; m < T; m += NGW) row_resnorm(c.x_in + (size_t)m * DM, nullptr, nullptr, nullptr, c.XB + (size_t)m * DM, lane);
        }
    }
    if constexpr (PH == PH_A2) {
        pg8::Gemm g{c.XB, c.W_IN}; pg8::StaticOrder S; S.init(T, NZ, G, blk);
        EpiInProj E{c.AQK, c.AV, c.AO, c.BQ, c.BKV, c.CQKV, c.KR, c.SM, c.SSQ, c.ROPE, c.m_gbias};
        pg8::gemm_phase<DM, DM, DM, 128>(lds, g, S, E);
    }
    if constexpr (PH == PH_B) {
        { pg8::Gemm g{c.CQKV, c.W_UQ}; pg8::StaticOrder S; S.init(T, 768, G, blk); EpiMlaQ E{c.QM, c.SSQ, c.ROPE}; pg8::gemm_phase<384, 640, 384, 128>(lds, g, S, E); }
        { pg8::Gemm g{c.CQKV + 384, c.W_UKV}; pg8::StaticOrder S; S.init(T, 1024, G, blk); EpiMlaKV E{c.KN, c.VM, c.SSQ}; pg8::gemm_phase<256, 640, 256, 128>(lds, g, S, E); }
    }
    if constexpr (PH == PH_E) {
        pg8::StaticOrder S; S.init(T, DM, G, blk);
        bf16* GT = c.GTall + (size_t)blk * 65536;
        { pg8::Gemm g{c.XB, c.W_G}; EpiGate E{GT}; pg8::gemm_phase<DM, DM, DM, 128>(lds, g, S, E); }
        { pg8::Gemm g{c.AV, c.W_BR}; EpiBranch E{GT, c.MERGED, 1}; pg8::gemm_phase<512, 512, 512, 128>(lds, g, S, E); }
        { pg8::Gemm g{c.XB, c.W_G + (size_t)1024 * 1024}; EpiGate E{GT}; pg8::gemm_phase<DM, DM, DM, 128>(lds, g, S, E); }
        { pg8::Gemm g{c.BQ, c.W_BR + (size_t)1024 * 512}; EpiBranch E{GT, c.MERGED, 0}; pg8::gemm_phase<512, 512, 512, 128>(lds, g, S, E); }
        { pg8::Gemm g{c.XB, c.W_G + (size_t)2 * 1024 * 1024}; EpiGate E{GT}; pg8::gemm_phase<DM, DM, DM, 128>(lds, g, S, E); }
        { pg8::Gemm g{c.QM, c.W_BR + (size_t)2 * 1024 * 512}; EpiBranch E{GT, c.MERGED, 0}; pg8::gemm_phase<512, 768, 512, 192>(lds, g, S, E); }
    }
    if constexpr (PH == PH_F) {
        {
            PHASE_IDS;
            constexpr int I_GU = (DM / 64) * (2 * DFF / 32), I_DN = (DFF / 64) * (DM / 32);
#pragma unroll 1
            for (int it = gw; it < I_GU + I_DN; it += NGW) {
                if (it < I_GU) {
                    const int n0 = 32 * (it % (2 * DFF / 32)), j = n0 >> 8, w = n0 & 255;
                    if (w < 128) tr_item(MapPlain{c.w_fg, 128 * j + w - n0, 1.f}, DFF, c.gains + 2 * DM, c.W_GU, DM, 2 * DFF / 32, it, wscr, lane);
                    else tr_item(MapPlain{c.w_fu, 128 * j + (w - 128) - n0, 1.f}, DFF, c.gains + 2 * DM, c.W_GU, DM, 2 * DFF / 32, it, wscr, lane);
                }
                else tr_item(MapPlain{c.w_fd, 0, 1.f}, DM, nullptr, c.W_DN, DFF, DM / 32, it - I_GU, wscr, lane);
            }
        }
        __syncthreads();
        pg8::Gemm g{c.MERGED, c.W_OUT}; pg8::StaticOrder S; S.init(T, DM, G, blk); EpiF32 E{c.MIX, DM};
        pg8::gemm_phase<DM, DM, DM, 128>(lds, g, S, E);
    }
    if constexpr (PH == PH_F2) {
        PHASE_IDS;
#pragma unroll 1
        for (int m = gw; m < T; m += NGW) row_resnorm((layer == 0 ? c.x_in : c.XS) + (size_t)m * DM, c.MIX + (size_t)m * DM, c.gains + DM, c.XS + (size_t)m * DM, c.XB + (size_t)m * DM, lane);
    }
    if constexpr (PH == PH_G) {
        pg8::Gemm g{c.XB, c.W_GU}; pg8::StaticOrder S; S.init(T, 2 * DFF, G, blk); EpiSwiGLU E{c.U};
        pg8::gemm_phase<DM, DM, DM, 128>(lds, g, S, E);
    }
    if constexpr (PH == PH_H) {
        pg8::Gemm g{c.U, c.W_DN}; pg8::StaticOrder S; S.init(T, DM, G, blk); EpiF32 E{c.FD, DM};
        pg8::gemm_phase<DFF, DFF, DFF, 128>(lds, g, S, E);
    }
    if constexpr (PH == PH_H2) {
        PHASE_IDS;
#pragma unroll 1
        for (int m = gw; m < T; m += NGW) row_resnorm(c.XS + (size_t)m * DM, c.FD + (size_t)m * DM, c.gains + 3 * DM, c.XS + (size_t)m * DM, c.XB + (size_t)m * DM, lane);
    }
}
template <int PH>
__global__ void __launch_bounds__(512, 2) k_phase(Args args, int layer) {
    extern __shared__ __attribute__((aligned(16))) unsigned char lds_raw[];
    run_phase<PH>(args, layer, lds_raw);
}

__global__ void __launch_bounds__(256) k_compress(Args args, int layer) {
    __shared__ float hbuf[2 * 128];
    const Ctx c = make_ctx(args, layer);
    const int tid = threadIdx.x;
    for (int it = blockIdx.x; it < 2040; it += gridDim.x) {
        const int r = it * 2 + (tid >> 7), j = tid & 127;
        const int kv = r / 2040, rem = r % 2040, bg = rem / 255, n = rem % 255, b = bg >> 1, gg = bg & 1;
        const bf16* xr = c.BKV + ((size_t)(((kv * NB + b) * 2 + gg) * SEQ + 16 * n)) * 64;
        const float* w1 = c.cmp_w1 + (size_t)kv * 2048 * 128 + j; const float* ps = c.cmp_pos + kv * 2048;
        float acc = 0.f;
#pragma unroll 8
        for (int k = 0; k < 2048; ++k) acc += (bf2f(xr[k]) + ps[k]) * w1[(size_t)k * 128];
        __syncthreads();
        hbuf[(tid >> 7) * 128 + j] = siluf_(acc);
        __syncthreads();
        if (tid < 128) {
            const int rr = tid >> 6, d = tid & 63; const int r2 = it * 2 + rr;
            const int kv2 = r2 / 2040, rem2 = r2 % 2040, bg2 = rem2 / 255, n2 = rem2 % 255;
            const float* w2 = c.cmp_w2 + (size_t)kv2 * 128 * 64 + d; float o = 0.f;
#pragma unroll 8
            for (int jj = 0; jj < 128; ++jj) o += hbuf[rr * 128 + jj] * w2[jj * 64];
            c.KCMP[((size_t)((kv2 * 8 + bg2) * 256 + n2)) * 64 + d] = o;
        }
    }
}
__global__ void __launch_bounds__(256) k_mla_naive(Args args, int layer) {
    __shared__ float qsh[4][4 * 96];
    const Ctx c = make_ctx(args, layer);
    const int tid = threadIdx.x, lane = tid & 63, wave = tid >> 6;
    float* qs = qsh[wave];
    const int NGW = gridDim.x * 4, gw = blockIdx.x * 4 + wave;
    for (int task0 = gw; task0 < 32768; task0 += NGW) {
        const int bh = task0 & 31, tq0 = task0 >> 5, tq = (bh & 1) ? 1023 - tq0 : tq0;
        const int b = bh >> 3, h = bh & 7, s0 = tq * 4; const size_t t0 = (size_t)b * SEQ + s0;
        for (int e = lane; e < 4 * 96; e += 64) qs[e] = bf2f(c.QM[(t0 + e / 96) * 768 + h * 96 + (e % 96)]);
        float m[4], l[4], o[4];
#pragma unroll
        for (int r = 0; r < 4; ++r) { m[r] = -INFINITY; l[r] = 0.f; o[r] = 0.f; }
        const bf16* Kh = c.KN + (size_t)(b * 8 + h) * SEQ * 64; const bf16* Vh = c.VM + (size_t)(b * 8 + h) * SEQ * 64; const bf16* Krh = c.KR + (size_t)b * SEQ * 32;
        const int nkb = (s0 + 3) / 64 + 1;
        for (int kb = 0; kb < nkb; ++kb) {
            const int key = kb * 64 + lane; bool valid[4];
#pragma unroll
            for (int r = 0; r < 4; ++r) valid[r] = key <= s0 + r;
            nattn_block<4, true>(qs, Kh + (size_t)kb * 64 * 64, 64, Krh + (size_t)kb * 64 * 32, 32, Vh + (size_t)kb * 64 * 64, 64, valid, m, l, o, lane);
        }
#pragma unroll
        for (int r = 0; r < 4; ++r) c.QM[(t0 + r) * 768 + h * 96 + lane] = (bf16)f2bf(o[r] / l[r]);
    }
}
__global__ void __launch_bounds__(256) k_cmp_naive(Args args, int layer) {
    __shared__ float qsh[4][256 + 256];
    const Ctx c = make_ctx(args, layer);
    const int tid = threadIdx.x, lane = tid & 63, wave = tid >> 6;
    float* qs = qsh[wave]; float* psb = qs + 256;
    const int NGW = gridDim.x * 4, gw = blockIdx.x * 4 + wave;
    for (int task = gw; task < 32768; task += NGW) {
        const int bg = task >> 12, s = task & 4095, b = bg >> 1, gg = bg & 1; const size_t t = (size_t)b * SEQ + s;
        for (int e = lane; e < 256; e += 64) qs[e] = bf2f(c.BQ[t * 512 + gg * 256 + e]);
        const float* Kc = c.KCMP + (size_t)(0 * 8 + bg) * 256 * 64; const float* Vc = c.KCMP + (size_t)(1 * 8 + bg) * 256 * 64;
        float sc[4][4]; float mx[4] = {-INFINITY, -INFINITY, -INFINITY, -INFINITY};
#pragma unroll
        for (int kb = 0; kb < 4; ++kb) {
            const int n = kb * 64 + lane; const bool valid = (n < 255) && (16 * n + 31 <= s);
            const float* kr = Kc + (size_t)n * 64; float a[4] = {0.f, 0.f, 0.f, 0.f};
            for (int d0 = 0; d0 < 64; d0 += 4) {
                const f32x4 kd = *(const f32x4*)(kr + d0);
#pragma unroll
                for (int e = 0; e < 4; ++e)
#pragma unroll
                    for (int h = 0; h < 4; ++h) a[h] += qs[h * 64 + d0 + e] * kd[e];
            }
#pragma unroll
            for (int h = 0; h < 4; ++h) { sc[kb][h] = valid ? a[h] : -INFINITY; mx[h] = fmaxf(mx[h], sc[kb][h]); }
        }
        float o[4] = {0.f, 0.f, 0.f, 0.f}; float psum[4] = {0.f, 0.f, 0.f, 0.f};
#pragma unroll
        for (int h = 0; h < 4; ++h) {
            const float mh = wave_max(mx[h]);
            float e[4]; float ls = 0.f;
#pragma unroll
            for (int kb = 0; kb < 4; ++kb) { e[kb] = (mh == -INFINITY || sc[kb][h] == -INFINITY) ? 0.f : exp2f(sc[kb][h] - mh); ls += e[kb]; }
            ls = wave_sum(ls); const float inv = ls > 0.f ? 1.0f / ls : 0.f;
#pragma unroll
            for (int kb = 0; kb < 4; ++kb) { sc[kb][h] = e[kb] * inv; psum[kb] += sc[kb][h]; }
        }
#pragma unroll
        for (int kb = 0; kb < 4; ++kb) {
            for (int key = 0; key < 64; ++key) {
                const int n = kb * 64 + key; if (16 * n + 31 > s) break;
                const float vv = Vc[(size_t)n * 64 + lane];
#pragma unroll
                for (int h = 0; h < 4; ++h) o[h] += rdlane(sc[kb][h], key) * vv;
            }
        }
#pragma unroll
        for (int kb = 0; kb < 4; ++kb) psb[kb * 64 + lane] = psum[kb];
        __builtin_amdgcn_wave_barrier();
        float imp = 0.f;
#pragma unroll
        for (int q = -1; q < 4; ++q) { const int n = 4 * lane + q; if (n >= 0 && n < 255) imp += psb[n]; }
        const int cur = s >> 6;
        const bool vj = lane <= cur; const bool forced = (lane == 0) || (lane == cur) || (lane == cur - 1);
        const float score = vj ? imp + (forced ? 1e4f : 0.f) : -1.0f;
        int cnt = 0;
        for (int i2 = 0; i2 < 64; ++i2) { const float si = rdlane(score, i2); cnt += ((si > score) || (si == score && i2 < lane)) ? 1 : 0; }
        const bool selb = (cnt < 16) && (score > -0.5f);
        const unsigned long long mask = __ballot(selb);
        if (lane == 0) c.SEL[t * 2 + gg] = mask;
#pragma unroll
        for (int h = 0; h < 4; ++h) c.P1[t * 512 + (gg * 4 + h) * 64 + lane] = (bf16)f2bf(c.SM[t * 32 + 8 + (gg * 4 + h) * 3 + 0] * o[h]);
        __builtin_amdgcn_wave_barrier();
    }
}
__global__ void __launch_bounds__(256) k_selwin_naive(Args args, int layer) {
    __shared__ float qsh[4][256];
    const Ctx c = make_ctx(args, layer);
    const int tid = threadIdx.x, lane = tid & 63, wave = tid >> 6;
    float* qs = qsh[wave];
    const int NGW = gridDim.x * 4, gw = blockIdx.x * 4 + wave;
    for (int task = gw; task < 32768; task += NGW) {
        const int bg = task & 7, s = task >> 3, b = bg >> 1, gg = bg & 1; const size_t t = (size_t)b * SEQ + s;
        for (int e = lane; e < 256; e += 64) qs[e] = bf2f(c.BQ[t * 512 + gg * 256 + e]);
        const unsigned long long mk = c.SEL[t * 2 + gg];
        const unsigned mlo = __builtin_amdgcn_readfirstlane((unsigned)mk), mhi = __builtin_amdgcn_readfirstlane((unsigned)(mk >> 32));
        const bf16* Ks = c.BKV + (size_t)((2 * NB + b) * 2 + gg) * SEQ * 64; const bf16* Vs = c.BKV + (size_t)((3 * NB + b) * 2 + gg) * SEQ * 64;
        const bf16* Kw = c.BKV + (size_t)((4 * NB + b) * 2 + gg) * SEQ * 64; const bf16* Vw = c.BKV + (size_t)((5 * NB + b) * 2 + gg) * SEQ * 64;
        float m[4], l[4], o[4], osel[4];
#pragma unroll
        for (int r = 0; r < 4; ++r) { m[r] = -INFINITY; l[r] = 0.f; o[r] = 0.f; }
        for (int j = 0; j < 64; ++j) {
            const unsigned bit = j < 32 ? (mlo >> j) & 1u : (mhi >> (j - 32)) & 1u;
            if (!bit) continue;
            const bool vk = (j * 64 + lane) <= s; bool valid[4] = {vk, vk, vk, vk};
            nattn_block<4, false>(qs, Ks + (size_t)j * 64 * 64, 64, nullptr, 0, Vs + (size_t)j * 64 * 64, 64, valid, m, l, o, lane);
        }
#pragma unroll
        for (int r = 0; r < 4; ++r) { osel[r] = l[r] > 0.f ? o[r] / l[r] : 0.f; m[r] = -INFINITY; l[r] = 0.f; o[r] = 0.f; }
        const int jb0 = (s >= 511 ? s - 511 : 0) >> 6, jb1 = s >> 6;
        for (int j = jb0; j <= jb1; ++j) {
            const int key = j * 64 + lane; const bool vk = (key <= s) && (s - key < 512); bool valid[4] = {vk, vk, vk, vk};
            nattn_block<4, false>(qs, Kw + (size_t)j * 64 * 64, 64, nullptr, 0, Vw + (size_t)j * 64 * 64, 64, valid, m, l, o, lane);
        }
#pragma unroll
        for (int r = 0; r < 4; ++r) {
            const int hh = gg * 4 + r; const float ow = l[r] > 0.f ? o[r] / l[r] : 0.f;
            const float y = bf2f(c.P1[t * 512 + hh * 64 + lane]) + c.SM[t * 32 + 8 + hh * 3 + 1] * osel[r] + c.SM[t * 32 + 8 + hh * 3 + 2] * ow;
            c.BQ[t * 512 + hh * 64 + lane] = (bf16)f2bf(y);
        }
        __builtin_amdgcn_wave_barrier();
    }
}
__global__ void __launch_bounds__(128) k_mlstm_naive(Args args, int layer) {
    __shared__ float qk[128]; __shared__ float red[2];
    const Ctx c = make_ctx(args, layer);
    const int tid = threadIdx.x, lane = tid & 63, wave = tid >> 6;
    const int b = blockIdx.x >> 2, h = blockIdx.x & 3;
    float C[64], nv[64];
#pragma unroll
    for (int d = 0; d < 64; ++d) { C[d] = 0.f; nv[d] = 0.f; }
    float mstate = 0.f;
    const int ch = tid < 64 ? h * 64 + tid : 256 + h * 64 + (tid - 64);
    float cw[4];
#pragma unroll
    for (int kk = 0; kk < 4; ++kk) cw[kk] = c.m_conv[kk * 512 + ch];
    const float hn = c.m_hnorm[h * 128 + tid];
    for (int s = 0; s < SEQ; ++s) {
        const size_t t = (size_t)b * SEQ + s;
        {
            float a = 0.f;
#pragma unroll
            for (int kk = 0; kk < 4; ++kk) { const int sp = s - 3 + kk; if (sp >= 0) a += cw[kk] * bf2f(c.AQK[((size_t)b * SEQ + sp) * 512 + ch]); }
            float y = siluf_(a); if (tid < 64) y *= 0.125f;
            qk[tid] = y;
        }
        __syncthreads();
        const float li = c.SM[t * 32 + h], lf = c.SM[t * 32 + 4 + h];
        const float mn = fmaxf(lf + mstate, li); const float fp = expf(lf + mstate - mn), ip = expf(li - mn); mstate = mn;
        const float v = bf2f(c.AV[t * 512 + h * 128 + tid]); const float iv = ip * v;
        float num = 0.f, den = 0.f;
#pragma unroll
        for (int d = 0; d < 64; ++d) { const float kd = qk[64 + d], qd = qk[d]; C[d] = fp * C[d] + iv * kd; nv[d] = fp * nv[d] + ip * kd; num += C[d] * qd; den += nv[d] * qd; }
        const float hv = num / fmaxf(fabsf(den), expf(-mn));
        const float ss = wave_sum(hv * hv); if (lane == 0) red[wave] = ss;
        __syncthreads();
        const float rstd = rsqrtf((red[0] + red[1]) * (1.0f / 128.0f) + EPS);
        const float y = hv * rstd * hn * bf2f(c.AO[t * 512 + h * 128 + tid]);
        c.AV[t * 512 + h * 128 + tid] = (bf16)f2bf(y);
    }
}

extern "C" void kernel_launch(void* const* d_in, const int* in_sizes, int n_in, void* d_out, int out_size, void* d_ws, size_t ws_size, hipStream_t stream) {
    static int grid = 0;
    if (grid == 0) {
        if (n_in != 19 || out_size != T * DM || ws_size < WS_END) { fprintf(stderr, "kernel_launch: unexpected problem: n_in %d out %d ws %zu\n", n_in, out_size, ws_size); grid = -1; return; }
        int dev = 0, cus = 0;
        (void)hipGetDevice(&dev); (void)hipDeviceGetAttribute(&cus, hipDeviceAttributeMultiprocessorCount, dev);
        bool ok = true;
#define SETLDS(k) ok = ok && (hipFuncSetAttribute((const void*)k, hipFuncAttributeMaxDynamicSharedMemorySize, LDS_BYTES) == hipSuccess)
        SETLDS(k_phase<PH_P0>); SETLDS(k_phase<PH_A2>); SETLDS(k_phase<PH_B>); SETLDS(k_phase<PH_E>); SETLDS(k_phase<PH_F>); SETLDS(k_phase<PH_F2>); SETLDS(k_phase<PH_G>); SETLDS(k_phase<PH_H>); SETLDS(k_phase<PH_H2>);
        if (!ok) { fprintf(stderr, "kernel_launch: hipFuncSetAttribute failed\n"); grid = -1; return; }
        grid = cus;
        if (grid != 256) { fprintf(stderr, "kernel_launch: built for 256 CUs, found %d\n", grid); grid = -1; return; }
    }
    if (grid < 0) return;
    Args a{};
    for (int i = 0; i < 19; ++i) a.in[i] = d_in[i];
    a.out = (float*)d_out; a.ws = (unsigned char*)d_ws;
    for (int layer = 0; layer < 2; ++layer) {
        hipLaunchKernelGGL(k_phase<PH_P0>, dim3(grid), dim3(512), LDS_BYTES, stream, a, layer);
        hipLaunchKernelGGL(k_phase<PH_A2>, dim3(grid), dim3(512), LDS_BYTES, stream, a, layer);
        hipLaunchKernelGGL(k_phase<PH_B>, dim3(grid), dim3(512), LDS_BYTES, stream, a, layer);
        hipLaunchKernelGGL(k_compress, dim3(1020), dim3(256), 0, stream, a, layer);
        hipLaunchKernelGGL(k_mla_naive, dim3(2048), dim3(256), 0, stream, a, layer);
        hipLaunchKernelGGL(k_cmp_naive, dim3(2048), dim3(256), 0, stream, a, layer);
        hipLaunchKernelGGL(k_selwin_naive, dim3(2048), dim3(256), 0, stream, a, layer);
        hipLaunchKernelGGL(k_mlstm_naive, dim3(16), dim3(128), 0, stream, a, layer);
        hipLaunchKernelGGL(k_phase<PH_E>, dim3(grid), dim3(512), LDS_BYTES, stream, a, layer);
        hipLaunchKernelGGL(k_phase<PH_F>, dim3(grid), dim3(512), LDS_BYTES, stream, a, layer);
        hipLaunchKernelGGL(k_phase<PH_F2>, dim3(grid), dim3(512), LDS_BYTES, stream, a, layer);
        hipLaunchKernelGGL(k_phase<PH_G>, dim3(grid), dim3(512), LDS_BYTES, stream, a, layer);
        hipLaunchKernelGGL(k_phase<PH_H>, dim3(grid), dim3(512), LDS_BYTES, stream, a, layer);
        hipLaunchKernelGGL(k_phase<PH_H2>, dim3(grid), dim3(512), LDS_BYTES, stream, a, layer);
    }
}
```

```cpp
#include <hip/hip_runtime.h>
#include <hip/hip_cooperative_groups.h>
#include <cstdio>
#include <cstdint>
namespace cg = cooperative_groups;

#define LAS __attribute__((address_space(3)))
typedef unsigned short bf16;
typedef short bf16x8 __attribute__((ext_vector_type(8)));
typedef float f32x4 __attribute__((ext_vector_type(4)));
typedef unsigned u32x4 __attribute__((ext_vector_type(4)));
typedef unsigned u32x2 __attribute__((ext_vector_type(2)));

constexpr int NB = 4, SEQ = 4096, T = NB * SEQ, DM = 1024, DIN = 6592, DFF = 2816;
constexpr float EPS = 1e-6f;
constexpr float LOG2E = 1.4426950408889634f;
constexpr float QSCALE_NSA = 0.125f * LOG2E;
constexpr float QSCALE_MLA = 0.10206207261596577f * LOG2E;
constexpr int NZ = 3584;

constexpr size_t MiB = 1u << 20;
constexpr size_t WS_ROPE = 1 * MiB, WS_SM = 3 * MiB, WS_SSQ = 5 * MiB, WS_SEL = 7 * MiB, WS_KCMP = 7 * MiB + 256 * 1024;
constexpr size_t WS_WIN = 9 * MiB, WS_WG = 16 * MiB, WS_WUQ = 22 * MiB, WS_WUKV = 22 * MiB + 640 * 1024, WS_WBR = 23 * MiB + 256 * 1024, WS_WOUT = 26 * MiB + 256 * 1024;
constexpr size_t WS_XB = 31 * MiB, WS_AV = 63 * MiB, WS_AO = 79 * MiB, WS_BQ = 95 * MiB, WS_BKV = 111 * MiB, WS_AQK = 135 * MiB, WS_CQKV = 151 * MiB;
constexpr size_t WS_QM = 171 * MiB, WS_KN = 195 * MiB, WS_VM = 211 * MiB, WS_KR = 227 * MiB, WS_CL = 228 * MiB;
constexpr size_t WS_P1 = 151 * MiB, WS_GT = 111 * MiB, WS_MERGED = 195 * MiB, WS_WGU = 63 * MiB, WS_WDN = 74 * MiB, WS_MIX = 95 * MiB, WS_U = 95 * MiB, WS_FD = 183 * MiB;
constexpr size_t WS_END = 247 * MiB;

constexpr int LDS_BYTES = 147456;

__device__ __forceinline__ unsigned f2bf(float f) { unsigned u = __builtin_bit_cast(unsigned, f); return (u + 0x7fffu + ((u >> 16) & 1u)) >> 16; }
__device__ __forceinline__ unsigned pk2(float lo, float hi) { return f2bf(lo) | (f2bf(hi) << 16); }
__device__ __forceinline__ float bf2f(unsigned short u) { return __builtin_bit_cast(float, (unsigned)u << 16); }
__device__ __forceinline__ float bflo(unsigned w) { return __builtin_bit_cast(float, w << 16); }
__device__ __forceinline__ float bfhi(unsigned w) { return __builtin_bit_cast(float, w & 0xffff0000u); }
__device__ __forceinline__ float wave_sum(float v) {
#pragma unroll
    for (int o = 1; o < 64; o <<= 1) v += __shfl_xor(v, o);
    return v;
}
__device__ __forceinline__ float wave_max(float v) {
#pragma unroll
    for (int o = 1; o < 64; o <<= 1) v = fmaxf(v, __shfl_xor(v, o));
    return v;
}
__device__ __forceinline__ float sigmoidf_(float x) { return 1.0f / (1.0f + __expf(-x)); }
__device__ __forceinline__ float siluf_(float x) { return x / (1.0f + __expf(-x)); }
__device__ __forceinline__ float logsigmoidf_(float x) { return x >= 0.f ? -log1pf(expf(-x)) : x - log1pf(expf(x)); }
__device__ __forceinline__ float rdlane(float v, int l) { return __builtin_bit_cast(float, __builtin_amdgcn_readlane(__builtin_bit_cast(int, v), l)); }

namespace pg8 {
constexpr int BM = 256, BK = 64, HALF = 128, HTB = HALF * BK * 2, STAGE_BYTES = 8 * HTB, NXCD = 8, WGM = 8;
__host__ __device__ __forceinline__ int lds_byte(int r, int c) { const int st = (r >> 4) * 2 + (c >> 5), rr = r & 15, cc = c & 31, ob = rr * 64 + cc * 2; return st * 1024 + (ob ^ (((ob >> 9) & 1) << 5)); }
__host__ __device__ __forceinline__ void stage_rc(int b, int& R, int& C) { const int st = b / 1024, sb = b % 1024, swz = sb ^ (((sb >> 9) & 1) << 5); R = (st >> 1) * 16 + swz / 64; C = (st & 1) * 32 + (swz % 64) / 2; }
__host__ __device__ __forceinline__ int perm32(int rho) { const int n = rho >> 4, i = rho & 15; return 8 * (i >> 2) + 4 * n + (i & 3); }

struct Unit { int pm, pn; };
struct Gemm { const bf16* A; const bf16* Bt; };

struct StaticOrder {
    int nM, nN, nwg, G, c;
    __host__ __device__ void init(int M, int N, int G_, int c_) { nM = M / BM; nN = N / BM; nwg = nM * nN; G = G_; c = c_; }
    __host__ __device__ bool next(int i, Unit& u) const {
        const long L = (long)i * G + c; if (L >= nwg) return false;
        int wgid = (int)L; { const int q = nwg / NXCD, r = nwg % NXCD, xcd = wgid % NXCD, off = wgid / NXCD; wgid = (xcd < r ? xcd * (q + 1) : r * (q + 1) + (xcd - r) * q) + off; }
        const int nig = WGM * nN, gid = wgid / nig, fm = gid * WGM, gsz = (nM - fm) < WGM ? (nM - fm) : WGM;
        u.pm = fm + ((wgid % nig) % gsz); u.pn = (wgid % nig) / gsz; return true;
    }
};

template <int GK, int LDA, int LDB, int KSTEPA, class Epi, class Sched>
__device__ __forceinline__ void gemm_phase(LAS unsigned char* lds, const Gemm g, const Sched& S, const Epi& E) {
    int tid_ = threadIdx.x; asm volatile("" : "+v"(tid_));
    const int tid = tid_, wid = __builtin_amdgcn_readfirstlane(tid >> 6), lane = tid & 63, wr = wid >> 2, wc = wid & 3, fr = lane & 15, fq = lane >> 4;
    constexpr int nt = GK / BK;
    unsigned voffA[2], voffB[2];
#pragma unroll
    for (int i = 0; i < 2; ++i) { int R, C; stage_rc(tid * 16 + i * 8192, R, C); const int Rb = Epi::PERM ? ((R & ~31) + perm32(R & 31)) : R;
        voffA[i] = (unsigned)(R * LDA + C) * 2u; voffB[i] = (unsigned)(Rb * LDB + C) * 2u; }
    constexpr size_t kstepA = (size_t)KSTEPA, kstepB = (size_t)(BK * 2);
    constexpr size_t hstepA = (size_t)HALF * LDA * 2, hstepB = (size_t)HALF * LDB * 2;
    constexpr size_t tstepA = 2 * hstepA, tstepB = 2 * hstepB;
    const unsigned ldsw = (unsigned)wid * 1024u;
    const int aoff = lds_byte(wr * 64 + fr, fq * 8), boff = lds_byte(wc * 32 + fr, fq * 8);
#define PG8_SA(b, h) (((b) * 2 + (h)) * HTB)
#define PG8_SB(b, h) ((4 + (b) * 2 + (h)) * HTB)
#define PG8_STAGE(bufoff, gbase, voff) do { _Pragma("unroll") for (int _i = 0; _i < 2; ++_i) \
        __builtin_amdgcn_global_load_lds((const unsigned*)((const char*)(gbase) + (voff)[_i]), (LAS unsigned*)(lds + (bufoff) + ldsw + _i * 8192), 16, 0, 0); } while (0)
#define PG8_LDA(dst, b, h) do { _Pragma("unroll") for (int m = 0; m < 4; ++m) _Pragma("unroll") for (int k = 0; k < 2; ++k) dst[m][k] = *(const LAS bf16x8*)(lds + PG8_SA(b, h) + aoff + m * 2048 + k * 1024); } while (0)
#define PG8_LDB(dst, b, h) do { _Pragma("unroll") for (int n = 0; n < 2; ++n) _Pragma("unroll") for (int k = 0; k < 2; ++k) dst[n][k] = *(const LAS bf16x8*)(lds + PG8_SB(b, h) + boff + n * 2048 + k * 1024); } while (0)
#define PG8_MMA(ai, bj, At, Bt) do { __builtin_amdgcn_s_setprio(1); _Pragma("unroll") for (int m = 0; m < 4; ++m) _Pragma("unroll") for (int n = 0; n < 2; ++n) _Pragma("unroll") for (int k = 0; k < 2; ++k) \
        acc[ai][bj][m][n] = __builtin_amdgcn_mfma_f32_16x16x32_bf16(Bt[n][k], At[m][k], acc[ai][bj][m][n], 0, 0, 0); __builtin_amdgcn_s_setprio(0); } while (0)
#define PG8_WAIT_V(n) asm volatile("s_waitcnt vmcnt(" #n ")" ::: "memory")
#define PG8_WAIT_L(n) asm volatile("s_waitcnt lgkmcnt(" #n ")" ::: "memory")
#define PG8_BAR __builtin_amdgcn_s_barrier()
#define PG8_SCHED __builtin_amdgcn_sched_barrier(0)
    Unit cur, nxt; int ui = 0;
    if (!S.next(0, cur)) return;
    f32x4 acc[2][2][4][2];
#pragma unroll
    for (int a = 0; a < 2; ++a)
#pragma unroll
        for (int b = 0; b < 2; ++b)
#pragma unroll
            for (int m = 0; m < 4; ++m)
#pragma unroll
                for (int n = 0; n < 2; ++n) acc[a][b][m][n] = (f32x4){0.f, 0.f, 0.f, 0.f};
    bf16x8 At[4][2], B0[2][2], B1[2][2];
    const char* cA = (const char*)g.A + (size_t)cur.pm * tstepA; const char* cB = (const char*)g.Bt + (size_t)cur.pn * tstepB;
    PG8_STAGE(PG8_SB(0, 0), cB, voffB); PG8_STAGE(PG8_SB(0, 1), cB + hstepB, voffB); PG8_STAGE(PG8_SA(0, 0), cA, voffA); PG8_STAGE(PG8_SA(0, 1), cA + hstepA, voffA);
    if (wr == 1) PG8_BAR;
    PG8_WAIT_V(2); PG8_BAR;
    PG8_STAGE(PG8_SB(1, 0), cB + kstepB, voffB); PG8_STAGE(PG8_SA(1, 0), cA + kstepA, voffA); PG8_STAGE(PG8_SB(1, 1), cB + hstepB + kstepB, voffB);
    PG8_WAIT_V(6); PG8_BAR;
    for (;;) {
        const bool has_next = S.next(ui + 1, nxt);
        const char* nA = has_next ? (const char*)g.A + (size_t)nxt.pm * tstepA : cA; const char* nB = has_next ? (const char*)g.Bt + (size_t)nxt.pn * tstepB : cB;
#pragma unroll 1
        for (int t = 0; t < nt; t += 2) {
            const bool last = (t == nt - 2);
            const char* a1 = cA + (size_t)(t + 1) * kstepA;
            const char* a2 = last ? nA : cA + (size_t)(t + 2) * kstepA; const char* b2 = last ? nB : cB + (size_t)(t + 2) * kstepB;
            const char* a3 = a2 + kstepA; const char* b3 = b2 + kstepB;
            PG8_LDB(B0, 0, 0); PG8_LDB(B1, 0, 1); PG8_SCHED; PG8_LDA(At, 0, 0); PG8_STAGE(PG8_SA(1, 1), a1 + hstepA, voffA);
            PG8_WAIT_V(8); PG8_WAIT_L(0); PG8_BAR; PG8_MMA(0, 0, At, B0); PG8_MMA(0, 1, At, B1); PG8_BAR; PG8_SCHED;
            PG8_LDA(At, 0, 1); PG8_STAGE(PG8_SB(0, 0), b2, voffB); PG8_STAGE(PG8_SB(0, 1), b2 + hstepB, voffB); PG8_STAGE(PG8_SA(0, 0), a2, voffA);
            PG8_WAIT_V(8); PG8_WAIT_L(0); PG8_BAR; PG8_MMA(1, 0, At, B0); PG8_MMA(1, 1, At, B1); PG8_BAR; PG8_SCHED;
            PG8_LDB(B0, 1, 0); PG8_LDB(B1, 1, 1); PG8_SCHED; PG8_LDA(At, 1, 0); PG8_STAGE(PG8_SA(0, 1), a2 + hstepA, voffA);
            PG8_WAIT_V(8); PG8_WAIT_L(0); PG8_BAR; PG8_MMA(0, 0, At, B0); PG8_MMA(0, 1, At, B1); PG8_BAR; PG8_SCHED;
            PG8_LDA(At, 1, 1); PG8_STAGE(PG8_SB(1, 0), b3, voffB); PG8_STAGE(PG8_SB(1, 1), b3 + hstepB, voffB); PG8_STAGE(PG8_SA(1, 0), a3, voffA);
            PG8_WAIT_V(8); PG8_WAIT_L(0); PG8_BAR; PG8_MMA(1, 0, At, B0); PG8_MMA(1, 1, At, B1); PG8_BAR; PG8_SCHED;
        }
        if (wr == 0) PG8_BAR;
        E(acc, cur, wr, wc, fr, fq);
        if (!has_next) break;
#pragma unroll
        for (int a = 0; a < 2; ++a)
#pragma unroll
            for (int b = 0; b < 2; ++b)
#pragma unroll
                for (int m = 0; m < 4; ++m)
#pragma unroll
                    for (int n = 0; n < 2; ++n) acc[a][b][m][n] = (f32x4){0.f, 0.f, 0.f, 0.f};
        cur = nxt; cA = nA; cB = nB; ++ui;
        if (wr == 1) PG8_BAR;
    }
    PG8_WAIT_V(0);
    PG8_BAR;
#undef PG8_SA
#undef PG8_SB
#undef PG8_STAGE
#undef PG8_LDA
#undef PG8_LDB
#undef PG8_MMA
#undef PG8_WAIT_V
#undef PG8_WAIT_L
#undef PG8_BAR
#undef PG8_SCHED
}
}
using pg8::Unit;
typedef const f32x4 (&AccRef)[2][2][4][2];

__device__ __forceinline__ u32x4 pack8(const f32x4 a, const f32x4 b) { u32x4 w; w.x = pk2(a[0], a[1]); w.y = pk2(a[2], a[3]); w.z = pk2(b[0], b[1]); w.w = pk2(b[2], b[3]); return w; }

struct EpiInProj {
    static constexpr bool PERM = true;
    bf16 *AQK, *AV, *AO, *BQ, *BKV, *CQKV, *KR; float *SM, *SSQ; const float* ROPE; const float* gbias;
    __device__ __forceinline__ void operator()(AccRef acc, const Unit& u, int wr, int wc, int fr, int fq) const {
        const int pn = u.pn;
#pragma unroll
        for (int ai = 0; ai < 2; ++ai)
#pragma unroll
            for (int m = 0; m < 4; ++m) {
                const int row = u.pm * 256 + ai * 128 + wr * 64 + m * 16 + fr;
#pragma unroll
                for (int bj = 0; bj < 2; ++bj) {
                    f32x4 v0 = acc[ai][bj][m][0], v1 = acc[ai][bj][m][1];
                    const int cg = bj * 128 + wc * 32;
                    const int c0 = cg + 8 * fq;
                    if (pn < 8) {
                        const int region = pn >> 1; const int col = (pn & 1) * 256 + c0;
                        bf16* base = region == 0 ? AQK : region == 1 ? AV : region == 2 ? AO : BQ;
                        if (region == 2) {
#pragma unroll
                            for (int e = 0; e < 4; ++e) { v0[e] = sigmoidf_(v0[e]); v1[e] = sigmoidf_(v1[e]); }
                        }
                        *(u32x4*)(base + (size_t)row * 512 + col) = pack8(v0, v1);
                    } else if (pn < 11) {
                        const int cc = (pn - 8) * 256 + c0; const int i = cc >> 7, gg = (cc >> 6) & 1, d = cc & 63; const int b = row >> 12, s = row & 4095;
                        *(u32x4*)(BKV + ((size_t)(((i * NB + b) * 2 + gg) * SEQ + s)) * 64 + d) = pack8(v0, v1);
                    } else {
                        const int gb = (pn - 11) * 256 + cg;
                        if (gb < 640) {
                            *(u32x4*)(CQKV + (size_t)row * 640 + gb + 8 * fq) = pack8(v0, v1);
                            float ss = 0.f;
#pragma unroll
                            for (int e = 0; e < 4; ++e) ss += v0[e] * v0[e] + v1[e] * v1[e];
                            ss += __shfl_xor(ss, 16); ss += __shfl_xor(ss, 32);
                            if (fq == 0) SSQ[(size_t)row * 24 + (gb >> 5)] = ss;
                        } else if (gb == 640) {
                            float o[8];
#pragma unroll
                            for (int e = 0; e < 8; ++e) {
                                const float v = e < 4 ? v0[e] : v1[e - 4]; const float p = __shfl_xor(v, 32);
                                const int i = (8 * fq + e) & 15; const float cs = ROPE[((size_t)row * 16 + i) * 2], sn = ROPE[((size_t)row * 16 + i) * 2 + 1];
                                o[e] = fq < 2 ? v * cs - p * sn : p * sn + v * cs;
                            }
                            u32x4 w; w.x = pk2(o[0], o[1]); w.y = pk2(o[2], o[3]); w.z = pk2(o[4], o[5]); w.w = pk2(o[6], o[7]);
                            *(u32x4*)(KR + (size_t)row * 32 + 8 * fq) = w;
                        } else if (gb == 672) {
                            float o[8];
#pragma unroll
                            for (int e = 0; e < 8; ++e) {
                                const float v = e < 4 ? v0[e] : v1[e - 4];
                                if (fq == 0) { const float x = v + gbias[e]; o[e] = e < 4 ? x : logsigmoidf_(x); }
                                else o[e] = sigmoidf_(v);
                            }
                            float* dst = SM + (size_t)row * 32 + 8 * fq;
                            *(f32x4*)dst = (f32x4){o[0], o[1], o[2], o[3]}; *(f32x4*)(dst + 4) = (f32x4){o[4], o[5], o[6], o[7]};
                        }
                    }
                }
                asm volatile("" ::: "memory");
            }
    }
};

struct EpiMlaQ {
    static constexpr bool PERM = true;
    bf16* QM; const float* SSQ; const float* ROPE;
    __device__ __forceinline__ void operator()(AccRef acc, const Unit& u, int wr, int wc, int fr, int fq) const {
#pragma unroll
        for (int ai = 0; ai < 2; ++ai)
#pragma unroll
            for (int m = 0; m < 4; ++m) {
                const int row = u.pm * 256 + ai * 128 + wr * 64 + m * 16 + fr;
                const f32x4* sp = (const f32x4*)(SSQ + (size_t)row * 24);
                const f32x4 s0 = sp[0], s1 = sp[1], s2 = sp[2];
                const float ss = (s0[0] + s0[1] + s0[2] + s0[3]) + (s1[0] + s1[1] + s1[2] + s1[3]) + (s2[0] + s2[1] + s2[2] + s2[3]);
                const float rstd = rsqrtf(ss * (1.0f / 384.0f) + EPS);
#pragma unroll
                for (int bj = 0; bj < 2; ++bj) {
                    const int cgi = u.pn * 8 + bj * 4 + wc;
                    f32x4 v0 = acc[ai][bj][m][0] * rstd, v1 = acc[ai][bj][m][1] * rstd;
                    if (cgi % 3 == 2) {
                        float o[8];
#pragma unroll
                        for (int e = 0; e < 8; ++e) {
                            const float v = e < 4 ? v0[e] : v1[e - 4]; const float p = __shfl_xor(v, 32);
                            const int i = (8 * fq + e) & 15; const float cs = ROPE[((size_t)row * 16 + i) * 2], sn = ROPE[((size_t)row * 16 + i) * 2 + 1];
                            o[e] = fq < 2 ? v * cs - p * sn : p * sn + v * cs;
                        }
                        v0 = (f32x4){o[0], o[1], o[2], o[3]}; v1 = (f32x4){o[4], o[5], o[6], o[7]};
                    }
                    *(u32x4*)(QM + (size_t)row * 768 + cgi * 32 + 8 * fq) = pack8(v0, v1);
                }
                asm volatile("" ::: "memory");
            }
    }
};
struct EpiMlaKV {
    static constexpr bool PERM = true;
    bf16 *KN, *VM; const float* SSQ;
    __device__ __forceinline__ void operator()(AccRef acc, const Unit& u, int wr, int wc, int fr, int fq) const {
#pragma unroll
        for (int ai = 0; ai < 2; ++ai)
#pragma unroll
            for (int m = 0; m < 4; ++m) {
                const int row = u.pm * 256 + ai * 128 + wr * 64 + m * 16 + fr;
                const f32x4* sp = (const f32x4*)(SSQ + (size_t)row * 24 + 12);
                const f32x4 s0 = sp[0], s1 = sp[1];
                const float ss = (s0[0] + s0[1] + s0[2] + s0[3]) + (s1[0] + s1[1] + s1[2] + s1[3]);
                const float rstd = rsqrtf(ss * (1.0f / 256.0f) + EPS);
                const int b = row >> 12, s = row & 4095;
#pragma unroll
                for (int bj = 0; bj < 2; ++bj) {
                    const int h = u.pn * 2 + bj; const int j = wc * 32 + 8 * fq;
                    const f32x4 v0 = acc[ai][bj][m][0] * rstd, v1 = acc[ai][bj][m][1] * rstd;
                    bf16* dst = (j < 64 ? KN : VM) + ((size_t)((b * 8 + h) * SEQ + s)) * 64 + (j & 63);
                    *(u32x4*)dst = pack8(v0, v1);
                }
                asm volatile("" ::: "memory");
            }
    }
};
struct EpiGate {
    static constexpr bool PERM = true;
    bf16* GT;
    __device__ __forceinline__ void operator()(AccRef acc, const Unit& u, int wr, int wc, int fr, int fq) const {
        int tid = threadIdx.x; asm volatile("" : "+v"(tid));
#pragma unroll
        for (int ai = 0; ai < 2; ++ai)
#pragma unroll
            for (int bj = 0; bj < 2; ++bj)
#pragma unroll
                for (int m = 0; m < 4; ++m) {
                    f32x4 v0 = acc[ai][bj][m][0], v1 = acc[ai][bj][m][1];
#pragma unroll
                    for (int e = 0; e < 4; ++e) { v0[e] = sigmoidf_(v0[e]); v1[e] = sigmoidf_(v1[e]); }
                    const int q = (ai * 2 + bj) * 4 + m;
                    *(u32x4*)(GT + ((size_t)q * 512 + tid) * 8) = pack8(v0, v1);
                    asm volatile("" ::: "memory");
                }
    }
};
struct EpiBranch {
    static constexpr bool PERM = true;
    const bf16* GT; bf16* MG; int first;
    __device__ __forceinline__ void operator()(AccRef acc, const Unit& u, int wr, int wc, int fr, int fq) const {
        int tid = threadIdx.x; asm volatile("" : "+v"(tid));
#pragma unroll
        for (int ai = 0; ai < 2; ++ai)
#pragma unroll
            for (int m = 0; m < 4; ++m) {
                const int row = u.pm * 256 + ai * 128 + wr * 64 + m * 16 + fr;
#pragma unroll
                for (int bj = 0; bj < 2; ++bj) {
                    const int col = u.pn * 256 + bj * 128 + wc * 32 + 8 * fq;
                    const int q = (ai * 2 + bj) * 4 + m;
                    const u32x4 gw = *(const u32x4*)(GT + ((size_t)q * 512 + tid) * 8);
                    f32x4 v0 = acc[ai][bj][m][0], v1 = acc[ai][bj][m][1];
                    v0[0] *= bflo(gw.x); v0[1] *= bfhi(gw.x); v0[2] *= bflo(gw.y); v0[3] *= bfhi(gw.y);
                    v1[0] *= bflo(gw.z); v1[1] *= bfhi(gw.z); v1[2] *= bflo(gw.w); v1[3] *= bfhi(gw.w);
                    bf16* dst = MG + (size_t)row * 1024 + col;
                    if (!first) {
                        const u32x4 ow = *(const u32x4*)dst;
                        v0[0] += bflo(ow.x); v0[1] += bfhi(ow.x); v0[2] += bflo(ow.y); v0[3] += bfhi(ow.y);
                        v1[0] += bflo(ow.z); v1[1] += bfhi(ow.z); v1[2] += bflo(ow.w); v1[3] += bfhi(ow.w);
                    }
                    *(u32x4*)dst = pack8(v0, v1);
                }
                asm volatile("" ::: "memory");
            }
    }
};
struct EpiF32 {
    static constexpr bool PERM = false;
    float* C; int ldc;
    __device__ __forceinline__ void operator()(AccRef acc, const Unit& u, int wr, int wc, int fr, int fq) const {
        const int row0 = u.pm * 256 + wr * 64 + fr, col0 = u.pn * 256 + wc * 32 + 4 * fq;
#pragma unroll
        for (int ai = 0; ai < 2; ++ai)
#pragma unroll
            for (int m = 0; m < 4; ++m) { float* rowp = C + (size_t)(row0 + ai * 128 + m * 16) * ldc + col0;
#pragma unroll
                for (int bj = 0; bj < 2; ++bj)
#pragma unroll
                    for (int n = 0; n < 2; ++n) *(f32x4*)(rowp + bj * 128 + n * 16) = acc[ai][bj][m][n]; }
    }
};
struct EpiSwiGLU {
    static constexpr bool PERM = true;
    bf16* U;
    __device__ __forceinline__ void operator()(AccRef acc, const Unit& u, int wr, int wc, int fr, int fq) const {
#pragma unroll
        for (int ai = 0; ai < 2; ++ai)
#pragma unroll
            for (int m = 0; m < 4; ++m) {
                const int row = u.pm * 256 + ai * 128 + wr * 64 + m * 16 + fr;
                f32x4 g0 = acc[ai][0][m][0], g1 = acc[ai][0][m][1]; const f32x4 u0 = acc[ai][1][m][0], u1 = acc[ai][1][m][1];
#pragma unroll
                for (int e = 0; e < 4; ++e) { g0[e] = siluf_(g0[e]) * u0[e]; g1[e] = siluf_(g1[e]) * u1[e]; }
                *(u32x4*)(U + (size_t)row * DFF + u.pn * 128 + wc * 32 + 8 * fq) = pack8(g0, g1);
                asm volatile("" ::: "memory");
            }
    }
};

struct ColSrc { const float* p; float cs; };
template <class Map>
__device__ __forceinline__ void tr_item(const Map& mp, int ldw, const float* kscale, bf16* WT, int ldt, int nblk, int item, LAS float* scr, int lane) {
    const int kb = item / nblk, nb = item % nblk, k0 = 64 * kb, n0 = 32 * nb;
    const ColSrc cs = mp(n0 + (lane & 31));
#pragma unroll 8
    for (int i = 0; i < 32; ++i) { const int kk = 2 * i + (lane >> 5); const int k = k0 + kk;
        float v = 0.f; if (cs.p) { v = cs.p[(size_t)k * ldw] * cs.cs; if (kscale) v *= kscale[k]; }
        scr[kk * 33 + (lane & 31)] = v; }
    asm volatile("s_waitcnt lgkmcnt(0)" ::: "memory");
    const int c = lane & 7;
#pragma unroll
    for (int j = 0; j < 4; ++j) { const int n = (lane >> 3) + 8 * j; const LAS float* s = scr + (8 * c) * 33 + n;
        u32x4 o; o.x = pk2(s[0 * 33], s[1 * 33]); o.y = pk2(s[2 * 33], s[3 * 33]); o.z = pk2(s[4 * 33], s[5 * 33]); o.w = pk2(s[6 * 33], s[7 * 33]);
        *(u32x4*)(WT + (size_t)(n0 + n) * ldt + k0 + 8 * c) = o; }
    asm volatile("s_waitcnt lgkmcnt(0)" ::: "memory");
}
struct MapIn {
    const float* W;
    __device__ __forceinline__ ColSrc operator()(int n) const {
        int src; float cs = 1.f;
        if (n < 1536) src = n;
        else if (n < 2048) { src = 1544 + (n - 1536); cs = QSCALE_NSA; }
        else if (n < 2816) src = 2056 + (n - 2048);
        else if (n < 3200) src = 2848 + (n - 2816);
        else if (n < 3488) src = 3232 + (n - 3200);
        else if (n < 3496) src = 1536 + (n - 3488);
        else if (n < 3520) src = 2824 + (n - 3496);
        else src = -1;
        ColSrc r; r.p = src >= 0 ? W + src : nullptr; r.cs = cs; return r;
    }
};
struct MapPlain { const float* W; int off; float cs; __device__ __forceinline__ ColSrc operator()(int n) const { ColSrc r; r.p = W + off + n; r.cs = cs; return r; } };
struct MapGU { const float* Wg; const float* Wu; __device__ __forceinline__ ColSrc operator()(int n) const { const int j = n >> 8, w = n & 255; ColSrc r; r.p = (w < 128 ? Wg : Wu) + 128 * j + (w & 127); r.cs = 1.f; return r; } };

__device__ __forceinline__ void row_resnorm(const float* xin, const float* delta, const float* gain, float* xout, bf16* xb, int lane) {
    f32x4 v[4];
#pragma unroll
    for (int j = 0; j < 4; ++j) v[j] = ((const f32x4*)xin)[lane + 64 * j];
    if (delta) {
        f32x4 d[4]; float s = 0.f;
#pragma unroll
        for (int j = 0; j < 4; ++j) { d[j] = ((const f32x4*)delta)[lane + 64 * j]; s += (d[j][0] * d[j][0] + d[j][1] * d[j][1]) + (d[j][2] * d[j][2] + d[j][3] * d[j][3]); }
        const float rstd = rsqrtf(wave_sum(s) * (1.0f / DM) + EPS);
#pragma unroll
        for (int j = 0; j < 4; ++j) { const f32x4 g = ((const f32x4*)gain)[lane + 64 * j]; v[j] = v[j] + g * d[j] * rstd; }
    }
    if (xout) {
#pragma unroll
        for (int j = 0; j < 4; ++j) ((f32x4*)xout)[lane + 64 * j] = v[j];
    }
    float s2 = 0.f;
#pragma unroll
    for (int j = 0; j < 4; ++j) s2 += (v[j][0] * v[j][0] + v[j][1] * v[j][1]) + (v[j][2] * v[j][2] + v[j][3] * v[j][3]);
    const float r2 = rsqrtf(wave_sum(s2) * (1.0f / DM) + EPS);
#pragma unroll
    for (int j = 0; j < 4; ++j) { u32x2 w; w.x = pk2(v[j][0] * r2, v[j][1] * r2); w.y = pk2(v[j][2] * r2, v[j][3] * r2); ((u32x2*)xb)[lane + 64 * j] = w; }
}

template <int NH, bool EXT>
__device__ __forceinline__ void nattn_block(const float* qs, const bf16* Kb, int ldk, const bf16* K2b, int ldk2, const bf16* Vb, int ldv,
                                            const bool (&valid)[NH], float (&m)[NH], float (&l)[NH], float (&o)[NH], int lane) {
    constexpr int QD = EXT ? 96 : 64;
    float s[NH];
#pragma unroll
    for (int h = 0; h < NH; ++h) s[h] = 0.f;
    const u32x4* kp = (const u32x4*)(Kb + (size_t)lane * ldk);
#pragma unroll
    for (int c = 0; c < 8; ++c) {
        asm volatile("" ::: "memory");
        const u32x4 kk = kp[c];
        const float kf[8] = {bflo(kk.x), bfhi(kk.x), bflo(kk.y), bfhi(kk.y), bflo(kk.z), bfhi(kk.z), bflo(kk.w), bfhi(kk.w)};
#pragma unroll
        for (int h = 0; h < NH; ++h)
#pragma unroll
            for (int e = 0; e < 8; ++e) s[h] += qs[h * QD + 8 * c + e] * kf[e];
    }
    if (EXT) {
        const u32x4* k2 = (const u32x4*)(K2b + (size_t)lane * ldk2);
#pragma unroll
        for (int c = 0; c < 4; ++c) {
            asm volatile("" ::: "memory");
            const u32x4 kk = k2[c];
            const float kf[8] = {bflo(kk.x), bfhi(kk.x), bflo(kk.y), bfhi(kk.y), bflo(kk.z), bfhi(kk.z), bflo(kk.w), bfhi(kk.w)};
#pragma unroll
            for (int h = 0; h < NH; ++h)
#pragma unroll
                for (int e = 0; e < 8; ++e) s[h] += qs[h * QD + 64 + 8 * c + e] * kf[e];
        }
    }
    float p[NH];
#pragma unroll
    for (int h = 0; h < NH; ++h) {
        const float sv = valid[h] ? s[h] : -INFINITY;
        const float bm = wave_max(sv);
        const float mn = fmaxf(m[h], bm);
        if (mn == -INFINITY) { p[h] = 0.f; continue; }
        const float alpha = exp2f(m[h] - mn);
        p[h] = valid[h] ? exp2f(s[h] - mn) : 0.f;
        l[h] = l[h] * alpha + wave_sum(p[h]); o[h] *= alpha; m[h] = mn;
    }
#pragma unroll 8
    for (int key = 0; key < 64; ++key) {
        const float vv = bf2f(Vb[(size_t)key * ldv + lane]);
#pragma unroll
        for (int h = 0; h < NH; ++h) o[h] += rdlane(p[h], key) * vv;
    }
}

struct Args { const void* in[19]; float* out; unsigned char* ws; };

struct Ctx {
    const float *x_in; const int* positions; float* XS;
    float *ROPE, *SM, *SSQ; unsigned long long* SEL; float* KCMP;
    bf16 *W_IN, *W_G, *W_UQ, *W_UKV, *W_BR, *W_OUT, *W_GU, *W_DN;
    bf16 *XB, *AV, *AO, *BQ, *BKV, *AQK, *CQKV, *QM, *KN, *VM, *KR, *P1, *GTall, *MERGED, *U; float *MIX, *FD;
    const float *gains, *w_in, *m_conv, *m_gbias, *m_hnorm, *cmp_pos, *cmp_w1, *cmp_w2, *q_norm, *kv_norm, *w_uq, *w_ukv, *w_branch, *w_out, *w_fg, *w_fu, *w_fd;
};
__device__ __forceinline__ Ctx make_ctx(const Args& args, int layer) {
    Ctx c; unsigned char* ws = args.ws;
    c.x_in = (const float*)args.in[0]; c.positions = (const int*)args.in[1]; c.XS = args.out;
    c.ROPE = (float*)(ws + WS_ROPE); c.SM = (float*)(ws + WS_SM); c.SSQ = (float*)(ws + WS_SSQ); c.SEL = (unsigned long long*)(ws + WS_SEL); c.KCMP = (float*)(ws + WS_KCMP);
    c.W_IN = (bf16*)(ws + WS_WIN); c.W_G = (bf16*)(ws + WS_WG); c.W_UQ = (bf16*)(ws + WS_WUQ); c.W_UKV = (bf16*)(ws + WS_WUKV);
    c.W_BR = (bf16*)(ws + WS_WBR); c.W_OUT = (bf16*)(ws + WS_WOUT); c.W_GU = (bf16*)(ws + WS_WGU); c.W_DN = (bf16*)(ws + WS_WDN);
    c.XB = (bf16*)(ws + WS_XB); c.AV = (bf16*)(ws + WS_AV); c.AO = (bf16*)(ws + WS_AO); c.BQ = (bf16*)(ws + WS_BQ); c.BKV = (bf16*)(ws + WS_BKV);
    c.AQK = (bf16*)(ws + WS_AQK); c.CQKV = (bf16*)(ws + WS_CQKV); c.QM = (bf16*)(ws + WS_QM); c.KN = (bf16*)(ws + WS_KN); c.VM = (bf16*)(ws + WS_VM);
    c.KR = (bf16*)(ws + WS_KR); c.P1 = (bf16*)(ws + WS_P1); c.GTall = (bf16*)(ws + WS_GT); c.MERGED = (bf16*)(ws + WS_MERGED);
    c.MIX = (float*)(ws + WS_MIX); c.U = (bf16*)(ws + WS_U); c.FD = (float*)(ws + WS_FD);
    c.gains = (const float*)args.in[2] + (size_t)layer * 4 * DM;
    c.w_in = (const float*)args.in[3] + (size_t)layer * DM * DIN;
    c.m_conv = (const float*)args.in[4] + (size_t)layer * 4 * 512;
    c.m_gbias = (const float*)args.in[5] + layer * 8;
    c.m_hnorm = (const float*)args.in[6] + layer * 512;
    c.cmp_pos = (const float*)args.in[7] + (size_t)layer * 2 * 2048;
    c.cmp_w1 = (const float*)args.in[8] + (size_t)layer * 2 * 2048 * 128;
    c.cmp_w2 = (const float*)args.in[9] + (size_t)layer * 2 * 128 * 64;
    c.q_norm = (const float*)args.in[10] + layer * 384;
    c.kv_norm = (const float*)args.in[11] + layer * 256;
    c.w_uq = (const float*)args.in[12] + (size_t)layer * 384 * 768;
    c.w_ukv = (const float*)args.in[13] + (size_t)layer * 256 * 1024;
    c.w_branch = (const float*)args.in[14] + (size_t)layer * 3 * 512 * 1024;
    c.w_out = (const float*)args.in[15] + (size_t)layer * DM * DM;
    c.w_fg = (const float*)args.in[16] + (size_t)layer * DM * DFF;
    c.w_fu = (const float*)args.in[17] + (size_t)layer * DM * DFF;
    c.w_fd = (const float*)args.in[18] + (size_t)layer * DFF * DM;
    return c;
}

#define PHASE_IDS int tid_o = threadIdx.x; asm volatile("" : "+v"(tid_o)); const int tid = tid_o, lane = tid & 63, wave = __builtin_amdgcn_readfirstlane(tid >> 6), gw = blk * 8 + wave; \
    LAS float* wscr = (LAS float*)(lds + wave * 16384); (void)wscr; (void)gw; (void)lane; (void)tid

enum { PH_P0 = 0, PH_A2, PH_B, PH_E, PH_F, PH_F2, PH_G, PH_H, PH_H2 };

template <int PH>
__device__ __forceinline__ void run_phase(const Args& args, int layer, unsigned char* lds_raw) {
    LAS unsigned char* lds = (LAS unsigned char*)lds_raw;
    const int G = gridDim.x, blk = blockIdx.x, NGW = G * 8;
    const Ctx c = make_ctx(args, layer);
    if constexpr (PH == PH_P0) {
        PHASE_IDS;
        constexpr int I_IN = (DM / 64) * (NZ / 32), I_G = (DM / 64) * (3072 / 32), I_UQ = (384 / 64) * (768 / 32), I_UKV = (256 / 64) * (1024 / 32);
        constexpr int I_BR = (512 / 64) * (1024 / 32), I_OUT = (DM / 64) * (DM / 32);
        constexpr int NIT = I_IN + I_G + I_UQ + I_UKV + 3 * I_BR + I_OUT;
#pragma unroll 1
        for (int it = gw; it < NIT; it += NGW) {
            int r = it;
            if (r < I_IN) { tr_item(MapIn{c.w_in}, DIN, c.gains, c.W_IN, DM, NZ / 32, r, wscr, lane); continue; } r -= I_IN;
            if (r < I_G) { tr_item(MapPlain{c.w_in, 3520, 1.f}, DIN, c.gains, c.W_G, DM, 3072 / 32, r, wscr, lane); continue; } r -= I_G;
            if (r < I_UQ) { tr_item(MapPlain{c.w_uq, 0, QSCALE_MLA}, 768, c.q_norm, c.W_UQ, 384, 768 / 32, r, wscr, lane); continue; } r -= I_UQ;
            if (r < I_UKV) { tr_item(MapPlain{c.w_ukv, 0, 1.f}, 1024, c.kv_norm, c.W_UKV, 256, 1024 / 32, r, wscr, lane); continue; } r -= I_UKV;
            if (r < 3 * I_BR) { const int br = r / I_BR; tr_item(MapPlain{c.w_branch + (size_t)br * 512 * 1024, 0, 1.f}, 1024, nullptr, c.W_BR + (size_t)br * 1024 * 512, 512, 1024 / 32, r % I_BR, wscr, lane); continue; } r -= 3 * I_BR;
            tr_item(MapPlain{c.w_out, 0, 1.f}, DM, nullptr, c.W_OUT, DM, DM / 32, r, wscr, lane);
        }
        if (layer == 0) {
#pragma unroll 1
            for (int i = blk * 512 + tid; i < T * 16; i += G * 512) {
                const int t = i >> 4, d = i & 15;
                const double f4 = (d & 3) == 0 ? 1.0 : (d & 3) == 1 ? 0.5623413251903491 : (d & 3) == 2 ? 0.31622776601683794 : 0.1778279410038923;
                const double f1 = (d >> 2) == 0 ? 1.0 : (d >> 2) == 1 ? 0.1 : (d >> 2) == 2 ? 0.01 : 0.001;
                const double ang = (double)c.positions[t] * (f4 * f1);
                const double q = rint(ang * 0.6366197723675814);
                const double y = fma(-q, 6.123233995736766e-17, fma(-q, 1.5707963267948966, ang));
                const double y2 = y * y;
                const double sy = y * (1.0 + y2 * (-1.0 / 6 + y2 * (1.0 / 120 + y2 * (-1.0 / 5040 + y2 * (1.0 / 362880 + y2 * (-1.0 / 39916800))))));
                const double cy = 1.0 + y2 * (-0.5 + y2 * (1.0 / 24 + y2 * (-1.0 / 720 + y2 * (1.0 / 40320 + y2 * (-1.0 / 3628800 + y2 * (1.0 / 479001600))))));
                const int qi = (int)q & 3;
                const double cs = qi == 0 ? cy : qi == 1 ? -sy : qi == 2 ? -cy : sy;
                const double sn = qi == 0 ? sy : qi == 1 ? cy : qi == 2 ? -sy : -cy;
                c.ROPE[2 * (size_t)i] = (float)cs; c.ROPE[2 * (size_t)i + 1] = (float)sn;
            }
#pragma unroll 1
            for (int m = gw; m < T; m += NGW) row_resnorm(c.x_in + (size_t)m * DM, nullptr, nullptr, nullptr, c.XB + (size_t)m * DM, lane);
        }
    }
    if constexpr (PH == PH_A2) {
        pg8::Gemm g{c.XB, c.W_IN}; pg8::StaticOrder S; S.init(T, NZ, G, blk);
        EpiInProj E{c.AQK, c.AV, c.AO, c.BQ, c.BKV, c.CQKV, c.KR, c.SM, c.SSQ, c.ROPE, c.m_gbias};
        pg8::gemm_phase<DM, DM, DM, 128>(lds, g, S, E);
    }
    if constexpr (PH == PH_B) {
        { pg8::Gemm g{c.CQKV, c.W_UQ}; pg8::StaticOrder S; S.init(T, 768, G, blk); EpiMlaQ E{c.QM, c.SSQ, c.ROPE}; pg8::gemm_phase<384, 640, 384, 128>(lds, g, S, E); }
        { pg8::Gemm g{c.CQKV + 384, c.W_UKV}; pg8::StaticOrder S; S.init(T, 1024, G, blk); EpiMlaKV E{c.KN, c.VM, c.SSQ}; pg8::gemm_phase<256, 640, 256, 128>(lds, g, S, E); }
    }
    if constexpr (PH == PH_E) {
        pg8::StaticOrder S; S.init(T, DM, G, blk);
        bf16* GT = c.GTall + (size_t)blk * 65536;
        { pg8::Gemm g{c.XB, c.W_G}; EpiGate E{GT}; pg8::gemm_phase<DM, DM, DM, 128>(lds, g, S, E); }
        { pg8::Gemm g{c.AV, c.W_BR}; EpiBranch E{GT, c.MERGED, 1}; pg8::gemm_phase<512, 512, 512, 128>(lds, g, S, E); }
        { pg8::Gemm g{c.XB, c.W_G + (size_t)1024 * 1024}; EpiGate E{GT}; pg8::gemm_phase<DM, DM, DM, 128>(lds, g, S, E); }
        { pg8::Gemm g{c.BQ, c.W_BR + (size_t)1024 * 512}; EpiBranch E{GT, c.MERGED, 0}; pg8::gemm_phase<512, 512, 512, 128>(lds, g, S, E); }
        { pg8::Gemm g{c.XB, c.W_G + (size_t)2 * 1024 * 1024}; EpiGate E{GT}; pg8::gemm_phase<DM, DM, DM, 128>(lds, g, S, E); }
        { pg8::Gemm g{c.QM, c.W_BR + (size_t)2 * 1024 * 512}; EpiBranch E{GT, c.MERGED, 0}; pg8::gemm_phase<512, 768, 512, 192>(lds, g, S, E); }
    }
    if constexpr (PH == PH_F) {
        {
            PHASE_IDS;
            constexpr int I_GU = (DM / 64) * (2 * DFF / 32), I_DN = (DFF / 64) * (DM / 32);
#pragma unroll 1
            for (int it = gw; it < I_GU + I_DN; it += NGW) {
                if (it < I_GU) {
                    const int n0 = 32 * (it % (2 * DFF / 32)), j = n0 >> 8, w = n0 & 255;
                    if (w < 128) tr_item(MapPlain{c.w_fg, 128 * j + w - n0, 1.f}, DFF, c.gains + 2 * DM, c.W_GU, DM, 2 * DFF / 32, it, wscr, lane);
                    else tr_item(MapPlain{c.w_fu, 128 * j + (w - 128) - n0, 1.f}, DFF, c.gains + 2 * DM, c.W_GU, DM, 2 * DFF / 32, it, wscr, lane);
                }
                else tr_item(MapPlain{c.w_fd, 0, 1.f}, DM, nullptr, c.W_DN, DFF, DM / 32, it - I_GU, wscr, lane);
            }
        }
        __syncthreads();
        pg8::Gemm g{c.MERGED, c.W_OUT}; pg8::StaticOrder S; S.init(T, DM, G, blk); EpiF32 E{c.MIX, DM};
        pg8::gemm_phase<DM, DM, DM, 128>(lds, g, S, E);
    }
    if constexpr (PH == PH_F2) {
        PHASE_IDS;
#pragma unroll 1
        for (int m = gw; m < T; m += NGW) row_resnorm((layer == 0 ? c.x_in : c.XS) + (size_t)m * DM, c.MIX + (size_t)m * DM, c.gains + DM, c.XS + (size_t)m * DM, c.XB + (size_t)m * DM, lane);
    }
    if constexpr (PH == PH_G) {
        pg8::Gemm g{c.XB, c.W_GU}; pg8::StaticOrder S; S.init(T, 2 * DFF, G, blk); EpiSwiGLU E{c.U};
        pg8::gemm_phase<DM, DM, DM, 128>(lds, g, S, E);
    }
    if constexpr (PH == PH_H) {
        pg8::Gemm g{c.U, c.W_DN}; pg8::StaticOrder S; S.init(T, DM, G, blk); EpiF32 E{c.FD, DM};
        pg8::gemm_phase<DFF, DFF, DFF, 128>(lds, g, S, E);
    }
    if constexpr (PH == PH_H2) {
        PHASE_IDS;
#pragma unroll 1
        for (int m = gw; m < T; m += NGW) row_resnorm(c.XS + (size_t)m * DM, c.FD + (size_t)m * DM, c.gains + 3 * DM, c.XS + (size_t)m * DM, c.XB + (size_t)m * DM, lane);
    }
}
template <int PH>
__global__ void __launch_bounds__(512, 2) k_phase(Args args, int layer) {
    extern __shared__ __attribute__((aligned(16))) unsigned char lds_raw[];
    run_phase<PH>(args, layer, lds_raw);
}

namespace att {
typedef float f32x16 __attribute__((ext_vector_type(16)));
typedef short s16x4 __attribute__((ext_vector_type(4)));
constexpr int VST = 192;
__device__ __forceinline__ int crow(int r, int hi) { return (r & 3) + 8 * (r >> 2) + 4 * hi; }
__device__ __forceinline__ s16x4 vtr(const LAS unsigned char* p) { return __builtin_bit_cast(s16x4, __builtin_amdgcn_ds_read_tr16_b64_v4i16((LAS s16x4*)p)); }
__device__ __forceinline__ bf16x8 pack8f(const f32x16& p, int b) {
    u32x4 w; w.x = pk2(p[b], p[b + 1]); w.y = pk2(p[b + 2], p[b + 3]); w.z = pk2(p[b + 4], p[b + 5]); w.w = pk2(p[b + 6], p[b + 7]);
    return __builtin_bit_cast(bf16x8, w);
}
struct Pass {
    f32x16 o[2]; float l;
};
template <int DQK, int MODE>
__device__ __forceinline__ Pass attn_pass(LAS unsigned char* lds, const bf16x8* qf, const bf16* K1, int ld1, const bf16* K2, int ld2, const bf16* V, int ldv,
                                          unsigned long long tmask, int qpos, unsigned long long sel, int q0) {
    constexpr int KST = DQK == 96 ? 208 : 144;
    constexpr int KBYTES = 64 * KST, VBYTES = 64 * VST, BUF = KBYTES + VBYTES;
    int tid_o = threadIdx.x; asm volatile("" : "+v"(tid_o));
    const int tid = tid_o, lane = tid & 63, hi = lane >> 5, r32 = lane & 31;
    Pass R; R.o[0] = f32x16{}; R.o[1] = f32x16{}; float m = -INFINITY, l = 0.f;
    const int skey = tid >> 3, sch = tid & 7;
    u32x4 kreg, vreg, k2reg;
    unsigned mlo = (unsigned)tmask, mhi = (unsigned)(tmask >> 32);
    auto next_tile = [&]() -> int {
        int j;
        if (mlo) { j = __builtin_ctz(mlo); mlo &= mlo - 1; } else if (mhi) { j = 32 + __builtin_ctz(mhi); mhi &= mhi - 1; } else j = -1;
        return j;
    };
    int jcur = next_tile();
    if (jcur < 0) { R.l = 0.f; return R; }
    auto gload = [&](int j) {
        kreg = *(const u32x4*)(K1 + (size_t)(j * 64 + skey) * ld1 + sch * 8);
        vreg = *(const u32x4*)(V + (size_t)(j * 64 + skey) * ldv + sch * 8);
        if (DQK == 96) { if (tid < 256) k2reg = *(const u32x4*)(K2 + (size_t)(j * 64 + (tid >> 2)) * ld2 + (tid & 3) * 8); }
    };
    auto lstore = [&](int buf) {
        LAS unsigned char* kb = lds + buf * BUF; LAS unsigned char* vb = kb + KBYTES;
        *(LAS u32x4*)(kb + skey * KST + sch * 16) = kreg;
        *(LAS u32x4*)(vb + skey * VST + sch * 16) = vreg;
        if (DQK == 96) { if (tid < 256) *(LAS u32x4*)(kb + (tid >> 2) * KST + 128 + (tid & 3) * 16) = k2reg; }
    };
    gload(jcur); lstore(0);
    __syncthreads();
    int buf = 0;
    const int vlane = (4 * hi + ((lane & 15) >> 2)) * VST + (16 * ((lane >> 4) & 1) + 4 * (lane & 3)) * 2;
    while (jcur >= 0) {
        const int jnext = next_tile();
        if (jnext >= 0) gload(jnext);
        const LAS unsigned char* kb = lds + buf * BUF; const LAS unsigned char* vb = kb + KBYTES;
        f32x16 p0 = f32x16{}, p1 = f32x16{};
#pragma unroll
        for (int s = 0; s < DQK / 16; ++s) {
            const bf16x8 k0 = *(const LAS bf16x8*)(kb + r32 * KST + s * 32 + hi * 16);
            const bf16x8 k1 = *(const LAS bf16x8*)(kb + (32 + r32) * KST + s * 32 + hi * 16);
            p0 = __builtin_amdgcn_mfma_f32_32x32x16_bf16(k0, qf[s], p0, 0, 0, 0);
            p1 = __builtin_amdgcn_mfma_f32_32x32x16_bf16(k1, qf[s], p1, 0, 0, 0);
        }
        bool need = true;
        if (MODE == 0) need = (jcur * 64 + 63 > q0);
        if (need) {
            const int kbase = jcur * 64 + 4 * hi;
            bool rowok = true;
            if (MODE == 1) rowok = (sel >> jcur) & 1ull;
#pragma unroll
            for (int r = 0; r < 16; ++r) {
                const int k0i = kbase + (r & 3) + 8 * (r >> 2), k1i = k0i + 32;
                bool ok0 = rowok && (k0i <= qpos), ok1 = rowok && (k1i <= qpos);
                if (MODE == 2) { ok0 = ok0 && (qpos - k0i < 512); ok1 = ok1 && (qpos - k1i < 512); }
                if (!ok0) p0[r] = -INFINITY;
                if (!ok1) p1[r] = -INFINITY;
            }
        }
        float rm = fmaxf(p0[0], p1[0]);
#pragma unroll
        for (int r = 1; r < 16; ++r) rm = fmaxf(rm, fmaxf(p0[r], p1[r]));
        rm = fmaxf(rm, __shfl_xor(rm, 32));
        const float mn = fmaxf(m, rm);
        const float ms = (mn == -INFINITY) ? 0.f : mn;
        const float alpha = exp2f(m - ms);
        m = mn;
        float ps = 0.f;
#pragma unroll
        for (int r = 0; r < 16; ++r) { p0[r] = exp2f(p0[r] - ms); p1[r] = exp2f(p1[r] - ms); ps += p0[r] + p1[r]; }
        l = l * alpha + ps;
#pragma unroll
        for (int r = 0; r < 16; ++r) { R.o[0][r] *= alpha; R.o[1][r] *= alpha; }
        bf16x8 pb[4];
        pb[0] = pack8f(p0, 0); pb[1] = pack8f(p0, 8); pb[2] = pack8f(p1, 0); pb[3] = pack8f(p1, 8);
#pragma unroll
        for (int db = 0; db < 2; ++db)
#pragma unroll
            for (int ks = 0; ks < 4; ++ks) {
                const LAS unsigned char* vp = vb + ks * 16 * VST + db * 64 + vlane;
                const s16x4 lo = vtr(vp), hh = vtr(vp + 8 * VST);
                const bf16x8 vf = (bf16x8){lo[0], lo[1], lo[2], lo[3], hh[0], hh[1], hh[2], hh[3]};
                R.o[db] = __builtin_amdgcn_mfma_f32_32x32x16_bf16(vf, pb[ks], R.o[db], 0, 0, 0);
            }
        if (jnext >= 0) lstore(buf ^ 1);
        __syncthreads();
        buf ^= 1; jcur = jnext;
    }
    R.l = l + __shfl_xor(l, 32);
    return R;
}
}

constexpr int ATT_LDS = 2 * (64 * 208 + 64 * att::VST);

__device__ __forceinline__ void mla_attn_phase(const Ctx& c, LAS unsigned char* lds) {
    const int blk = blockIdx.x;
    const int bh = blk >> 3, b = bh >> 3, h = bh & 7;
    const bf16* Kh = c.KN + (size_t)(b * 8 + h) * SEQ * 64; const bf16* Vh = c.VM + (size_t)(b * 8 + h) * SEQ * 64; const bf16* Krh = c.KR + (size_t)b * SEQ * 32;
#pragma unroll 1
    for (int u = 0; u < 2; ++u) {
        int tid_o = threadIdx.x; asm volatile("" : "+v"(tid_o));
        const int tid = tid_o, lane = tid & 63, wave = tid >> 6, hi = lane >> 5, r32 = lane & 31;
        const int qb = u == 0 ? (blk & 7) : 15 - (blk & 7);
        const int q0 = qb * 256, qpos = q0 + wave * 32 + r32;
        bf16* qrow = c.QM + ((size_t)b * SEQ + qpos) * 768 + h * 96;
        bf16x8 qf[6];
#pragma unroll
        for (int s = 0; s < 6; ++s) qf[s] = *(const bf16x8*)(qrow + s * 16 + hi * 8);
        const int nt = (q0 + 256) / 64;
        const unsigned long long tmask = nt >= 64 ? ~0ull : ((1ull << nt) - 1ull);
        const att::Pass R = att::attn_pass<96, 0>(lds, qf, Kh, 64, Krh, 32, Vh, 64, tmask, qpos, 0ull, q0);
        const float inv = 1.0f / R.l;
#pragma unroll
        for (int db = 0; db < 2; ++db)
#pragma unroll
            for (int g4 = 0; g4 < 4; ++g4) {
                u32x2 w; w.x = pk2(R.o[db][4 * g4] * inv, R.o[db][4 * g4 + 1] * inv); w.y = pk2(R.o[db][4 * g4 + 2] * inv, R.o[db][4 * g4 + 3] * inv);
                *(u32x2*)(qrow + db * 32 + 8 * g4 + 4 * hi) = w;
            }
    }
}
__device__ __forceinline__ void nsa_attn_phase(const Ctx& c, LAS unsigned char* lds) {
    const int blk = blockIdx.x;
    const int bg = blk >> 5, b = bg >> 1, gg = bg & 1;
    const bf16* Ks = c.BKV + (size_t)((2 * NB + b) * 2 + gg) * SEQ * 64; const bf16* Vs = c.BKV + (size_t)((3 * NB + b) * 2 + gg) * SEQ * 64;
    const bf16* Kw = c.BKV + (size_t)((4 * NB + b) * 2 + gg) * SEQ * 64; const bf16* Vw = c.BKV + (size_t)((5 * NB + b) * 2 + gg) * SEQ * 64;
#pragma unroll 1
    for (int u = 0; u < 2; ++u) {
        int tid_o = threadIdx.x; asm volatile("" : "+v"(tid_o));
        const int tid = tid_o, lane = tid & 63, wave = tid >> 6, hi = lane >> 5, r32 = lane & 31;
        const int tt = u == 0 ? (blk & 31) : 63 - (blk & 31);
        const int q0 = tt * 64, row = wave * 32 + r32, qpos = q0 + (row >> 2), hh = gg * 4 + (row & 3);
        const size_t t = (size_t)b * SEQ + qpos;
        bf16* qrow = c.BQ + t * 512 + hh * 64;
        bf16x8 qf[4];
#pragma unroll
        for (int s = 0; s < 4; ++s) qf[s] = *(const bf16x8*)(qrow + s * 16 + hi * 8);
        const unsigned long long sel = c.SEL[t * 2 + gg];
        unsigned long long um = sel;
#pragma unroll
        for (int o = 1; o < 64; o <<= 1) { const unsigned lo = __shfl_xor((unsigned)um, o), hx = __shfl_xor((unsigned)(um >> 32), o); um |= ((unsigned long long)hx << 32) | lo; }
        LAS unsigned long long* ux = (LAS unsigned long long*)(lds + ATT_LDS);
        if (lane == 0) ux[wave] = um;
        __syncthreads();
        unsigned long long uall = 0ull;
#pragma unroll
        for (int w = 0; w < 8; ++w) uall |= ux[w];
        const unsigned ulo = __builtin_amdgcn_readfirstlane((unsigned)uall), uhi = __builtin_amdgcn_readfirstlane((unsigned)(uall >> 32));
        const unsigned long long tm_sel = (((unsigned long long)uhi << 32) | ulo) & (tt >= 63 ? ~0ull : ((1ull << (tt + 1)) - 1ull));
        const att::Pass Rs = att::attn_pass<64, 1>(lds, qf, Ks, 64, nullptr, 0, Vs, 64, tm_sel, qpos, sel, q0);
        const float gs = c.SM[t * 32 + 8 + hh * 3 + 1], gwn = c.SM[t * 32 + 8 + hh * 3 + 2];
        const float fs = Rs.l > 0.f ? gs / Rs.l : 0.f;
        att::f32x16 res[2];
#pragma unroll
        for (int db = 0; db < 2; ++db)
#pragma unroll
            for (int r = 0; r < 16; ++r) res[db][r] = Rs.o[db][r] * fs;
        const int j0 = tt >= 8 ? tt - 8 : 0;
        const unsigned long long tm_win = (tt >= 63 ? ~0ull : ((1ull << (tt + 1)) - 1ull)) & ~((1ull << j0) - 1ull);
        const att::Pass Rw = att::attn_pass<64, 2>(lds, qf, Kw, 64, nullptr, 0, Vw, 64, tm_win, qpos, 0ull, q0);
        const float fw = Rw.l > 0.f ? gwn / Rw.l : 0.f;
        const bf16* p1row = c.P1 + t * 512 + hh * 64;
#pragma unroll
        for (int db = 0; db < 2; ++db)
#pragma unroll
            for (int g4 = 0; g4 < 4; ++g4) {
                const u32x2 pw = *(const u32x2*)(p1row + db * 32 + 8 * g4 + 4 * hi);
                const float y0 = res[db][4 * g4] + Rw.o[db][4 * g4] * fw + bflo(pw.x), y1 = res[db][4 * g4 + 1] + Rw.o[db][4 * g4 + 1] * fw + bfhi(pw.x);
                const float y2 = res[db][4 * g4 + 2] + Rw.o[db][4 * g4 + 2] * fw + bflo(pw.y), y3 = res[db][4 * g4 + 3] + Rw.o[db][4 * g4 + 3] * fw + bfhi(pw.y);
                u32x2 w; w.x = pk2(y0, y1); w.y = pk2(y2, y3);
                *(u32x2*)(qrow + db * 32 + 8 * g4 + 4 * hi) = w;
            }
        __syncthreads();
    }
}
template <int WHICH>
__global__ void __launch_bounds__(512, 2) k_attn(Args args, int layer) {
    extern __shared__ __attribute__((aligned(16))) unsigned char lds_raw[];
    const Ctx c = make_ctx(args, layer);
    if (WHICH == 0) mla_attn_phase(c, (LAS unsigned char*)lds_raw); else nsa_attn_phase(c, (LAS unsigned char*)lds_raw);
}

__global__ void __launch_bounds__(256) k_compress(Args args, int layer) {
    __shared__ float hbuf[2 * 128];
    const Ctx c = make_ctx(args, layer);
    const int tid = threadIdx.x;
    for (int it = blockIdx.x; it < 2040; it += gridDim.x) {
        const int r = it * 2 + (tid >> 7), j = tid & 127;
        const int kv = r / 2040, rem = r % 2040, bg = rem / 255, n = rem % 255, b = bg >> 1, gg = bg & 1;
        const bf16* xr = c.BKV + ((size_t)(((kv * NB + b) * 2 + gg) * SEQ + 16 * n)) * 64;
        const float* w1 = c.cmp_w1 + (size_t)kv * 2048 * 128 + j; const float* ps = c.cmp_pos + kv * 2048;
        float acc = 0.f;
#pragma unroll 8
        for (int k = 0; k < 2048; ++k) acc += (bf2f(xr[k]) + ps[k]) * w1[(size_t)k * 128];
        __syncthreads();
        hbuf[(tid >> 7) * 128 + j] = siluf_(acc);
        __syncthreads();
        if (tid < 128) {
            const int rr = tid >> 6, d = tid & 63; const int r2 = it * 2 + rr;
            const int kv2 = r2 / 2040, rem2 = r2 % 2040, bg2 = rem2 / 255, n2 = rem2 % 255;
            const float* w2 = c.cmp_w2 + (size_t)kv2 * 128 * 64 + d; float o = 0.f;
#pragma unroll 8
            for (int jj = 0; jj < 128; ++jj) o += hbuf[rr * 128 + jj] * w2[jj * 64];
            c.KCMP[((size_t)((kv2 * 8 + bg2) * 256 + n2)) * 64 + d] = o;
        }
    }
}
__global__ void __launch_bounds__(256) k_mla_naive(Args args, int layer) {
    __shared__ float qsh[4][4 * 96];
    const Ctx c = make_ctx(args, layer);
    const int tid = threadIdx.x, lane = tid & 63, wave = tid >> 6;
    float* qs = qsh[wave];
    const int NGW = gridDim.x * 4, gw = blockIdx.x * 4 + wave;
    for (int task0 = gw; task0 < 32768; task0 += NGW) {
        const int bh = task0 & 31, tq0 = task0 >> 5, tq = (bh & 1) ? 1023 - tq0 : tq0;
        const int b = bh >> 3, h = bh & 7, s0 = tq * 4; const size_t t0 = (size_t)b * SEQ + s0;
        for (int e = lane; e < 4 * 96; e += 64) qs[e] = bf2f(c.QM[(t0 + e / 96) * 768 + h * 96 + (e % 96)]);
        float m[4], l[4], o[4];
#pragma unroll
        for (int r = 0; r < 4; ++r) { m[r] = -INFINITY; l[r] = 0.f; o[r] = 0.f; }
        const bf16* Kh = c.KN + (size_t)(b * 8 + h) * SEQ * 64; const bf16* Vh = c.VM + (size_t)(b * 8 + h) * SEQ * 64; const bf16* Krh = c.KR + (size_t)b * SEQ * 32;
        const int nkb = (s0 + 3) / 64 + 1;
        for (int kb = 0; kb < nkb; ++kb) {
            const int key = kb * 64 + lane; bool valid[4];
#pragma unroll
            for (int r = 0; r < 4; ++r) valid[r] = key <= s0 + r;
            nattn_block<4, true>(qs, Kh + (size_t)kb * 64 * 64, 64, Krh + (size_t)kb * 64 * 32, 32, Vh + (size_t)kb * 64 * 64, 64, valid, m, l, o, lane);
        }
#pragma unroll
        for (int r = 0; r < 4; ++r) c.QM[(t0 + r) * 768 + h * 96 + lane] = (bf16)f2bf(o[r] / l[r]);
    }
}
__global__ void __launch_bounds__(256) k_cmp_naive(Args args, int layer) {
    __shared__ float qsh[4][256 + 256];
    const Ctx c = make_ctx(args, layer);
    const int tid = threadIdx.x, lane = tid & 63, wave = tid >> 6;
    float* qs = qsh[wave]; float* psb = qs + 256;
    const int NGW = gridDim.x * 4, gw = blockIdx.x * 4 + wave;
    for (int task = gw; task < 32768; task += NGW) {
        const int bg = task >> 12, s = task & 4095, b = bg >> 1, gg = bg & 1; const size_t t = (size_t)b * SEQ + s;
        for (int e = lane; e < 256; e += 64) qs[e] = bf2f(c.BQ[t * 512 + gg * 256 + e]);
        const float* Kc = c.KCMP + (size_t)(0 * 8 + bg) * 256 * 64; const float* Vc = c.KCMP + (size_t)(1 * 8 + bg) * 256 * 64;
        float sc[4][4]; float mx[4] = {-INFINITY, -INFINITY, -INFINITY, -INFINITY};
#pragma unroll
        for (int kb = 0; kb < 4; ++kb) {
            const int n = kb * 64 + lane; const bool valid = (n < 255) && (16 * n + 31 <= s);
            const float* kr = Kc + (size_t)n * 64; float a[4] = {0.f, 0.f, 0.f, 0.f};
            for (int d0 = 0; d0 < 64; d0 += 4) {
                const f32x4 kd = *(const f32x4*)(kr + d0);
#pragma unroll
                for (int e = 0; e < 4; ++e)
#pragma unroll
                    for (int h = 0; h < 4; ++h) a[h] += qs[h * 64 + d0 + e] * kd[e];
            }
#pragma unroll
            for (int h = 0; h < 4; ++h) { sc[kb][h] = valid ? a[h] : -INFINITY; mx[h] = fmaxf(mx[h], sc[kb][h]); }
        }
        float o[4] = {0.f, 0.f, 0.f, 0.f}; float psum[4] = {0.f, 0.f, 0.f, 0.f};
#pragma unroll
        for (int h = 0; h < 4; ++h) {
            const float mh = wave_max(mx[h]);
            float e[4]; float ls = 0.f;
#pragma unroll
            for (int kb = 0; kb < 4; ++kb) { e[kb] = (mh == -INFINITY || sc[kb][h] == -INFINITY) ? 0.f : exp2f(sc[kb][h] - mh); ls += e[kb]; }
            ls = wave_sum(ls); const float inv = ls > 0.f ? 1.0f / ls : 0.f;
#pragma unroll
            for (int kb = 0; kb < 4; ++kb) { sc[kb][h] = e[kb] * inv; psum[kb] += sc[kb][h]; }
        }
#pragma unroll
        for (int kb = 0; kb < 4; ++kb) {
            for (int key = 0; key < 64; ++key) {
                const int n = kb * 64 + key; if (16 * n + 31 > s) break;
                const float vv = Vc[(size_t)n * 64 + lane];
#pragma unroll
                for (int h = 0; h < 4; ++h) o[h] += rdlane(sc[kb][h], key) * vv;
            }
        }
#pragma unroll
        for (int kb = 0; kb < 4; ++kb) psb[kb * 64 + lane] = psum[kb];
        __builtin_amdgcn_wave_barrier();
        float imp = 0.f;
#pragma unroll
        for (int q = -1; q < 4; ++q) { const int n = 4 * lane + q; if (n >= 0 && n < 255) imp += psb[n]; }
        const int cur = s >> 6;
        const bool vj = lane <= cur; const bool forced = (lane == 0) || (lane == cur) || (lane == cur - 1);
        const float score = vj ? imp + (forced ? 1e4f : 0.f) : -1.0f;
        int cnt = 0;
        for (int i2 = 0; i2 < 64; ++i2) { const float si = rdlane(score, i2); cnt += ((si > score) || (si == score && i2 < lane)) ? 1 : 0; }
        const bool selb = (cnt < 16) && (score > -0.5f);
        const unsigned long long mask = __ballot(selb);
        if (lane == 0) c.SEL[t * 2 + gg] = mask;
#pragma unroll
        for (int h = 0; h < 4; ++h) c.P1[t * 512 + (gg * 4 + h) * 64 + lane] = (bf16)f2bf(c.SM[t * 32 + 8 + (gg * 4 + h) * 3 + 0] * o[h]);
        __builtin_amdgcn_wave_barrier();
    }
}
__global__ void __launch_bounds__(256) k_selwin_naive(Args args, int layer) {
    __shared__ float qsh[4][256];
    const Ctx c = make_ctx(args, layer);
    const int tid = threadIdx.x, lane = tid & 63, wave = tid >> 6;
    float* qs = qsh[wave];
    const int NGW = gridDim.x * 4, gw = blockIdx.x * 4 + wave;
    for (int task = gw; task < 32768; task += NGW) {
        const int bg = task & 7, s = task >> 3, b = bg >> 1, gg = bg & 1; const size_t t = (size_t)b * SEQ + s;
        for (int e = lane; e < 256; e += 64) qs[e] = bf2f(c.BQ[t * 512 + gg * 256 + e]);
        const unsigned long long mk = c.SEL[t * 2 + gg];
        const unsigned mlo = __builtin_amdgcn_readfirstlane((unsigned)mk), mhi = __builtin_amdgcn_readfirstlane((unsigned)(mk >> 32));
        const bf16* Ks = c.BKV + (size_t)((2 * NB + b) * 2 + gg) * SEQ * 64; const bf16* Vs = c.BKV + (size_t)((3 * NB + b) * 2 + gg) * SEQ * 64;
        const bf16* Kw = c.BKV + (size_t)((4 * NB + b) * 2 + gg) * SEQ * 64; const bf16* Vw = c.BKV + (size_t)((5 * NB + b) * 2 + gg) * SEQ * 64;
        float m[4], l[4], o[4], osel[4];
#pragma unroll
        for (int r = 0; r < 4; ++r) { m[r] = -INFINITY; l[r] = 0.f; o[r] = 0.f; }
        for (int j = 0; j < 64; ++j) {
            const unsigned bit = j < 32 ? (mlo >> j) & 1u : (mhi >> (j - 32)) & 1u;
            if (!bit) continue;
            const bool vk = (j * 64 + lane) <= s; bool valid[4] = {vk, vk, vk, vk};
            nattn_block<4, false>(qs, Ks + (size_t)j * 64 * 64, 64, nullptr, 0, Vs + (size_t)j * 64 * 64, 64, valid, m, l, o, lane);
        }
#pragma unroll
        for (int r = 0; r < 4; ++r) { osel[r] = l[r] > 0.f ? o[r] / l[r] : 0.f; m[r] = -INFINITY; l[r] = 0.f; o[r] = 0.f; }
        const int jb0 = (s >= 511 ? s - 511 : 0) >> 6, jb1 = s >> 6;
        for (int j = jb0; j <= jb1; ++j) {
            const int key = j * 64 + lane; const bool vk = (key <= s) && (s - key < 512); bool valid[4] = {vk, vk, vk, vk};
            nattn_block<4, false>(qs, Kw + (size_t)j * 64 * 64, 64, nullptr, 0, Vw + (size_t)j * 64 * 64, 64, valid, m, l, o, lane);
        }
#pragma unroll
        for (int r = 0; r < 4; ++r) {
            const int hh = gg * 4 + r; const float ow = l[r] > 0.f ? o[r] / l[r] : 0.f;
            const float y = bf2f(c.P1[t * 512 + hh * 64 + lane]) + c.SM[t * 32 + 8 + hh * 3 + 1] * osel[r] + c.SM[t * 32 + 8 + hh * 3 + 2] * ow;
            c.BQ[t * 512 + hh * 64 + lane] = (bf16)f2bf(y);
        }
        __builtin_amdgcn_wave_barrier();
    }
}
__global__ void __launch_bounds__(128) k_mlstm_naive(Args args, int layer) {
    __shared__ float qk[128]; __shared__ float red[2];
    const Ctx c = make_ctx(args, layer);
    const int tid = threadIdx.x, lane = tid & 63, wave = tid >> 6;
    const int b = blockIdx.x >> 2, h = blockIdx.x & 3;
    float C[64], nv[64];
#pragma unroll
    for (int d = 0; d < 64; ++d) { C[d] = 0.f; nv[d] = 0.f; }
    float mstate = 0.f;
    const int ch = tid < 64 ? h * 64 + tid : 256 + h * 64 + (tid - 64);
    float cw[4];
#pragma unroll
    for (int kk = 0; kk < 4; ++kk) cw[kk] = c.m_conv[kk * 512 + ch];
    const float hn = c.m_hnorm[h * 128 + tid];
    for (int s = 0; s < SEQ; ++s) {
        const size_t t = (size_t)b * SEQ + s;
        {
            float a = 0.f;
#pragma unroll
            for (int kk = 0; kk < 4; ++kk) { const int sp = s - 3 + kk; if (sp >= 0) a += cw[kk] * bf2f(c.AQK[((size_t)b * SEQ + sp) * 512 + ch]); }
            float y = siluf_(a); if (tid < 64) y *= 0.125f;
            qk[tid] = y;
        }
        __syncthreads();
        const float li = c.SM[t * 32 + h], lf = c.SM[t * 32 + 4 + h];
        const float mn = fmaxf(lf + mstate, li); const float fp = expf(lf + mstate - mn), ip = expf(li - mn); mstate = mn;
        const float v = bf2f(c.AV[t * 512 + h * 128 + tid]); const float iv = ip * v;
        float num = 0.f, den = 0.f;
#pragma unroll
        for (int d = 0; d < 64; ++d) { const float kd = qk[64 + d], qd = qk[d]; C[d] = fp * C[d] + iv * kd; nv[d] = fp * nv[d] + ip * kd; num += C[d] * qd; den += nv[d] * qd; }
        const float hv = num / fmaxf(fabsf(den), expf(-mn));
        const float ss = wave_sum(hv * hv); if (lane == 0) red[wave] = ss;
        __syncthreads();
        const float rstd = rsqrtf((red[0] + red[1]) * (1.0f / 128.0f) + EPS);
        const float y = hv * rstd * hn * bf2f(c.AO[t * 512 + h * 128 + tid]);
        c.AV[t * 512 + h * 128 + tid] = (bf16)f2bf(y);
    }
}

extern "C" void kernel_launch(void* const* d_in, const int* in_sizes, int n_in, void* d_out, int out_size, void* d_ws, size_t ws_size, hipStream_t stream) {
    static int grid = 0;
    if (grid == 0) {
        if (n_in != 19 || out_size != T * DM || ws_size < WS_END) { fprintf(stderr, "kernel_launch: unexpected problem: n_in %d out %d ws %zu\n", n_in, out_size, ws_size); grid = -1; return; }
        int dev = 0, cus = 0;
        (void)hipGetDevice(&dev); (void)hipDeviceGetAttribute(&cus, hipDeviceAttributeMultiprocessorCount, dev);
        bool ok = true;
#define SETLDS(k) ok = ok && (hipFuncSetAttribute((const void*)k, hipFuncAttributeMaxDynamicSharedMemorySize, LDS_BYTES) == hipSuccess)
        SETLDS(k_phase<PH_P0>); SETLDS(k_phase<PH_A2>); SETLDS(k_phase<PH_B>); SETLDS(k_phase<PH_E>); SETLDS(k_phase<PH_F>); SETLDS(k_phase<PH_F2>); SETLDS(k_phase<PH_G>); SETLDS(k_phase<PH_H>); SETLDS(k_phase<PH_H2>); SETLDS(k_attn<0>); SETLDS(k_attn<1>);
        if (!ok) { fprintf(stderr, "kernel_launch: hipFuncSetAttribute failed\n"); grid = -1; return; }
        grid = cus;
        if (grid != 256) { fprintf(stderr, "kernel_launch: built for 256 CUs, found %d\n", grid); grid = -1; return; }
    }
    if (grid < 0) return;
    Args a{};
    for (int i = 0; i < 19; ++i) a.in[i] = d_in[i];
    a.out = (float*)d_out; a.ws = (unsigned char*)d_ws;
    for (int layer = 0; layer < 2; ++layer) {
        hipLaunchKernelGGL(k_phase<PH_P0>, dim3(grid), dim3(512), LDS_BYTES, stream, a, layer);
        hipLaunchKernelGGL(k_phase<PH_A2>, dim3(grid), dim3(512), LDS_BYTES, stream, a, layer);
        hipLaunchKernelGGL(k_phase<PH_B>, dim3(grid), dim3(512), LDS_BYTES, stream, a, layer);
        hipLaunchKernelGGL(k_compress, dim3(1020), dim3(256), 0, stream, a, layer);
        hipLaunchKernelGGL(k_attn<0>, dim3(grid), dim3(512), LDS_BYTES, stream, a, layer);
        hipLaunchKernelGGL(k_cmp_naive, dim3(2048), dim3(256), 0, stream, a, layer);
        hipLaunchKernelGGL(k_attn<1>, dim3(grid), dim3(512), LDS_BYTES, stream, a, layer);
        hipLaunchKernelGGL(k_mlstm_naive, dim3(16), dim3(128), 0, stream, a, layer);
        hipLaunchKernelGGL(k_phase<PH_E>, dim3(grid), dim3(512), LDS_BYTES, stream, a, layer);
        hipLaunchKernelGGL(k_phase<PH_F>, dim3(grid), dim3(512), LDS_BYTES, stream, a, layer);
        hipLaunchKernelGGL(k_phase<PH_F2>, dim3(grid), dim3(512), LDS_BYTES, stream, a, layer);
        hipLaunchKernelGGL(k_phase<PH_G>, dim3(grid), dim3(512), LDS_BYTES, stream, a, layer);
        hipLaunchKernelGGL(k_phase<PH_H>, dim3(grid), dim3(512), LDS_BYTES, stream, a, layer);
        hipLaunchKernelGGL(k_phase<PH_H2>, dim3(grid), dim3(512), LDS_BYTES, stream, a, layer);
    }
}
```

```cpp
#include <hip/hip_runtime.h>
#include <hip/hip_cooperative_groups.h>
#include <cstdio>
#include <cstdint>
namespace cg = cooperative_groups;

#define LAS __attribute__((address_space(3)))
typedef unsigned short bf16;
typedef short bf16x8 __attribute__((ext_vector_type(8)));
typedef float f32x4 __attribute__((ext_vector_type(4)));
typedef unsigned u32x4 __attribute__((ext_vector_type(4)));
typedef unsigned u32x2 __attribute__((ext_vector_type(2)));

constexpr int NB = 4, SEQ = 4096, T = NB * SEQ, DM = 1024, DIN = 6592, DFF = 2816;
constexpr float EPS = 1e-6f;
constexpr float LOG2E = 1.4426950408889634f;
constexpr float QSCALE_NSA = 0.125f * LOG2E;
constexpr float QSCALE_MLA = 0.10206207261596577f * LOG2E;
constexpr int NZ = 3584;

constexpr size_t MiB = 1u << 20;
constexpr size_t WS_ROPE = 1 * MiB, WS_SM = 3 * MiB, WS_SSQ = 5 * MiB, WS_SEL = 7 * MiB, WS_KCMP = 7 * MiB + 256 * 1024, WS_KCB = 8 * MiB + 256 * 1024;
constexpr size_t WS_WIN = 9 * MiB, WS_WG = 16 * MiB, WS_WUQ = 22 * MiB, WS_WUKV = 22 * MiB + 640 * 1024, WS_WBR = 23 * MiB + 256 * 1024, WS_WOUT = 26 * MiB + 256 * 1024;
constexpr size_t WS_WC1 = 28 * MiB + 256 * 1024, WS_B1 = 6 * MiB + 512 * 1024;
constexpr size_t WS_XB = 31 * MiB, WS_AV = 63 * MiB, WS_AO = 79 * MiB, WS_BQ = 95 * MiB, WS_BKV = 111 * MiB, WS_AQK = 135 * MiB, WS_CQKV = 151 * MiB;
constexpr size_t WS_QM = 171 * MiB, WS_KN = 195 * MiB, WS_VM = 211 * MiB, WS_KR = 227 * MiB, WS_CL = 228 * MiB, WS_NL = 244 * MiB, WS_MSC = 244 * MiB + 512 * 1024;
constexpr size_t WS_P1 = 151 * MiB, WS_GT = 111 * MiB, WS_MERGED = 195 * MiB, WS_WGU = 63 * MiB, WS_WDN = 74 * MiB, WS_MIX = 95 * MiB, WS_U = 95 * MiB, WS_FD = 183 * MiB;
constexpr size_t WS_END = 247 * MiB;

constexpr int LDS_BYTES = 147456;

__device__ __forceinline__ unsigned f2bf(float f) { unsigned u = __builtin_bit_cast(unsigned, f); return (u + 0x7fffu + ((u >> 16) & 1u)) >> 16; }
__device__ __forceinline__ unsigned pk2(float lo, float hi) { return f2bf(lo) | (f2bf(hi) << 16); }
__device__ __forceinline__ float bf2f(unsigned short u) { return __builtin_bit_cast(float, (unsigned)u << 16); }
__device__ __forceinline__ float bflo(unsigned w) { return __builtin_bit_cast(float, w << 16); }
__device__ __forceinline__ float bfhi(unsigned w) { return __builtin_bit_cast(float, w & 0xffff0000u); }
__device__ __forceinline__ float wave_sum(float v) {
#pragma unroll
    for (int o = 1; o < 64; o <<= 1) v += __shfl_xor(v, o);
    return v;
}
__device__ __forceinline__ float wave_max(float v) {
#pragma unroll
    for (int o = 1; o < 64; o <<= 1) v = fmaxf(v, __shfl_xor(v, o));
    return v;
}
__device__ __forceinline__ float sigmoidf_(float x) { return 1.0f / (1.0f + __expf(-x)); }
__device__ __forceinline__ float siluf_(float x) { return x / (1.0f + __expf(-x)); }
__device__ __forceinline__ float logsigmoidf_(float x) { return x >= 0.f ? -log1pf(expf(-x)) : x - log1pf(expf(x)); }
__device__ __forceinline__ float rdlane(float v, int l) { return __builtin_bit_cast(float, __builtin_amdgcn_readlane(__builtin_bit_cast(int, v), l)); }

namespace pg8 {
constexpr int BM = 256, BK = 64, HALF = 128, HTB = HALF * BK * 2, STAGE_BYTES = 8 * HTB, NXCD = 8, WGM = 8;
__host__ __device__ __forceinline__ int lds_byte(int r, int c) { const int st = (r >> 4) * 2 + (c >> 5), rr = r & 15, cc = c & 31, ob = rr * 64 + cc * 2; return st * 1024 + (ob ^ (((ob >> 9) & 1) << 5)); }
__host__ __device__ __forceinline__ void stage_rc(int b, int& R, int& C) { const int st = b / 1024, sb = b % 1024, swz = sb ^ (((sb >> 9) & 1) << 5); R = (st >> 1) * 16 + swz / 64; C = (st & 1) * 32 + (swz % 64) / 2; }
__host__ __device__ __forceinline__ int perm32(int rho) { const int n = rho >> 4, i = rho & 15; return 8 * (i >> 2) + 4 * n + (i & 3); }

struct Unit { int pm, pn; };
struct Gemm { const bf16* A; const bf16* Bt; };

struct StaticOrder {
    int nM, nN, nwg, G, c;
    __host__ __device__ void init(int M, int N, int G_, int c_) { nM = M / BM; nN = N / BM; nwg = nM * nN; G = G_; c = c_; }
    __host__ __device__ bool next(int i, Unit& u) const {
        const long L = (long)i * G + c; if (L >= nwg) return false;
        int wgid = (int)L; { const int q = nwg / NXCD, r = nwg % NXCD, xcd = wgid % NXCD, off = wgid / NXCD; wgid = (xcd < r ? xcd * (q + 1) : r * (q + 1) + (xcd - r) * q) + off; }
        const int nig = WGM * nN, gid = wgid / nig, fm = gid * WGM, gsz = (nM - fm) < WGM ? (nM - fm) : WGM;
        u.pm = fm + ((wgid % nig) % gsz); u.pn = (wgid % nig) / gsz; return true;
    }
};

template <int GK, int LDA, int LDB, int KSTEPA, class Epi, class Sched>
__device__ __forceinline__ void gemm_phase(LAS unsigned char* lds, const Gemm g, const Sched& S, const Epi& E) {
    int tid_ = threadIdx.x; asm volatile("" : "+v"(tid_));
    const int tid = tid_, wid = __builtin_amdgcn_readfirstlane(tid >> 6), lane = tid & 63, wr = wid >> 2, wc = wid & 3, fr = lane & 15, fq = lane >> 4;
    constexpr int nt = GK / BK;
    unsigned voffA[2], voffB[2];
#pragma unroll
    for (int i = 0; i < 2; ++i) { int R, C; stage_rc(tid * 16 + i * 8192, R, C); const int Rb = Epi::PERM ? ((R & ~31) + perm32(R & 31)) : R;
        voffA[i] = (unsigned)(R * LDA + C) * 2u; voffB[i] = (unsigned)(Rb * LDB + C) * 2u; }
    constexpr size_t kstepA = (size_t)KSTEPA, kstepB = (size_t)(BK * 2);
    constexpr size_t hstepA = (size_t)HALF * LDA * 2, hstepB = (size_t)HALF * LDB * 2;
    constexpr size_t tstepA = 2 * hstepA, tstepB = 2 * hstepB;
    const unsigned ldsw = (unsigned)wid * 1024u;
    const int aoff = lds_byte(wr * 64 + fr, fq * 8), boff = lds_byte(wc * 32 + fr, fq * 8);
#define PG8_SA(b, h) (((b) * 2 + (h)) * HTB)
#define PG8_SB(b, h) ((4 + (b) * 2 + (h)) * HTB)
#define PG8_STAGE(bufoff, gbase, voff) do { _Pragma("unroll") for (int _i = 0; _i < 2; ++_i) \
        __builtin_amdgcn_global_load_lds((const unsigned*)((const char*)(gbase) + (voff)[_i]), (LAS unsigned*)(lds + (bufoff) + ldsw + _i * 8192), 16, 0, 0); } while (0)
#define PG8_LDA(dst, b, h) do { _Pragma("unroll") for (int m = 0; m < 4; ++m) _Pragma("unroll") for (int k = 0; k < 2; ++k) dst[m][k] = *(const LAS bf16x8*)(lds + PG8_SA(b, h) + aoff + m * 2048 + k * 1024); } while (0)
#define PG8_LDB(dst, b, h) do { _Pragma("unroll") for (int n = 0; n < 2; ++n) _Pragma("unroll") for (int k = 0; k < 2; ++k) dst[n][k] = *(const LAS bf16x8*)(lds + PG8_SB(b, h) + boff + n * 2048 + k * 1024); } while (0)
#define PG8_MMA(ai, bj, At, Bt) do { __builtin_amdgcn_s_setprio(1); _Pragma("unroll") for (int m = 0; m < 4; ++m) _Pragma("unroll") for (int n = 0; n < 2; ++n) _Pragma("unroll") for (int k = 0; k < 2; ++k) \
        acc[ai][bj][m][n] = __builtin_amdgcn_mfma_f32_16x16x32_bf16(Bt[n][k], At[m][k], acc[ai][bj][m][n], 0, 0, 0); __builtin_amdgcn_s_setprio(0); } while (0)
#define PG8_WAIT_V(n) asm volatile("s_waitcnt vmcnt(" #n ")" ::: "memory")
#define PG8_WAIT_L(n) asm volatile("s_waitcnt lgkmcnt(" #n ")" ::: "memory")
#define PG8_BAR __builtin_amdgcn_s_barrier()
#define PG8_SCHED __builtin_amdgcn_sched_barrier(0)
    Unit cur, nxt; int ui = 0;
    if (!S.next(0, cur)) return;
    f32x4 acc[2][2][4][2];
#pragma unroll
    for (int a = 0; a < 2; ++a)
#pragma unroll
        for (int b = 0; b < 2; ++b)
#pragma unroll
            for (int m = 0; m < 4; ++m)
#pragma unroll
                for (int n = 0; n < 2; ++n) acc[a][b][m][n] = (f32x4){0.f, 0.f, 0.f, 0.f};
    bf16x8 At[4][2], B0[2][2], B1[2][2];
    const char* cA = (const char*)g.A + (size_t)cur.pm * tstepA; const char* cB = (const char*)g.Bt + (size_t)cur.pn * tstepB;
    PG8_STAGE(PG8_SB(0, 0), cB, voffB); PG8_STAGE(PG8_SB(0, 1), cB + hstepB, voffB); PG8_STAGE(PG8_SA(0, 0), cA, voffA); PG8_STAGE(PG8_SA(0, 1), cA + hstepA, voffA);
    if (wr == 1) PG8_BAR;
    PG8_WAIT_V(2); PG8_BAR;
    PG8_STAGE(PG8_SB(1, 0), cB + kstepB, voffB); PG8_STAGE(PG8_SA(1, 0), cA + kstepA, voffA); PG8_STAGE(PG8_SB(1, 1), cB + hstepB + kstepB, voffB);
    PG8_WAIT_V(6); PG8_BAR;
    for (;;) {
        const bool has_next = S.next(ui + 1, nxt);
        const char* nA = has_next ? (const char*)g.A + (size_t)nxt.pm * tstepA : cA; const char* nB = has_next ? (const char*)g.Bt + (size_t)nxt.pn * tstepB : cB;
#pragma unroll 1
        for (int t = 0; t < nt; t += 2) {
            const bool last = (t == nt - 2);
            const char* a1 = cA + (size_t)(t + 1) * kstepA;
            const char* a2 = last ? nA : cA + (size_t)(t + 2) * kstepA; const char* b2 = last ? nB : cB + (size_t)(t + 2) * kstepB;
            const char* a3 = a2 + kstepA; const char* b3 = b2 + kstepB;
            PG8_LDB(B0, 0, 0); PG8_LDB(B1, 0, 1); PG8_SCHED; PG8_LDA(At, 0, 0); PG8_STAGE(PG8_SA(1, 1), a1 + hstepA, voffA);
            PG8_WAIT_V(8); PG8_WAIT_L(0); PG8_BAR; PG8_MMA(0, 0, At, B0); PG8_MMA(0, 1, At, B1); PG8_BAR; PG8_SCHED;
            PG8_LDA(At, 0, 1); PG8_STAGE(PG8_SB(0, 0), b2, voffB); PG8_STAGE(PG8_SB(0, 1), b2 + hstepB, voffB); PG8_STAGE(PG8_SA(0, 0), a2, voffA);
            PG8_WAIT_V(8); PG8_WAIT_L(0); PG8_BAR; PG8_MMA(1, 0, At, B0); PG8_MMA(1, 1, At, B1); PG8_BAR; PG8_SCHED;
            PG8_LDB(B0, 1, 0); PG8_LDB(B1, 1, 1); PG8_SCHED; PG8_LDA(At, 1, 0); PG8_STAGE(PG8_SA(0, 1), a2 + hstepA, voffA);
            PG8_WAIT_V(8); PG8_WAIT_L(0); PG8_BAR; PG8_MMA(0, 0, At, B0); PG8_MMA(0, 1, At, B1); PG8_BAR; PG8_SCHED;
            PG8_LDA(At, 1, 1); PG8_STAGE(PG8_SB(1, 0), b3, voffB); PG8_STAGE(PG8_SB(1, 1), b3 + hstepB, voffB); PG8_STAGE(PG8_SA(1, 0), a3, voffA);
            PG8_WAIT_V(8); PG8_WAIT_L(0); PG8_BAR; PG8_MMA(1, 0, At, B0); PG8_MMA(1, 1, At, B1); PG8_BAR; PG8_SCHED;
        }
        if (wr == 0) PG8_BAR;
        if constexpr (!Epi::AFTER_DRAIN) E(acc, cur, wr, wc, fr, fq);
        if (!has_next) break;
#pragma unroll
        for (int a = 0; a < 2; ++a)
#pragma unroll
            for (int b = 0; b < 2; ++b)
#pragma unroll
                for (int m = 0; m < 4; ++m)
#pragma unroll
                    for (int n = 0; n < 2; ++n) acc[a][b][m][n] = (f32x4){0.f, 0.f, 0.f, 0.f};
        cur = nxt; cA = nA; cB = nB; ++ui;
        if (wr == 1) PG8_BAR;
    }
    PG8_WAIT_V(0);
    PG8_BAR;
    if constexpr (Epi::AFTER_DRAIN) E.fused(acc, cur, wr, wc, fr, fq, lds, tid);
#undef PG8_SA
#undef PG8_SB
#undef PG8_STAGE
#undef PG8_LDA
#undef PG8_LDB
#undef PG8_MMA
#undef PG8_WAIT_V
#undef PG8_WAIT_L
#undef PG8_BAR
#undef PG8_SCHED
}
}
using pg8::Unit;
typedef const f32x4 (&AccRef)[2][2][4][2];

__device__ __forceinline__ u32x4 pack8(const f32x4 a, const f32x4 b) { u32x4 w; w.x = pk2(a[0], a[1]); w.y = pk2(a[2], a[3]); w.z = pk2(b[0], b[1]); w.w = pk2(b[2], b[3]); return w; }

struct EpiInProj {
    static constexpr bool PERM = true, AFTER_DRAIN = false;
    bf16 *AQK, *AV, *AO, *BQ, *BKV, *CQKV, *KR; float *SM, *SSQ; const float* ROPE; const float* gbias;
    __device__ __forceinline__ void operator()(AccRef acc, const Unit& u, int wr, int wc, int fr, int fq) const {
        const int pn = u.pn;
#pragma unroll
        for (int ai = 0; ai < 2; ++ai)
#pragma unroll
            for (int m = 0; m < 4; ++m) {
                const int row = u.pm * 256 + ai * 128 + wr * 64 + m * 16 + fr;
#pragma unroll
                for (int bj = 0; bj < 2; ++bj) {
                    f32x4 v0 = acc[ai][bj][m][0], v1 = acc[ai][bj][m][1];
                    const int cg = bj * 128 + wc * 32;
                    const int c0 = cg + 8 * fq;
                    if (pn < 8) {
                        const int region = pn >> 1; const int col = (pn & 1) * 256 + c0;
                        bf16* base = region == 0 ? AQK : region == 1 ? AV : region == 2 ? AO : BQ;
                        if (region == 2) {
#pragma unroll
                            for (int e = 0; e < 4; ++e) { v0[e] = sigmoidf_(v0[e]); v1[e] = sigmoidf_(v1[e]); }
                        }
                        *(u32x4*)(base + (size_t)row * 512 + col) = pack8(v0, v1);
                    } else if (pn < 11) {
                        const int cc = (pn - 8) * 256 + c0; const int i = cc >> 7, gg = (cc >> 6) & 1, d = cc & 63; const int b = row >> 12, s = row & 4095;
                        *(u32x4*)(BKV + ((size_t)(((i * NB + b) * 2 + gg) * SEQ + s)) * 64 + d) = pack8(v0, v1);
                    } else {
                        const int gb = (pn - 11) * 256 + cg;
                        if (gb < 640) {
                            *(u32x4*)(CQKV + (size_t)row * 640 + gb + 8 * fq) = pack8(v0, v1);
                            float ss = 0.f;
#pragma unroll
                            for (int e = 0; e < 4; ++e) ss += v0[e] * v0[e] + v1[e] * v1[e];
                            ss += __shfl_xor(ss, 16); ss += __shfl_xor(ss, 32);
                            if (fq == 0) SSQ[(size_t)row * 24 + (gb >> 5)] = ss;
                        } else if (gb == 640) {
                            float o[8];
#pragma unroll
                            for (int e = 0; e < 8; ++e) {
                                const float v = e < 4 ? v0[e] : v1[e - 4]; const float p = __shfl_xor(v, 32);
                                const int i = (8 * fq + e) & 15; const float cs = ROPE[((size_t)row * 16 + i) * 2], sn = ROPE[((size_t)row * 16 + i) * 2 + 1];
                                o[e] = fq < 2 ? v * cs - p * sn : p * sn + v * cs;
                            }
                            u32x4 w; w.x = pk2(o[0], o[1]); w.y = pk2(o[2], o[3]); w.z = pk2(o[4], o[5]); w.w = pk2(o[6], o[7]);
                            *(u32x4*)(KR + (size_t)row * 32 + 8 * fq) = w;
                        } else if (gb == 672) {
                            float o[8];
#pragma unroll
                            for (int e = 0; e < 8; ++e) {
                                const float v = e < 4 ? v0[e] : v1[e - 4];
                                if (fq == 0) { const float x = v + gbias[e]; o[e] = e < 4 ? x : logsigmoidf_(x); }
                                else o[e] = sigmoidf_(v);
                            }
                            float* dst = SM + (size_t)row * 32 + 8 * fq;
                            *(f32x4*)dst = (f32x4){o[0], o[1], o[2], o[3]}; *(f32x4*)(dst + 4) = (f32x4){o[4], o[5], o[6], o[7]};
                        }
                    }
                }
                asm volatile("" ::: "memory");
            }
    }
};

struct EpiMlaQ {
    static constexpr bool PERM = true, AFTER_DRAIN = false;
    bf16* QM; const float* SSQ; const float* ROPE;
    __device__ __forceinline__ void operator()(AccRef acc, const Unit& u, int wr, int wc, int fr, int fq) const {
#pragma unroll
        for (int ai = 0; ai < 2; ++ai)
#pragma unroll
            for (int m = 0; m < 4; ++m) {
                const int row = u.pm * 256 + ai * 128 + wr * 64 + m * 16 + fr;
                const f32x4* sp = (const f32x4*)(SSQ + (size_t)row * 24);
                const f32x4 s0 = sp[0], s1 = sp[1], s2 = sp[2];
                const float ss = (s0[0] + s0[1] + s0[2] + s0[3]) + (s1[0] + s1[1] + s1[2] + s1[3]) + (s2[0] + s2[1] + s2[2] + s2[3]);
                const float rstd = rsqrtf(ss * (1.0f / 384.0f) + EPS);
#pragma unroll
                for (int bj = 0; bj < 2; ++bj) {
                    const int cgi = u.pn * 8 + bj * 4 + wc;
                    f32x4 v0 = acc[ai][bj][m][0] * rstd, v1 = acc[ai][bj][m][1] * rstd;
                    if (cgi % 3 == 2) {
                        float o[8];
#pragma unroll
                        for (int e = 0; e < 8; ++e) {
                            const float v = e < 4 ? v0[e] : v1[e - 4]; const float p = __shfl_xor(v, 32);
                            const int i = (8 * fq + e) & 15; const float cs = ROPE[((size_t)row * 16 + i) * 2], sn = ROPE[((size_t)row * 16 + i) * 2 + 1];
                            o[e] = fq < 2 ? v * cs - p * sn : p * sn + v * cs;
                        }
                        v0 = (f32x4){o[0], o[1], o[2], o[3]}; v1 = (f32x4){o[4], o[5], o[6], o[7]};
                    }
                    *(u32x4*)(QM + (size_t)row * 768 + cgi * 32 + 8 * fq) = pack8(v0, v1);
                }
                asm volatile("" ::: "memory");
            }
    }
};
struct EpiMlaKV {
    static constexpr bool PERM = true, AFTER_DRAIN = false;
    bf16 *KN, *VM; const float* SSQ;
    __device__ __forceinline__ void operator()(AccRef acc, const Unit& u, int wr, int wc, int fr, int fq) const {
#pragma unroll
        for (int ai = 0; ai < 2; ++ai)
#pragma unroll
            for (int m = 0; m < 4; ++m) {
                const int row = u.pm * 256 + ai * 128 + wr * 64 + m * 16 + fr;
                const f32x4* sp = (const f32x4*)(SSQ + (size_t)row * 24 + 12);
                const f32x4 s0 = sp[0], s1 = sp[1];
                const float ss = (s0[0] + s0[1] + s0[2] + s0[3]) + (s1[0] + s1[1] + s1[2] + s1[3]);
                const float rstd = rsqrtf(ss * (1.0f / 256.0f) + EPS);
                const int b = row >> 12, s = row & 4095;
#pragma unroll
                for (int bj = 0; bj < 2; ++bj) {
                    const int h = u.pn * 2 + bj; const int j = wc * 32 + 8 * fq;
                    const f32x4 v0 = acc[ai][bj][m][0] * rstd, v1 = acc[ai][bj][m][1] * rstd;
                    bf16* dst = (j < 64 ? KN : VM) + ((size_t)((b * 8 + h) * SEQ + s)) * 64 + (j & 63);
                    *(u32x4*)dst = pack8(v0, v1);
                }
                asm volatile("" ::: "memory");
            }
    }
};
struct EpiGate {
    static constexpr bool PERM = true, AFTER_DRAIN = false;
    bf16* GT;
    __device__ __forceinline__ void operator()(AccRef acc, const Unit& u, int wr, int wc, int fr, int fq) const {
        int tid = threadIdx.x; asm volatile("" : "+v"(tid));
#pragma unroll
        for (int ai = 0; ai < 2; ++ai)
#pragma unroll
            for (int bj = 0; bj < 2; ++bj)
#pragma unroll
                for (int m = 0; m < 4; ++m) {
                    f32x4 v0 = acc[ai][bj][m][0], v1 = acc[ai][bj][m][1];
#pragma unroll
                    for (int e = 0; e < 4; ++e) { v0[e] = sigmoidf_(v0[e]); v1[e] = sigmoidf_(v1[e]); }
                    const int q = (ai * 2 + bj) * 4 + m;
                    *(u32x4*)(GT + ((size_t)q * 512 + tid) * 8) = pack8(v0, v1);
                    asm volatile("" ::: "memory");
                }
    }
};
struct EpiBranch {
    static constexpr bool PERM = true, AFTER_DRAIN = false;
    const bf16* GT; bf16* MG; int first;
    __device__ __forceinline__ void operator()(AccRef acc, const Unit& u, int wr, int wc, int fr, int fq) const {
        int tid = threadIdx.x; asm volatile("" : "+v"(tid));
#pragma unroll
        for (int ai = 0; ai < 2; ++ai)
#pragma unroll
            for (int m = 0; m < 4; ++m) {
                const int row = u.pm * 256 + ai * 128 + wr * 64 + m * 16 + fr;
#pragma unroll
                for (int bj = 0; bj < 2; ++bj) {
                    const int col = u.pn * 256 + bj * 128 + wc * 32 + 8 * fq;
                    const int q = (ai * 2 + bj) * 4 + m;
                    const u32x4 gw = *(const u32x4*)(GT + ((size_t)q * 512 + tid) * 8);
                    f32x4 v0 = acc[ai][bj][m][0], v1 = acc[ai][bj][m][1];
                    v0[0] *= bflo(gw.x); v0[1] *= bfhi(gw.x); v0[2] *= bflo(gw.y); v0[3] *= bfhi(gw.y);
                    v1[0] *= bflo(gw.z); v1[1] *= bfhi(gw.z); v1[2] *= bflo(gw.w); v1[3] *= bfhi(gw.w);
                    bf16* dst = MG + (size_t)row * 1024 + col;
                    if (!first) {
                        const u32x4 ow = *(const u32x4*)dst;
                        v0[0] += bflo(ow.x); v0[1] += bfhi(ow.x); v0[2] += bflo(ow.y); v0[3] += bfhi(ow.y);
                        v1[0] += bflo(ow.z); v1[1] += bfhi(ow.z); v1[2] += bflo(ow.w); v1[3] += bfhi(ow.w);
                    }
                    *(u32x4*)dst = pack8(v0, v1);
                }
                asm volatile("" ::: "memory");
            }
    }
};
struct EpiF32 {
    static constexpr bool PERM = false, AFTER_DRAIN = false;
    float* C; int ldc;
    __device__ __forceinline__ void operator()(AccRef acc, const Unit& u, int wr, int wc, int fr, int fq) const {
        const int row0 = u.pm * 256 + wr * 64 + fr, col0 = u.pn * 256 + wc * 32 + 4 * fq;
#pragma unroll
        for (int ai = 0; ai < 2; ++ai)
#pragma unroll
            for (int m = 0; m < 4; ++m) { float* rowp = C + (size_t)(row0 + ai * 128 + m * 16) * ldc + col0;
#pragma unroll
                for (int bj = 0; bj < 2; ++bj)
#pragma unroll
                    for (int n = 0; n < 2; ++n) *(f32x4*)(rowp + bj * 128 + n * 16) = acc[ai][bj][m][n]; }
    }
};
struct EpiSwiGLU {
    static constexpr bool PERM = true, AFTER_DRAIN = false;
    bf16* U;
    __device__ __forceinline__ void operator()(AccRef acc, const Unit& u, int wr, int wc, int fr, int fq) const {
#pragma unroll
        for (int ai = 0; ai < 2; ++ai)
#pragma unroll
            for (int m = 0; m < 4; ++m) {
                const int row = u.pm * 256 + ai * 128 + wr * 64 + m * 16 + fr;
                f32x4 g0 = acc[ai][0][m][0], g1 = acc[ai][0][m][1]; const f32x4 u0 = acc[ai][1][m][0], u1 = acc[ai][1][m][1];
#pragma unroll
                for (int e = 0; e < 4; ++e) { g0[e] = siluf_(g0[e]) * u0[e]; g1[e] = siluf_(g1[e]) * u1[e]; }
                *(u32x4*)(U + (size_t)row * DFF + u.pn * 128 + wc * 32 + 8 * fq) = pack8(g0, g1);
                asm volatile("" ::: "memory");
            }
    }
};

struct RangeOrder {
    int nM, first, cnt, c;
    __device__ bool next(int i, Unit& u) const { const int L = (c - first) + i * cnt; if (c < first || c >= first + cnt || L >= nM) return false; u.pm = L; u.pn = 0; return true; }
};
struct EpiCompress {
    static constexpr bool PERM = false, AFTER_DRAIN = true;
    const float* b1; const float* w2; bf16* out;
    __device__ __forceinline__ void fused(AccRef acc, const Unit& u, int wr, int wc, int fr, int fq, LAS unsigned char* lds, int tid) const {
        constexpr int HST = 272;
#pragma unroll
        for (int ai = 0; ai < 2; ++ai)
#pragma unroll
            for (int m = 0; m < 4; ++m) {
                const int row = ai * 128 + wr * 64 + m * 16 + fr;
#pragma unroll
                for (int n = 0; n < 2; ++n) {
                    const int col = wc * 32 + 16 * n + 4 * fq;
                    const f32x4 bv = *(const f32x4*)(b1 + col); const f32x4 v = acc[ai][0][m][n] + bv;
                    u32x2 w; w.x = pk2(siluf_(v[0]), siluf_(v[1])); w.y = pk2(siluf_(v[2]), siluf_(v[3]));
                    *(LAS u32x2*)(lds + row * HST + col * 2) = w;
                }
            }
        __syncthreads();
        const int row = tid >> 1, d0 = (tid & 1) * 32;
        float o[32];
#pragma unroll
        for (int d = 0; d < 32; ++d) o[d] = 0.f;
#pragma unroll 2
        for (int j = 0; j < 128; ++j) {
            const float hv = bf2f(*(const LAS unsigned short*)(lds + row * HST + j * 2));
#pragma unroll
            for (int q = 0; q < 8; ++q) { const f32x4 wv = *(const f32x4*)(w2 + j * 64 + d0 + 4 * q); o[4 * q] += hv * wv[0]; o[4 * q + 1] += hv * wv[1]; o[4 * q + 2] += hv * wv[2]; o[4 * q + 3] += hv * wv[3]; }
        }
        bf16* dst = out + ((size_t)(u.pm * 256 + row)) * 64 + d0;
        const float z = row == 255 ? 0.f : 1.f;
#pragma unroll
        for (int q = 0; q < 4; ++q) {
            u32x4 w; w.x = pk2(o[8 * q] * z, o[8 * q + 1] * z); w.y = pk2(o[8 * q + 2] * z, o[8 * q + 3] * z); w.z = pk2(o[8 * q + 4] * z, o[8 * q + 5] * z); w.w = pk2(o[8 * q + 6] * z, o[8 * q + 7] * z);
            *(u32x4*)(dst + 8 * q) = w;
        }
        __syncthreads();
    }
};

struct ColSrc { const float* p; float cs; };
template <class Map>
__device__ __forceinline__ void tr_item(const Map& mp, int ldw, const float* kscale, bf16* WT, int ldt, int nblk, int item, LAS float* scr, int lane) {
    const int kb = item / nblk, nb = item % nblk, k0 = 64 * kb, n0 = 32 * nb;
    const ColSrc cs = mp(n0 + (lane & 31));
#pragma unroll 8
    for (int i = 0; i < 32; ++i) { const int kk = 2 * i + (lane >> 5); const int k = k0 + kk;
        float v = 0.f; if (cs.p) { v = cs.p[(size_t)k * ldw] * cs.cs; if (kscale) v *= kscale[k]; }
        scr[kk * 33 + (lane & 31)] = v; }
    asm volatile("s_waitcnt lgkmcnt(0)" ::: "memory");
    const int c = lane & 7;
#pragma unroll
    for (int j = 0; j < 4; ++j) { const int n = (lane >> 3) + 8 * j; const LAS float* s = scr + (8 * c) * 33 + n;
        u32x4 o; o.x = pk2(s[0 * 33], s[1 * 33]); o.y = pk2(s[2 * 33], s[3 * 33]); o.z = pk2(s[4 * 33], s[5 * 33]); o.w = pk2(s[6 * 33], s[7 * 33]);
        *(u32x4*)(WT + (size_t)(n0 + n) * ldt + k0 + 8 * c) = o; }
    asm volatile("s_waitcnt lgkmcnt(0)" ::: "memory");
}
struct MapIn {
    const float* W;
    __device__ __forceinline__ ColSrc operator()(int n) const {
        int src; float cs = 1.f;
        if (n < 1536) src = n;
        else if (n < 2048) { src = 1544 + (n - 1536); cs = QSCALE_NSA; }
        else if (n < 2816) src = 2056 + (n - 2048);
        else if (n < 3200) src = 2848 + (n - 2816);
        else if (n < 3488) src = 3232 + (n - 3200);
        else if (n < 3496) src = 1536 + (n - 3488);
        else if (n < 3520) src = 2824 + (n - 3496);
        else src = -1;
        ColSrc r; r.p = src >= 0 ? W + src : nullptr; r.cs = cs; return r;
    }
};
struct MapPlain { const float* W; int off; float cs; __device__ __forceinline__ ColSrc operator()(int n) const { ColSrc r; r.p = W + off + n; r.cs = cs; return r; } };
struct MapPad { const float* W; int nvalid; __device__ __forceinline__ ColSrc operator()(int n) const { ColSrc r; r.p = n < nvalid ? W + n : nullptr; r.cs = 1.f; return r; } };
struct MapGU { const float* Wg; const float* Wu; __device__ __forceinline__ ColSrc operator()(int n) const { const int j = n >> 8, w = n & 255; ColSrc r; r.p = (w < 128 ? Wg : Wu) + 128 * j + (w & 127); r.cs = 1.f; return r; } };

__device__ __forceinline__ void row_resnorm(const float* xin, const float* delta, const float* gain, float* xout, bf16* xb, int lane) {
    f32x4 v[4];
#pragma unroll
    for (int j = 0; j < 4; ++j) v[j] = ((const f32x4*)xin)[lane + 64 * j];
    if (delta) {
        f32x4 d[4]; float s = 0.f;
#pragma unroll
        for (int j = 0; j < 4; ++j) { d[j] = ((const f32x4*)delta)[lane + 64 * j]; s += (d[j][0] * d[j][0] + d[j][1] * d[j][1]) + (d[j][2] * d[j][2] + d[j][3] * d[j][3]); }
        const float rstd = rsqrtf(wave_sum(s) * (1.0f / DM) + EPS);
#pragma unroll
        for (int j = 0; j < 4; ++j) { const f32x4 g = ((const f32x4*)gain)[lane + 64 * j]; v[j] = v[j] + g * d[j] * rstd; }
    }
    if (xout) {
#pragma unroll
        for (int j = 0; j < 4; ++j) ((f32x4*)xout)[lane + 64 * j] = v[j];
    }
    float s2 = 0.f;
#pragma unroll
    for (int j = 0; j < 4; ++j) s2 += (v[j][0] * v[j][0] + v[j][1] * v[j][1]) + (v[j][2] * v[j][2] + v[j][3] * v[j][3]);
    const float r2 = rsqrtf(wave_sum(s2) * (1.0f / DM) + EPS);
#pragma unroll
    for (int j = 0; j < 4; ++j) { u32x2 w; w.x = pk2(v[j][0] * r2, v[j][1] * r2); w.y = pk2(v[j][2] * r2, v[j][3] * r2); ((u32x2*)xb)[lane + 64 * j] = w; }
}

template <int NH, bool EXT>
__device__ __forceinline__ void nattn_block(const float* qs, const bf16* Kb, int ldk, const bf16* K2b, int ldk2, const bf16* Vb, int ldv,
                                            const bool (&valid)[NH], float (&m)[NH], float (&l)[NH], float (&o)[NH], int lane) {
    constexpr int QD = EXT ? 96 : 64;
    float s[NH];
#pragma unroll
    for (int h = 0; h < NH; ++h) s[h] = 0.f;
    const u32x4* kp = (const u32x4*)(Kb + (size_t)lane * ldk);
#pragma unroll
    for (int c = 0; c < 8; ++c) {
        asm volatile("" ::: "memory");
        const u32x4 kk = kp[c];
        const float kf[8] = {bflo(kk.x), bfhi(kk.x), bflo(kk.y), bfhi(kk.y), bflo(kk.z), bfhi(kk.z), bflo(kk.w), bfhi(kk.w)};
#pragma unroll
        for (int h = 0; h < NH; ++h)
#pragma unroll
            for (int e = 0; e < 8; ++e) s[h] += qs[h * QD + 8 * c + e] * kf[e];
    }
    if (EXT) {
        const u32x4* k2 = (const u32x4*)(K2b + (size_t)lane * ldk2);
#pragma unroll
        for (int c = 0; c < 4; ++c) {
            asm volatile("" ::: "memory");
            const u32x4 kk = k2[c];
            const float kf[8] = {bflo(kk.x), bfhi(kk.x), bflo(kk.y), bfhi(kk.y), bflo(kk.z), bfhi(kk.z), bflo(kk.w), bfhi(kk.w)};
#pragma unroll
            for (int h = 0; h < NH; ++h)
#pragma unroll
                for (int e = 0; e < 8; ++e) s[h] += qs[h * QD + 64 + 8 * c + e] * kf[e];
        }
    }
    float p[NH];
#pragma unroll
    for (int h = 0; h < NH; ++h) {
        const float sv = valid[h] ? s[h] : -INFINITY;
        const float bm = wave_max(sv);
        const float mn = fmaxf(m[h], bm);
        if (mn == -INFINITY) { p[h] = 0.f; continue; }
        const float alpha = exp2f(m[h] - mn);
        p[h] = valid[h] ? exp2f(s[h] - mn) : 0.f;
        l[h] = l[h] * alpha + wave_sum(p[h]); o[h] *= alpha; m[h] = mn;
    }
#pragma unroll 8
    for (int key = 0; key < 64; ++key) {
        const float vv = bf2f(Vb[(size_t)key * ldv + lane]);
#pragma unroll
        for (int h = 0; h < NH; ++h) o[h] += rdlane(p[h], key) * vv;
    }
}

struct Args { const void* in[19]; float* out; unsigned char* ws; };

struct Ctx {
    const float *x_in; const int* positions; float* XS;
    float *ROPE, *SM, *SSQ; unsigned long long* SEL; float* KCMP; bf16* KCB; bf16* CL; float *NL, *MLOC, *BLV, *MS; bf16* W_C1; float* B1;
    bf16 *W_IN, *W_G, *W_UQ, *W_UKV, *W_BR, *W_OUT, *W_GU, *W_DN;
    bf16 *XB, *AV, *AO, *BQ, *BKV, *AQK, *CQKV, *QM, *KN, *VM, *KR, *P1, *GTall, *MERGED, *U; float *MIX, *FD;
    const float *gains, *w_in, *m_conv, *m_gbias, *m_hnorm, *cmp_pos, *cmp_w1, *cmp_w2, *q_norm, *kv_norm, *w_uq, *w_ukv, *w_branch, *w_out, *w_fg, *w_fu, *w_fd;
};
__device__ __forceinline__ Ctx make_ctx(const Args& args, int layer) {
    Ctx c; unsigned char* ws = args.ws;
    c.x_in = (const float*)args.in[0]; c.positions = (const int*)args.in[1]; c.XS = args.out;
    c.ROPE = (float*)(ws + WS_ROPE); c.SM = (float*)(ws + WS_SM); c.SSQ = (float*)(ws + WS_SSQ); c.SEL = (unsigned long long*)(ws + WS_SEL); c.KCMP = (float*)(ws + WS_KCMP); c.KCB = (bf16*)(ws + WS_KCB); c.CL = (bf16*)(ws + WS_CL); c.NL = (float*)(ws + WS_NL); c.MLOC = (float*)(ws + WS_MSC); c.BLV = c.MLOC + 1024; c.MS = c.MLOC + 2048; c.W_C1 = (bf16*)(ws + WS_WC1); c.B1 = (float*)(ws + WS_B1);
    c.W_IN = (bf16*)(ws + WS_WIN); c.W_G = (bf16*)(ws + WS_WG); c.W_UQ = (bf16*)(ws + WS_WUQ); c.W_UKV = (bf16*)(ws + WS_WUKV);
    c.W_BR = (bf16*)(ws + WS_WBR); c.W_OUT = (bf16*)(ws + WS_WOUT); c.W_GU = (bf16*)(ws + WS_WGU); c.W_DN = (bf16*)(ws + WS_WDN);
    c.XB = (bf16*)(ws + WS_XB); c.AV = (bf16*)(ws + WS_AV); c.AO = (bf16*)(ws + WS_AO); c.BQ = (bf16*)(ws + WS_BQ); c.BKV = (bf16*)(ws + WS_BKV);
    c.AQK = (bf16*)(ws + WS_AQK); c.CQKV = (bf16*)(ws + WS_CQKV); c.QM = (bf16*)(ws + WS_QM); c.KN = (bf16*)(ws + WS_KN); c.VM = (bf16*)(ws + WS_VM);
    c.KR = (bf16*)(ws + WS_KR); c.P1 = (bf16*)(ws + WS_P1); c.GTall = (bf16*)(ws + WS_GT); c.MERGED = (bf16*)(ws + WS_MERGED);
    c.MIX = (float*)(ws + WS_MIX); c.U = (bf16*)(ws + WS_U); c.FD = (float*)(ws + WS_FD);
    c.gains = (const float*)args.in[2] + (size_t)layer * 4 * DM;
    c.w_in = (const float*)args.in[3] + (size_t)layer * DM * DIN;
    c.m_conv = (const float*)args.in[4] + (size_t)layer * 4 * 512;
    c.m_gbias = (const float*)args.in[5] + layer * 8;
    c.m_hnorm = (const float*)args.in[6] + layer * 512;
    c.cmp_pos = (const float*)args.in[7] + (size_t)layer * 2 * 2048;
    c.cmp_w1 = (const float*)args.in[8] + (size_t)layer * 2 * 2048 * 128;
    c.cmp_w2 = (const float*)args.in[9] + (size_t)layer * 2 * 128 * 64;
    c.q_norm = (const float*)args.in[10] + layer * 384;
    c.kv_norm = (const float*)args.in[11] + layer * 256;
    c.w_uq = (const float*)args.in[12] + (size_t)layer * 384 * 768;
    c.w_ukv = (const float*)args.in[13] + (size_t)layer * 256 * 1024;
    c.w_branch = (const float*)args.in[14] + (size_t)layer * 3 * 512 * 1024;
    c.w_out = (const float*)args.in[15] + (size_t)layer * DM * DM;
    c.w_fg = (const float*)args.in[16] + (size_t)layer * DM * DFF;
    c.w_fu = (const float*)args.in[17] + (size_t)layer * DM * DFF;
    c.w_fd = (const float*)args.in[18] + (size_t)layer * DFF * DM;
    return c;
}

#define PHASE_IDS int tid_o = threadIdx.x; asm volatile("" : "+v"(tid_o)); const int tid = tid_o, lane = tid & 63, wave = __builtin_amdgcn_readfirstlane(tid >> 6), gw = blk * 8 + wave; \
    LAS float* wscr = (LAS float*)(lds + wave * 16384); (void)wscr; (void)gw; (void)lane; (void)tid

enum { PH_P0 = 0, PH_A2, PH_B, PH_E, PH_F, PH_F2, PH_G, PH_H, PH_H2 };

template <int PH>
__device__ __forceinline__ void run_phase(const Args& args, int layer, unsigned char* lds_raw) {
    LAS unsigned char* lds = (LAS unsigned char*)lds_raw;
    const int G = gridDim.x, blk = blockIdx.x, NGW = G * 8;
    const Ctx c = make_ctx(args, layer);
    if constexpr (PH == PH_P0) {
        PHASE_IDS;
        constexpr int I_IN = (DM / 64) * (NZ / 32), I_G = (DM / 64) * (3072 / 32), I_UQ = (384 / 64) * (768 / 32), I_UKV = (256 / 64) * (1024 / 32);
        constexpr int I_BR = (512 / 64) * (1024 / 32), I_OUT = (DM / 64) * (DM / 32);
        constexpr int I_C1 = (2048 / 64) * (256 / 32);
        constexpr int NIT = I_IN + I_G + I_UQ + I_UKV + 3 * I_BR + I_OUT + 2 * I_C1;
#pragma unroll 1
        for (int it = gw; it < NIT; it += NGW) {
            int r = it;
            if (r < I_IN) { tr_item(MapIn{c.w_in}, DIN, c.gains, c.W_IN, DM, NZ / 32, r, wscr, lane); continue; } r -= I_IN;
            if (r < I_G) { tr_item(MapPlain{c.w_in, 3520, 1.f}, DIN, c.gains, c.W_G, DM, 3072 / 32, r, wscr, lane); continue; } r -= I_G;
            if (r < I_UQ) { tr_item(MapPlain{c.w_uq, 0, QSCALE_MLA}, 768, c.q_norm, c.W_UQ, 384, 768 / 32, r, wscr, lane); continue; } r -= I_UQ;
            if (r < I_UKV) { tr_item(MapPlain{c.w_ukv, 0, 1.f}, 1024, c.kv_norm, c.W_UKV, 256, 1024 / 32, r, wscr, lane); continue; } r -= I_UKV;
            if (r < 3 * I_BR) { const int br = r / I_BR; tr_item(MapPlain{c.w_branch + (size_t)br * 512 * 1024, 0, 1.f}, 1024, nullptr, c.W_BR + (size_t)br * 1024 * 512, 512, 1024 / 32, r % I_BR, wscr, lane); continue; } r -= 3 * I_BR;
            if (r < I_OUT) { tr_item(MapPlain{c.w_out, 0, 1.f}, DM, nullptr, c.W_OUT, DM, DM / 32, r, wscr, lane); continue; } r -= I_OUT;
            { const int kv = r / I_C1; tr_item(MapPad{c.cmp_w1 + (size_t)kv * 2048 * 128, 128}, 128, nullptr, c.W_C1 + (size_t)kv * 256 * 2048, 2048, 256 / 32, r % I_C1, wscr, lane); }
        }
#pragma unroll 1
        for (int o = gw; o < 256; o += NGW) {
            const int kv = o >> 7, j = o & 127; float a = 0.f;
            for (int k = lane; k < 2048; k += 64) a += c.cmp_pos[kv * 2048 + k] * c.cmp_w1[((size_t)kv * 2048 + k) * 128 + j];
            a = wave_sum(a); if (lane == 0) c.B1[o] = a;
        }
        if (layer == 0) {
#pragma unroll 1
            for (int i = blk * 512 + tid; i < T * 16; i += G * 512) {
                const int t = i >> 4, d = i & 15;
                const double f4 = (d & 3) == 0 ? 1.0 : (d & 3) == 1 ? 0.5623413251903491 : (d & 3) == 2 ? 0.31622776601683794 : 0.1778279410038923;
                const double f1 = (d >> 2) == 0 ? 1.0 : (d >> 2) == 1 ? 0.1 : (d >> 2) == 2 ? 0.01 : 0.001;
                const double ang = (double)c.positions[t] * (f4 * f1);
                const double q = rint(ang * 0.6366197723675814);
                const double y = fma(-q, 6.123233995736766e-17, fma(-q, 1.5707963267948966, ang));
                const double y2 = y * y;
                const double sy = y * (1.0 + y2 * (-1.0 / 6 + y2 * (1.0 / 120 + y2 * (-1.0 / 5040 + y2 * (1.0 / 362880 + y2 * (-1.0 / 39916800))))));
                const double cy = 1.0 + y2 * (-0.5 + y2 * (1.0 / 24 + y2 * (-1.0 / 720 + y2 * (1.0 / 40320 + y2 * (-1.0 / 3628800 + y2 * (1.0 / 479001600))))));
                const int qi = (int)q & 3;
                const double cs = qi == 0 ? cy : qi == 1 ? -sy : qi == 2 ? -cy : sy;
                const double sn = qi == 0 ? sy : qi == 1 ? cy : qi == 2 ? -sy : -cy;
                c.ROPE[2 * (size_t)i] = (float)cs; c.ROPE[2 * (size_t)i + 1] = (float)sn;
            }
#pragma unroll 1
            for (int m = gw; m < T; m += NGW) row_resnorm(c.x_in + (size_t)m * DM, nullptr, nullptr, nullptr, c.XB + (size_t)m * DM, lane);
        }
    }
    if constexpr (PH == PH_A2) {
        pg8::Gemm g{c.XB, c.W_IN}; pg8::StaticOrder S; S.init(T, NZ, G, blk);
        EpiInProj E{c.AQK, c.AV, c.AO, c.BQ, c.BKV, c.CQKV, c.KR, c.SM, c.SSQ, c.ROPE, c.m_gbias};
        pg8::gemm_phase<DM, DM, DM, 128>(lds, g, S, E);
    }
    if constexpr (PH == PH_B) {
        { pg8::Gemm g{c.CQKV, c.W_UQ}; pg8::StaticOrder S; S.init(T, 768, G, blk); EpiMlaQ E{c.QM, c.SSQ, c.ROPE}; pg8::gemm_phase<384, 640, 384, 128>(lds, g, S, E); }
        { pg8::Gemm g{c.CQKV + 384, c.W_UKV}; pg8::StaticOrder S; S.init(T, 1024, G, blk); EpiMlaKV E{c.KN, c.VM, c.SSQ}; pg8::gemm_phase<256, 640, 256, 128>(lds, g, S, E); }
        { pg8::Gemm g{c.BKV, c.W_C1}; RangeOrder S{8, G - 16, 8, blk}; EpiCompress E{c.B1, c.cmp_w2, c.KCB}; pg8::gemm_phase<2048, 1024, 2048, 128>(lds, g, S, E); }
        { pg8::Gemm g{c.BKV + (size_t)NB * 2 * SEQ * 64, c.W_C1 + (size_t)256 * 2048}; RangeOrder S{8, G - 8, 8, blk}; EpiCompress E{c.B1 + 128, c.cmp_w2 + 128 * 64, c.KCB + (size_t)8 * 256 * 64}; pg8::gemm_phase<2048, 1024, 2048, 128>(lds, g, S, E); }
    }
    if constexpr (PH == PH_E) {
        pg8::StaticOrder S; S.init(T, DM, G, blk);
        bf16* GT = c.GTall + (size_t)blk * 65536;
        { pg8::Gemm g{c.XB, c.W_G}; EpiGate E{GT}; pg8::gemm_phase<DM, DM, DM, 128>(lds, g, S, E); }
        { pg8::Gemm g{c.AV, c.W_BR}; EpiBranch E{GT, c.MERGED, 1}; pg8::gemm_phase<512, 512, 512, 128>(lds, g, S, E); }
        { pg8::Gemm g{c.XB, c.W_G + (size_t)1024 * 1024}; EpiGate E{GT}; pg8::gemm_phase<DM, DM, DM, 128>(lds, g, S, E); }
        { pg8::Gemm g{c.BQ, c.W_BR + (size_t)1024 * 512}; EpiBranch E{GT, c.MERGED, 0}; pg8::gemm_phase<512, 512, 512, 128>(lds, g, S, E); }
        { pg8::Gemm g{c.XB, c.W_G + (size_t)2 * 1024 * 1024}; EpiGate E{GT}; pg8::gemm_phase<DM, DM, DM, 128>(lds, g, S, E); }
        { pg8::Gemm g{c.QM, c.W_BR + (size_t)2 * 1024 * 512}; EpiBranch E{GT, c.MERGED, 0}; pg8::gemm_phase<512, 768, 512, 192>(lds, g, S, E); }
    }
    if constexpr (PH == PH_F) {
        {
            PHASE_IDS;
            constexpr int I_GU = (DM / 64) * (2 * DFF / 32), I_DN = (DFF / 64) * (DM / 32);
#pragma unroll 1
            for (int it = gw; it < I_GU + I_DN; it += NGW) {
                if (it < I_GU) {
                    const int n0 = 32 * (it % (2 * DFF / 32)), j = n0 >> 8, w = n0 & 255;
                    if (w < 128) tr_item(MapPlain{c.w_fg, 128 * j + w - n0, 1.f}, DFF, c.gains + 2 * DM, c.W_GU, DM, 2 * DFF / 32, it, wscr, lane);
                    else tr_item(MapPlain{c.w_fu, 128 * j + (w - 128) - n0, 1.f}, DFF, c.gains + 2 * DM, c.W_GU, DM, 2 * DFF / 32, it, wscr, lane);
                }
                else tr_item(MapPlain{c.w_fd, 0, 1.f}, DM, nullptr, c.W_DN, DFF, DM / 32, it - I_GU, wscr, lane);
            }
        }
        __syncthreads();
        pg8::Gemm g{c.MERGED, c.W_OUT}; pg8::StaticOrder S; S.init(T, DM, G, blk); EpiF32 E{c.MIX, DM};
        pg8::gemm_phase<DM, DM, DM, 128>(lds, g, S, E);
    }
    if constexpr (PH == PH_F2) {
        PHASE_IDS;
#pragma unroll 1
        for (int m = gw; m < T; m += NGW) row_resnorm((layer == 0 ? c.x_in : c.XS) + (size_t)m * DM, c.MIX + (size_t)m * DM, c.gains + DM, c.XS + (size_t)m * DM, c.XB + (size_t)m * DM, lane);
    }
    if constexpr (PH == PH_G) {
        pg8::Gemm g{c.XB, c.W_GU}; pg8::StaticOrder S; S.init(T, 2 * DFF, G, blk); EpiSwiGLU E{c.U};
        pg8::gemm_phase<DM, DM, DM, 128>(lds, g, S, E);
    }
    if constexpr (PH == PH_H) {
        pg8::Gemm g{c.U, c.W_DN}; pg8::StaticOrder S; S.init(T, DM, G, blk); EpiF32 E{c.FD, DM};
        pg8::gemm_phase<DFF, DFF, DFF, 128>(lds, g, S, E);
    }
    if constexpr (PH == PH_H2) {
        PHASE_IDS;
#pragma unroll 1
        for (int m = gw; m < T; m += NGW) row_resnorm(c.XS + (size_t)m * DM, c.FD + (size_t)m * DM, c.gains + 3 * DM, c.XS + (size_t)m * DM, c.XB + (size_t)m * DM, lane);
    }
}
template <int PH>
__global__ void __launch_bounds__(512, 2) k_phase(Args args, int layer) {
    extern __shared__ __attribute__((aligned(16))) unsigned char lds_raw[];
    run_phase<PH>(args, layer, lds_raw);
}

namespace att {
typedef float f32x16 __attribute__((ext_vector_type(16)));
typedef short s16x4 __attribute__((ext_vector_type(4)));
constexpr int VST = 192;
__device__ __forceinline__ int crow(int r, int hi) { return (r & 3) + 8 * (r >> 2) + 4 * hi; }
__device__ __forceinline__ s16x4 vtr(const LAS unsigned char* p) { return __builtin_bit_cast(s16x4, __builtin_amdgcn_ds_read_tr16_b64_v4i16((LAS s16x4*)p)); }
__device__ __forceinline__ bf16x8 pack8f(const f32x16& p, int b) {
    u32x4 w; w.x = pk2(p[b], p[b + 1]); w.y = pk2(p[b + 2], p[b + 3]); w.z = pk2(p[b + 4], p[b + 5]); w.w = pk2(p[b + 6], p[b + 7]);
    return __builtin_bit_cast(bf16x8, w);
}
struct Pass {
    f32x16 o[2]; float l;
};
template <int DQK, int MODE>
__device__ __forceinline__ Pass attn_pass(LAS unsigned char* lds, const bf16x8* qf, const bf16* K1, int ld1, const bf16* K2, int ld2, const bf16* V, int ldv,
                                          unsigned long long tmask, int qpos, unsigned long long sel, int q0) {
    constexpr int KST = DQK == 96 ? 208 : 144;
    constexpr int KBYTES = 64 * KST, VBYTES = 64 * VST, BUF = KBYTES + VBYTES;
    int tid_o = threadIdx.x; asm volatile("" : "+v"(tid_o));
    const int tid = tid_o, lane = tid & 63, hi = lane >> 5, r32 = lane & 31;
    Pass R; R.o[0] = f32x16{}; R.o[1] = f32x16{}; float m = -INFINITY, l = 0.f;
    const int skey = tid >> 3, sch = tid & 7;
    u32x4 kreg, vreg, k2reg;
    unsigned mlo = (unsigned)tmask, mhi = (unsigned)(tmask >> 32);
    auto next_tile = [&]() -> int {
        int j;
        if (mlo) { j = __builtin_ctz(mlo); mlo &= mlo - 1; } else if (mhi) { j = 32 + __builtin_ctz(mhi); mhi &= mhi - 1; } else j = -1;
        return j;
    };
    int jcur = next_tile();
    if (jcur < 0) { R.l = 0.f; return R; }
    auto gload = [&](int j) {
        kreg = *(const u32x4*)(K1 + (size_t)(j * 64 + skey) * ld1 + sch * 8);
        vreg = *(const u32x4*)(V + (size_t)(j * 64 + skey) * ldv + sch * 8);
        if (DQK == 96) { if (tid < 256) k2reg = *(const u32x4*)(K2 + (size_t)(j * 64 + (tid >> 2)) * ld2 + (tid & 3) * 8); }
    };
    auto lstore = [&](int buf) {
        LAS unsigned char* kb = lds + buf * BUF; LAS unsigned char* vb = kb + KBYTES;
        *(LAS u32x4*)(kb + skey * KST + sch * 16) = kreg;
        *(LAS u32x4*)(vb + skey * VST + sch * 16) = vreg;
        if (DQK == 96) { if (tid < 256) *(LAS u32x4*)(kb + (tid >> 2) * KST + 128 + (tid & 3) * 16) = k2reg; }
    };
    gload(jcur); lstore(0);
    __syncthreads();
    int buf = 0;
    const int vlane = (4 * hi + ((lane & 15) >> 2)) * VST + (16 * ((lane >> 4) & 1) + 4 * (lane & 3)) * 2;
    while (jcur >= 0) {
        const int jnext = next_tile();
        if (jnext >= 0) gload(jnext);
        const LAS unsigned char* kb = lds + buf * BUF; const LAS unsigned char* vb = kb + KBYTES;
        f32x16 p0 = f32x16{}, p1 = f32x16{};
#pragma unroll
        for (int s = 0; s < DQK / 16; ++s) {
            const bf16x8 k0 = *(const LAS bf16x8*)(kb + r32 * KST + s * 32 + hi * 16);
            const bf16x8 k1 = *(const LAS bf16x8*)(kb + (32 + r32) * KST + s * 32 + hi * 16);
            p0 = __builtin_amdgcn_mfma_f32_32x32x16_bf16(k0, qf[s], p0, 0, 0, 0);
            p1 = __builtin_amdgcn_mfma_f32_32x32x16_bf16(k1, qf[s], p1, 0, 0, 0);
        }
        bool need = true;
        if (MODE == 0) need = (jcur * 64 + 63 > q0);
        if (need) {
            const int kbase = jcur * 64 + 4 * hi;
            bool rowok = true;
            if (MODE == 1) rowok = (sel >> jcur) & 1ull;
#pragma unroll
            for (int r = 0; r < 16; ++r) {
                const int k0i = kbase + (r & 3) + 8 * (r >> 2), k1i = k0i + 32;
                bool ok0 = rowok && (k0i <= qpos), ok1 = rowok && (k1i <= qpos);
                if (MODE == 2) { ok0 = ok0 && (qpos - k0i < 512); ok1 = ok1 && (qpos - k1i < 512); }
                if (!ok0) p0[r] = -INFINITY;
                if (!ok1) p1[r] = -INFINITY;
            }
        }
        float rm = fmaxf(p0[0], p1[0]);
#pragma unroll
        for (int r = 1; r < 16; ++r) rm = fmaxf(rm, fmaxf(p0[r], p1[r]));
        rm = fmaxf(rm, __shfl_xor(rm, 32));
        const float mn = fmaxf(m, rm);
        const float ms = (mn == -INFINITY) ? 0.f : mn;
        const float alpha = exp2f(m - ms);
        m = mn;
        float ps = 0.f;
#pragma unroll
        for (int r = 0; r < 16; ++r) { p0[r] = exp2f(p0[r] - ms); p1[r] = exp2f(p1[r] - ms); ps += p0[r] + p1[r]; }
        l = l * alpha + ps;
#pragma unroll
        for (int r = 0; r < 16; ++r) { R.o[0][r] *= alpha; R.o[1][r] *= alpha; }
        bf16x8 pb[4];
        pb[0] = pack8f(p0, 0); pb[1] = pack8f(p0, 8); pb[2] = pack8f(p1, 0); pb[3] = pack8f(p1, 8);
#pragma unroll
        for (int db = 0; db < 2; ++db)
#pragma unroll
            for (int ks = 0; ks < 4; ++ks) {
                const LAS unsigned char* vp = vb + ks * 16 * VST + db * 64 + vlane;
                const s16x4 lo = vtr(vp), hh = vtr(vp + 8 * VST);
                const bf16x8 vf = (bf16x8){lo[0], lo[1], lo[2], lo[3], hh[0], hh[1], hh[2], hh[3]};
                R.o[db] = __builtin_amdgcn_mfma_f32_32x32x16_bf16(vf, pb[ks], R.o[db], 0, 0, 0);
            }
        if (jnext >= 0) lstore(buf ^ 1);
        __syncthreads();
        buf ^= 1; jcur = jnext;
    }
    R.l = l + __shfl_xor(l, 32);
    return R;
}
}

constexpr int ATT_LDS = 2 * (64 * 208 + 64 * att::VST);

__device__ __forceinline__ void mla_attn_phase(const Ctx& c, LAS unsigned char* lds) {
    const int blk = blockIdx.x;
    const int bh = blk >> 3, b = bh >> 3, h = bh & 7;
    const bf16* Kh = c.KN + (size_t)(b * 8 + h) * SEQ * 64; const bf16* Vh = c.VM + (size_t)(b * 8 + h) * SEQ * 64; const bf16* Krh = c.KR + (size_t)b * SEQ * 32;
#pragma unroll 1
    for (int u = 0; u < 2; ++u) {
        int tid_o = threadIdx.x; asm volatile("" : "+v"(tid_o));
        const int tid = tid_o, lane = tid & 63, wave = tid >> 6, hi = lane >> 5, r32 = lane & 31;
        const int qb = u == 0 ? (blk & 7) : 15 - (blk & 7);
        const int q0 = qb * 256, qpos = q0 + wave * 32 + r32;
        bf16* qrow = c.QM + ((size_t)b * SEQ + qpos) * 768 + h * 96;
        bf16x8 qf[6];
#pragma unroll
        for (int s = 0; s < 6; ++s) qf[s] = *(const bf16x8*)(qrow + s * 16 + hi * 8);
        const int nt = (q0 + 256) / 64;
        const unsigned long long tmask = nt >= 64 ? ~0ull : ((1ull << nt) - 1ull);
        const att::Pass R = att::attn_pass<96, 0>(lds, qf, Kh, 64, Krh, 32, Vh, 64, tmask, qpos, 0ull, q0);
        const float inv = 1.0f / R.l;
#pragma unroll
        for (int db = 0; db < 2; ++db)
#pragma unroll
            for (int g4 = 0; g4 < 4; ++g4) {
                u32x2 w; w.x = pk2(R.o[db][4 * g4] * inv, R.o[db][4 * g4 + 1] * inv); w.y = pk2(R.o[db][4 * g4 + 2] * inv, R.o[db][4 * g4 + 3] * inv);
                *(u32x2*)(qrow + db * 32 + 8 * g4 + 4 * hi) = w;
            }
    }
}
__device__ __forceinline__ void nsa_attn_phase(const Ctx& c, LAS unsigned char* lds) {
    const int blk = blockIdx.x;
    const int bg = blk >> 5, b = bg >> 1, gg = bg & 1;
    const bf16* Ks = c.BKV + (size_t)((2 * NB + b) * 2 + gg) * SEQ * 64; const bf16* Vs = c.BKV + (size_t)((3 * NB + b) * 2 + gg) * SEQ * 64;
    const bf16* Kw = c.BKV + (size_t)((4 * NB + b) * 2 + gg) * SEQ * 64; const bf16* Vw = c.BKV + (size_t)((5 * NB + b) * 2 + gg) * SEQ * 64;
#pragma unroll 1
    for (int u = 0; u < 2; ++u) {
        int tid_o = threadIdx.x; asm volatile("" : "+v"(tid_o));
        const int tid = tid_o, lane = tid & 63, wave = tid >> 6, hi = lane >> 5, r32 = lane & 31;
        const int tt = u == 0 ? (blk & 31) : 63 - (blk & 31);
        const int q0 = tt * 64, row = wave * 32 + r32, qpos = q0 + (row >> 2), hh = gg * 4 + (row & 3);
        const size_t t = (size_t)b * SEQ + qpos;
        bf16* qrow = c.BQ + t * 512 + hh * 64;
        bf16x8 qf[4];
#pragma unroll
        for (int s = 0; s < 4; ++s) qf[s] = *(const bf16x8*)(qrow + s * 16 + hi * 8);
        const unsigned long long sel = c.SEL[t * 2 + gg];
        unsigned long long um = sel;
#pragma unroll
        for (int o = 1; o < 64; o <<= 1) { const unsigned lo = __shfl_xor((unsigned)um, o), hx = __shfl_xor((unsigned)(um >> 32), o); um |= ((unsigned long long)hx << 32) | lo; }
        LAS unsigned long long* ux = (LAS unsigned long long*)(lds + ATT_LDS);
        if (lane == 0) ux[wave] = um;
        __syncthreads();
        unsigned long long uall = 0ull;
#pragma unroll
        for (int w = 0; w < 8; ++w) uall |= ux[w];
        const unsigned ulo = __builtin_amdgcn_readfirstlane((unsigned)uall), uhi = __builtin_amdgcn_readfirstlane((unsigned)(uall >> 32));
        const unsigned long long tm_sel = (((unsigned long long)uhi << 32) | ulo) & (tt >= 63 ? ~0ull : ((1ull << (tt + 1)) - 1ull));
        const att::Pass Rs = att::attn_pass<64, 1>(lds, qf, Ks, 64, nullptr, 0, Vs, 64, tm_sel, qpos, sel, q0);
        const float gs = c.SM[t * 32 + 8 + hh * 3 + 1], gwn = c.SM[t * 32 + 8 + hh * 3 + 2];
        const float fs = Rs.l > 0.f ? gs / Rs.l : 0.f;
        att::f32x16 res[2];
#pragma unroll
        for (int db = 0; db < 2; ++db)
#pragma unroll
            for (int r = 0; r < 16; ++r) res[db][r] = Rs.o[db][r] * fs;
        const int j0 = tt >= 8 ? tt - 8 : 0;
        const unsigned long long tm_win = (tt >= 63 ? ~0ull : ((1ull << (tt + 1)) - 1ull)) & ~((1ull << j0) - 1ull);
        const att::Pass Rw = att::attn_pass<64, 2>(lds, qf, Kw, 64, nullptr, 0, Vw, 64, tm_win, qpos, 0ull, q0);
        const float fw = Rw.l > 0.f ? gwn / Rw.l : 0.f;
        const bf16* p1row = c.P1 + t * 512 + hh * 64;
#pragma unroll
        for (int db = 0; db < 2; ++db)
#pragma unroll
            for (int g4 = 0; g4 < 4; ++g4) {
                const u32x2 pw = *(const u32x2*)(p1row + db * 32 + 8 * g4 + 4 * hi);
                const float y0 = res[db][4 * g4] + Rw.o[db][4 * g4] * fw + bflo(pw.x), y1 = res[db][4 * g4 + 1] + Rw.o[db][4 * g4 + 1] * fw + bfhi(pw.x);
                const float y2 = res[db][4 * g4 + 2] + Rw.o[db][4 * g4 + 2] * fw + bflo(pw.y), y3 = res[db][4 * g4 + 3] + Rw.o[db][4 * g4 + 3] * fw + bfhi(pw.y);
                u32x2 w; w.x = pk2(y0, y1); w.y = pk2(y2, y3);
                *(u32x2*)(qrow + db * 32 + 8 * g4 + 4 * hi) = w;
            }
        __syncthreads();
    }
}
__device__ __forceinline__ void cmp_attn_phase(const Ctx& c, LAS unsigned char* lds) {
    using att::f32x16;
    constexpr int KST = 144, VST = att::VST, KOFF = 0, VOFF = 256 * KST, GOFF = VOFF + 256 * VST, LOFF = GOFF + 64 * 64 * 4;
    const int blk = blockIdx.x;
    const int bg = blk >> 5, b = bg >> 1, gg = bg & 1;
    const bf16* Kc = c.KCB + (size_t)(0 * 8 + bg) * 256 * 64; const bf16* Vc = c.KCB + (size_t)(1 * 8 + bg) * 256 * 64;
#pragma unroll 1
    for (int u = 0; u < 2; ++u) {
        int tid_o = threadIdx.x; asm volatile("" : "+v"(tid_o));
        const int tid = tid_o, lane = tid & 63, wave = tid >> 6, hi = lane >> 5, r32 = lane & 31;
        const int tt = u == 0 ? (blk & 31) : 63 - (blk & 31);
        const int q0 = tt * 64, row = wave * 32 + r32, qpos = q0 + (row >> 2), hh = gg * 4 + (row & 3);
        const size_t t = (size_t)b * SEQ + qpos;
        const bf16* qrow = c.BQ + t * 512 + hh * 64;
        bf16x8 qf[4];
#pragma unroll
        for (int s = 0; s < 4; ++s) qf[s] = *(const bf16x8*)(qrow + s * 16 + hi * 8);
        int ntile = ((q0 + 32) >> 4) / 64 + 1; if (ntile > 4) ntile = 4;
        for (int idx = tid; idx < ntile * 512; idx += 512) {
            const int key = idx >> 3, ch = idx & 7;
            *(LAS u32x4*)(lds + KOFF + key * KST + ch * 16) = *(const u32x4*)(Kc + (size_t)key * 64 + ch * 8);
            *(LAS u32x4*)(lds + VOFF + key * VST + ch * 16) = *(const u32x4*)(Vc + (size_t)key * 64 + ch * 8);
        }
        LAS float* Gs = (LAS float*)(lds + GOFF); LAS float* Ls = (LAS float*)(lds + LOFF);
#pragma unroll
        for (int i = 0; i < 8; ++i) { Gs[tid + 512 * i] = 0.f; Ls[tid + 512 * i] = 0.f; }
        __syncthreads();
        float m = -INFINITY, l = 0.f;
#pragma unroll 1
        for (int pass = 0; pass < 2; ++pass) {
            const float ms = (m == -INFINITY) ? 0.f : m;
            float inv = 0.f;
            if (pass == 1) { const float lt = l + __shfl_xor(l, 32); inv = lt > 0.f ? 1.0f / lt : 0.f; }
            f32x16 o0 = f32x16{}, o1 = f32x16{};
#pragma unroll 1
            for (int kt = 0; kt < ntile; ++kt) {
                const LAS unsigned char* kb = lds + KOFF + kt * 64 * KST;
                f32x16 p0 = f32x16{}, p1 = f32x16{};
#pragma unroll
                for (int s = 0; s < 4; ++s) {
                    const bf16x8 k0 = *(const LAS bf16x8*)(kb + r32 * KST + s * 32 + hi * 16);
                    const bf16x8 k1 = *(const LAS bf16x8*)(kb + (32 + r32) * KST + s * 32 + hi * 16);
                    p0 = __builtin_amdgcn_mfma_f32_32x32x16_bf16(k0, qf[s], p0, 0, 0, 0);
                    p1 = __builtin_amdgcn_mfma_f32_32x32x16_bf16(k1, qf[s], p1, 0, 0, 0);
                }
                const int nb0 = kt * 64 + 4 * hi;
#pragma unroll
                for (int r = 0; r < 16; ++r) {
                    const int n0 = nb0 + (r & 3) + 8 * (r >> 2), n1 = n0 + 32;
                    if (!((16 * n0 + 31 <= qpos) && n0 < 255)) p0[r] = -INFINITY;
                    if (!((16 * n1 + 31 <= qpos) && n1 < 255)) p1[r] = -INFINITY;
                }
                if (pass == 0) {
                    float rm = fmaxf(p0[0], p1[0]);
#pragma unroll
                    for (int r = 1; r < 16; ++r) rm = fmaxf(rm, fmaxf(p0[r], p1[r]));
                    rm = fmaxf(rm, __shfl_xor(rm, 32));
                    const float mn = fmaxf(m, rm); const float msn = (mn == -INFINITY) ? 0.f : mn;
                    const float alpha = exp2f(m - msn); m = mn;
                    float ps = 0.f;
#pragma unroll
                    for (int r = 0; r < 16; ++r) ps += exp2f(p0[r] - msn) + exp2f(p1[r] - msn);
                    l = l * alpha + ps;
                } else {
#pragma unroll
                    for (int r = 0; r < 16; ++r) { p0[r] = exp2f(p0[r] - ms) * inv; p1[r] = exp2f(p1[r] - ms) * inv; }
#pragma unroll
                    for (int hf = 0; hf < 2; ++hf)
#pragma unroll
                        for (int g = 0; g < 4; ++g) {
                            const f32x16& p = hf == 0 ? p0 : p1;
                            float G = (p[4 * g] + p[4 * g + 1]) + (p[4 * g + 2] + p[4 * g + 3]), L = p[4 * g + 3];
                            G += __shfl_xor(G, 1); G += __shfl_xor(G, 2); L += __shfl_xor(L, 1); L += __shfl_xor(L, 2);
                            if ((lane & 3) == 0) { const int j = 16 * kt + 8 * hf + 2 * g + hi; Gs[(row >> 2) * 64 + j] = G; Ls[(row >> 2) * 64 + j] = L; }
                        }
                    bf16x8 pb[4];
                    pb[0] = att::pack8f(p0, 0); pb[1] = att::pack8f(p0, 8); pb[2] = att::pack8f(p1, 0); pb[3] = att::pack8f(p1, 8);
                    const int vlane = (4 * hi + ((lane & 15) >> 2)) * VST + (16 * ((lane >> 4) & 1) + 4 * (lane & 3)) * 2;
                    const LAS unsigned char* vb = lds + VOFF + kt * 64 * VST;
#pragma unroll
                    for (int ks = 0; ks < 4; ++ks) {
                        const LAS unsigned char* vp = vb + ks * 16 * VST + vlane;
                        const att::s16x4 lo0 = att::vtr(vp), hh0 = att::vtr(vp + 8 * VST), lo1 = att::vtr(vp + 64), hh1 = att::vtr(vp + 64 + 8 * VST);
                        const bf16x8 vf0 = (bf16x8){lo0[0], lo0[1], lo0[2], lo0[3], hh0[0], hh0[1], hh0[2], hh0[3]};
                        const bf16x8 vf1 = (bf16x8){lo1[0], lo1[1], lo1[2], lo1[3], hh1[0], hh1[1], hh1[2], hh1[3]};
                        o0 = __builtin_amdgcn_mfma_f32_32x32x16_bf16(vf0, pb[ks], o0, 0, 0, 0);
                        o1 = __builtin_amdgcn_mfma_f32_32x32x16_bf16(vf1, pb[ks], o1, 0, 0, 0);
                    }
                }
            }
            if (pass == 1) {
                const float gc = c.SM[t * 32 + 8 + hh * 3 + 0];
                bf16* prow = c.P1 + t * 512 + hh * 64;
#pragma unroll
                for (int g4 = 0; g4 < 4; ++g4) {
                    u32x2 w; w.x = pk2(o0[4 * g4] * gc, o0[4 * g4 + 1] * gc); w.y = pk2(o0[4 * g4 + 2] * gc, o0[4 * g4 + 3] * gc);
                    *(u32x2*)(prow + 8 * g4 + 4 * hi) = w;
                    u32x2 w2; w2.x = pk2(o1[4 * g4] * gc, o1[4 * g4 + 1] * gc); w2.y = pk2(o1[4 * g4 + 2] * gc, o1[4 * g4 + 3] * gc);
                    *(u32x2*)(prow + 32 + 8 * g4 + 4 * hi) = w2;
                }
            }
        }
        __syncthreads();
#pragma unroll 1
        for (int i = 0; i < 8; ++i) {
            const int tok = wave * 8 + i, s = q0 + tok;
            const float imp = Gs[tok * 64 + lane] + (lane > 0 ? Ls[tok * 64 + lane - 1] : 0.f);
            const int cur = s >> 6;
            const bool vj = lane <= cur; const bool forced = (lane == 0) || (lane == cur) || (lane == cur - 1);
            const float score = vj ? imp + (forced ? 1e4f : 0.f) : -1.0f;
            int cnt = 0;
#pragma unroll 8
            for (int i2 = 0; i2 < 64; ++i2) { const float si = rdlane(score, i2); cnt += ((si > score) || (si == score && i2 < lane)) ? 1 : 0; }
            const bool selb = (cnt < 16) && (score > -0.5f);
            const unsigned long long mask = __ballot(selb);
            if (lane == 0) c.SEL[((size_t)b * SEQ + s) * 2 + gg] = mask;
        }
        __syncthreads();
    }
}
namespace ml {
using att::f32x16; using att::s16x4;
constexpr int QST = 144, KTST = 192, VST2 = 320, CST = 144;
__device__ __forceinline__ float scan_add(float v, int lane) {
#pragma unroll
    for (int o = 1; o < 64; o <<= 1) { const float u = __shfl_up(v, o); if (lane >= o) v += u; }
    return v;
}
__device__ __forceinline__ float scan_max(float v, int lane) {
#pragma unroll
    for (int o = 1; o < 64; o <<= 1) { const float u = __shfl_up(v, o); if (lane >= o) v = fmaxf(v, u); }
    return v;
}
__device__ __forceinline__ void conv8(const bf16* AQK, const float* m_conv, int b, int s, int ch0, float scale, float (&out)[8]) {
    float a[8] = {0.f, 0.f, 0.f, 0.f, 0.f, 0.f, 0.f, 0.f};
#pragma unroll
    for (int kk = 0; kk < 4; ++kk) {
        const int sp = s - 3 + kk;
        if (sp >= 0) {
            const u32x4 xv = *(const u32x4*)(AQK + ((size_t)b * SEQ + sp) * 512 + ch0);
            const f32x4 w0 = *(const f32x4*)(m_conv + kk * 512 + ch0), w1 = *(const f32x4*)(m_conv + kk * 512 + ch0 + 4);
            a[0] += w0[0] * bflo(xv.x); a[1] += w0[1] * bfhi(xv.x); a[2] += w0[2] * bflo(xv.y); a[3] += w0[3] * bfhi(xv.y);
            a[4] += w1[0] * bflo(xv.z); a[5] += w1[1] * bfhi(xv.z); a[6] += w1[2] * bflo(xv.w); a[7] += w1[3] * bfhi(xv.w);
        }
    }
#pragma unroll
    for (int e = 0; e < 8; ++e) out[e] = siluf_(a[e]) * scale;
}
__device__ __forceinline__ void ml1_phase(const Ctx& c, LAS unsigned char* lds) {
    constexpr int KOFF = 0, VOFF = 64 * KTST, SOFF = VOFF + 64 * VST2;
#pragma unroll 1
    for (int unit = blockIdx.x; unit < 1024; unit += gridDim.x) {
        int tid_o = threadIdx.x; asm volatile("" : "+v"(tid_o));
        const int tid = tid_o, lane = tid & 63, wave = tid >> 6, hi = lane >> 5, r32 = lane & 31;
        const int bh = unit >> 6, ch = unit & 63, b = bh >> 2, h = bh & 3, s0 = ch * 64;
        LAS float* wv = (LAS float*)(lds + SOFF);
        if (wave == 0) {
            const size_t t = (size_t)b * SEQ + s0 + lane;
            const float lf = c.SM[t * 32 + 4 + h], li = c.SM[t * 32 + h];
            const float bc = scan_add(lf, lane); const float g = li - bc;
            const float gmax = wave_max(g); const float bL = rdlane(bc, 63);
            wv[lane] = __expf(g - gmax);
            if (lane == 0) { c.MLOC[unit] = bL + gmax; c.BLV[unit] = bL; }
        }
        {
            const int tk = tid >> 3, cc = (tid & 7) * 16;
            const bf16* vsrc = c.AV + ((size_t)b * SEQ + s0 + tk) * 512 + h * 128 + cc;
            *(LAS u32x4*)(lds + VOFF + tk * VST2 + cc * 2) = *(const u32x4*)vsrc;
            *(LAS u32x4*)(lds + VOFF + tk * VST2 + cc * 2 + 16) = *(const u32x4*)(vsrc + 8);
        }
        __syncthreads();
        {
            const int tk = tid >> 3, cc = (tid & 7) * 8;
            float kf[8]; conv8(c.AQK, c.m_conv, b, s0 + tk, 256 + h * 64 + cc, 1.0f, kf);
            const float w = wv[tk];
            u32x4 o; o.x = pk2(kf[0] * w, kf[1] * w); o.y = pk2(kf[2] * w, kf[3] * w); o.z = pk2(kf[4] * w, kf[5] * w); o.w = pk2(kf[6] * w, kf[7] * w);
            *(LAS u32x4*)(lds + KOFF + tk * KTST + cc * 2) = o;
        }
        __syncthreads();
        if (tid < 64) {
            float a = 0.f;
#pragma unroll 8
            for (int tk = 0; tk < 64; ++tk) a += bf2f(*(const LAS unsigned short*)(lds + KOFF + tk * KTST + tid * 2));
            c.NL[(size_t)unit * 64 + tid] = a;
        }
        const int vb = wave >> 1, kb2 = wave & 1;
        const int tro = (8 * hi + ((lane & 15) >> 2)), tco = (16 * ((lane >> 4) & 1) + 4 * (lane & 3)) * 2;
        f32x16 acc = f32x16{};
#pragma unroll
        for (int ks = 0; ks < 4; ++ks) {
            const LAS unsigned char* vp = lds + VOFF + (16 * ks + tro) * VST2 + vb * 64 + tco;
            const LAS unsigned char* kp = lds + KOFF + (16 * ks + tro) * KTST + kb2 * 64 + tco;
            const s16x4 a0 = att::vtr(vp), a1 = att::vtr(vp + 4 * VST2), b0 = att::vtr(kp), b1 = att::vtr(kp + 4 * KTST);
            const bf16x8 af = (bf16x8){a0[0], a0[1], a0[2], a0[3], a1[0], a1[1], a1[2], a1[3]};
            const bf16x8 bf = (bf16x8){b0[0], b0[1], b0[2], b0[3], b1[0], b1[1], b1[2], b1[3]};
            acc = __builtin_amdgcn_mfma_f32_32x32x16_bf16(af, bf, acc, 0, 0, 0);
        }
        bf16* dst = c.CL + (size_t)unit * 8192 + kb2 * 32 + r32;
#pragma unroll
        for (int r = 0; r < 16; ++r) dst[(size_t)(vb * 32 + att::crow(r, hi)) * 64] = (bf16)f2bf(acc[r]);
        __syncthreads();
    }
}
__device__ __forceinline__ void ml2_phase(const Ctx& c) {
    const int gt = blockIdx.x * 512 + threadIdx.x;
    const int NT = gridDim.x * 512;
#pragma unroll 1
    for (int e0 = gt; e0 < 16 * 8192 + 16 * 64; e0 += NT) {
        const bool isn = e0 >= 16 * 8192;
        const int bh = isn ? (e0 - 16 * 8192) >> 6 : e0 >> 13, e = isn ? (e0 & 63) : (e0 & 8191);
        float m = 0.f, C = 0.f;
#pragma unroll 4
        for (int ch = 0; ch < 64; ++ch) {
            const int unit = bh * 64 + ch;
            const float ml = c.MLOC[unit], bl = c.BLV[unit];
            float cl;
            if (isn) { float* p = c.NL + (size_t)unit * 64 + e; cl = *p; *p = C; }
            else { bf16* p = c.CL + (size_t)unit * 8192 + e; cl = bf2f(*p); *p = (bf16)f2bf(C); }
            if (e == 0 && !isn) c.MS[unit] = m;
            const float mn = fmaxf(bl + m, ml);
            C = __expf(bl + m - mn) * C + __expf(ml - mn) * cl; m = mn;
        }
    }
}
__device__ __forceinline__ void ml3_phase(const Ctx& c, LAS unsigned char* lds) {
    constexpr int QOFF = 0, KOFF = 64 * QST, VOFF = KOFF + 64 * QST, COFF = VOFF + 64 * VST2, SOFF = COFF + 128 * CST;
#pragma unroll 1
    for (int unit = blockIdx.x; unit < 1024; unit += gridDim.x) {
        int tid_o = threadIdx.x; asm volatile("" : "+v"(tid_o));
        const int tid = tid_o, lane = tid & 63, wave = tid >> 6, hi = lane >> 5, r32 = lane & 31;
        const int bh = unit >> 6, ch = unit & 63, b = bh >> 2, h = bh & 3, s0 = ch * 64;
        LAS float* gS = (LAS float*)(lds + SOFF); LAS float* bS = gS + 64; LAS float* MS_ = gS + 128; LAS float* nS = gS + 192; LAS float* red = gS + 256;
        const float mc = c.MS[unit];
        if (wave == 0) {
            const size_t t = (size_t)b * SEQ + s0 + lane;
            const float lf = c.SM[t * 32 + 4 + h], li = c.SM[t * 32 + h];
            const float bc = scan_add(lf, lane); const float g = li - bc;
            const float pm = scan_max(g, lane);
            gS[lane] = g; bS[lane] = bc; MS_[lane] = fmaxf(mc, pm);
            nS[lane] = c.NL[(size_t)unit * 64 + lane];
        }
        {
            const int tk = tid >> 3, cc = (tid & 7) * 16;
            const bool isk = cc >= 64; const int c0 = isk ? 256 + h * 64 + (cc - 64) : h * 64 + cc;
            float f0[8], f1[8];
            conv8(c.AQK, c.m_conv, b, s0 + tk, c0, isk ? 1.0f : 0.125f, f0); conv8(c.AQK, c.m_conv, b, s0 + tk, c0 + 8, isk ? 1.0f : 0.125f, f1);
            u32x4 o0, o1; o0.x = pk2(f0[0], f0[1]); o0.y = pk2(f0[2], f0[3]); o0.z = pk2(f0[4], f0[5]); o0.w = pk2(f0[6], f0[7]);
            o1.x = pk2(f1[0], f1[1]); o1.y = pk2(f1[2], f1[3]); o1.z = pk2(f1[4], f1[5]); o1.w = pk2(f1[6], f1[7]);
            LAS unsigned char* dstp = lds + (isk ? KOFF : QOFF) + tk * QST + (isk ? cc - 64 : cc) * 2;
            *(LAS u32x4*)dstp = o0; *(LAS u32x4*)(dstp + 16) = o1;
            const bf16* vsrc = c.AV + ((size_t)b * SEQ + s0 + tk) * 512 + h * 128 + cc;
            *(LAS u32x4*)(lds + VOFF + tk * VST2 + cc * 2) = *(const u32x4*)vsrc;
            *(LAS u32x4*)(lds + VOFF + tk * VST2 + cc * 2 + 16) = *(const u32x4*)(vsrc + 8);
            const int vv = tid >> 2, kc = (tid & 3) * 16;
            const bf16* csrc = c.CL + (size_t)unit * 8192 + vv * 64 + kc;
            *(LAS u32x4*)(lds + COFF + vv * CST + kc * 2) = *(const u32x4*)csrc;
            *(LAS u32x4*)(lds + COFF + vv * CST + kc * 2 + 16) = *(const u32x4*)(csrc + 8);
        }
        __syncthreads();
        const int vb = wave >> 1, tb = wave & 1;
        const int tl = tb * 32 + r32;
        bf16x8 qf[4];
#pragma unroll
        for (int s = 0; s < 4; ++s) qf[s] = *(const LAS bf16x8*)(lds + QOFF + tl * QST + s * 32 + hi * 16);
        f32x16 p0 = f32x16{}, p1 = f32x16{};
#pragma unroll
        for (int s = 0; s < 4; ++s) {
            const bf16x8 k0 = *(const LAS bf16x8*)(lds + KOFF + r32 * QST + s * 32 + hi * 16);
            const bf16x8 k1 = *(const LAS bf16x8*)(lds + KOFF + (32 + r32) * QST + s * 32 + hi * 16);
            p0 = __builtin_amdgcn_mfma_f32_32x32x16_bf16(k0, qf[s], p0, 0, 0, 0);
            p1 = __builtin_amdgcn_mfma_f32_32x32x16_bf16(k1, qf[s], p1, 0, 0, 0);
        }
        const float Mt = MS_[tl], bt = bS[tl];
        float dsum = 0.f;
#pragma unroll
        for (int r = 0; r < 16; ++r) {
            const int sa = att::crow(r, hi), sb = sa + 32;
            const float wa = sa <= tl ? __expf(gS[sa] - Mt) : 0.f, wb = sb <= tl ? __expf(gS[sb] - Mt) : 0.f;
            p0[r] *= wa; p1[r] *= wb; dsum += p0[r] + p1[r];
        }
        dsum += __shfl_xor(dsum, 32);
        f32x16 acc = f32x16{};
#pragma unroll
        for (int s = 0; s < 4; ++s) {
            const bf16x8 cf = *(const LAS bf16x8*)(lds + COFF + (vb * 32 + r32) * CST + s * 32 + hi * 16);
            acc = __builtin_amdgcn_mfma_f32_32x32x16_bf16(cf, qf[s], acc, 0, 0, 0);
        }
        const float at = __expf(mc - Mt);
#pragma unroll
        for (int r = 0; r < 16; ++r) acc[r] *= at;
        float nq = 0.f;
#pragma unroll
        for (int s = 0; s < 4; ++s)
#pragma unroll
            for (int e = 0; e < 8; ++e) nq += nS[16 * s + 8 * hi + e] * bf2f((unsigned short)qf[s][e]);
        nq += __shfl_xor(nq, 32);
        bf16x8 pb[4];
        pb[0] = att::pack8f(p0, 0); pb[1] = att::pack8f(p0, 8); pb[2] = att::pack8f(p1, 0); pb[3] = att::pack8f(p1, 8);
        const int vlane = (4 * hi + ((lane & 15) >> 2)) * VST2 + (16 * ((lane >> 4) & 1) + 4 * (lane & 3)) * 2;
#pragma unroll
        for (int ks = 0; ks < 4; ++ks) {
            const LAS unsigned char* vp = lds + VOFF + ks * 16 * VST2 + vb * 64 + vlane;
            const s16x4 lo = att::vtr(vp), hh = att::vtr(vp + 8 * VST2);
            const bf16x8 vf = (bf16x8){lo[0], lo[1], lo[2], lo[3], hh[0], hh[1], hh[2], hh[3]};
            acc = __builtin_amdgcn_mfma_f32_32x32x16_bf16(vf, pb[ks], acc, 0, 0, 0);
        }
        const float den = at * nq + dsum;
        const float rdn = 1.0f / fmaxf(fabsf(den), __expf(-(bt + Mt)));
        float ss = 0.f;
#pragma unroll
        for (int r = 0; r < 16; ++r) { acc[r] *= rdn; ss += acc[r] * acc[r]; }
        ss += __shfl_xor(ss, 32);
        if (hi == 0) red[vb * 64 + tl] = ss;
        __syncthreads();
        const float rstd = rsqrtf((red[tl] + red[64 + tl] + red[128 + tl] + red[192 + tl]) * (1.0f / 128.0f) + EPS);
        const size_t t = (size_t)b * SEQ + s0 + tl;
#pragma unroll
        for (int g4 = 0; g4 < 4; ++g4) {
            const int v0 = vb * 32 + 8 * g4 + 4 * hi;
            const u32x2 aw = *(const u32x2*)(c.AO + t * 512 + h * 128 + v0);
            const f32x4 hn = *(const f32x4*)(c.m_hnorm + h * 128 + v0);
            u32x2 w; w.x = pk2(acc[4 * g4] * rstd * hn[0] * bflo(aw.x), acc[4 * g4 + 1] * rstd * hn[1] * bfhi(aw.x));
            w.y = pk2(acc[4 * g4 + 2] * rstd * hn[2] * bflo(aw.y), acc[4 * g4 + 3] * rstd * hn[3] * bfhi(aw.y));
            *(u32x2*)(c.AV + t * 512 + h * 128 + v0) = w;
        }
        __syncthreads();
    }
}
}
template <int WHICH>
__global__ void __launch_bounds__(512, 2) k_ml(Args args, int layer) {
    extern __shared__ __attribute__((aligned(16))) unsigned char lds_raw[];
    const Ctx c = make_ctx(args, layer);
    if (WHICH == 0) ml::ml1_phase(c, (LAS unsigned char*)lds_raw); else if (WHICH == 1) ml::ml2_phase(c); else ml::ml3_phase(c, (LAS unsigned char*)lds_raw);
}

template <int WHICH>
__global__ void __launch_bounds__(512, 2) k_attn(Args args, int layer) {
    extern __shared__ __attribute__((aligned(16))) unsigned char lds_raw[];
    const Ctx c = make_ctx(args, layer);
    if (WHICH == 0) mla_attn_phase(c, (LAS unsigned char*)lds_raw); else if (WHICH == 1) nsa_attn_phase(c, (LAS unsigned char*)lds_raw); else cmp_attn_phase(c, (LAS unsigned char*)lds_raw);
}

template <int LAYER>
__device__ __forceinline__ void mega_layer(const Args& args, unsigned char* lds_raw, cg::grid_group& grid) {
    LAS unsigned char* lds = (LAS unsigned char*)lds_raw;
    run_phase<PH_P0>(args, LAYER, lds_raw); grid.sync();
    run_phase<PH_A2>(args, LAYER, lds_raw); grid.sync();
    run_phase<PH_B>(args, LAYER, lds_raw);
    { const Ctx c = make_ctx(args, LAYER); ml::ml1_phase(c, lds); }
    grid.sync();
    { const Ctx c = make_ctx(args, LAYER); mla_attn_phase(c, lds); }
    { const Ctx c = make_ctx(args, LAYER); cmp_attn_phase(c, lds); }
    { const Ctx c = make_ctx(args, LAYER); ml::ml2_phase(c); }
    grid.sync();
    { const Ctx c = make_ctx(args, LAYER); nsa_attn_phase(c, lds); }
    { const Ctx c = make_ctx(args, LAYER); ml::ml3_phase(c, lds); }
    grid.sync();
    run_phase<PH_E>(args, LAYER, lds_raw); grid.sync();
    run_phase<PH_F>(args, LAYER, lds_raw); grid.sync();
    run_phase<PH_F2>(args, LAYER, lds_raw); grid.sync();
    run_phase<PH_G>(args, LAYER, lds_raw); grid.sync();
    run_phase<PH_H>(args, LAYER, lds_raw); grid.sync();
    run_phase<PH_H2>(args, LAYER, lds_raw);
    if (LAYER == 0) grid.sync();
}
__global__ void __launch_bounds__(512, 2) mega_fwd(Args args) {
    extern __shared__ __attribute__((aligned(16))) unsigned char lds_raw[];
    cg::grid_group grid = cg::this_grid();
    mega_layer<0>(args, lds_raw, grid);
    mega_layer<1>(args, lds_raw, grid);
}

__global__ void __launch_bounds__(256) k_compress(Args args, int layer) {
    __shared__ float hbuf[2 * 128];
    const Ctx c = make_ctx(args, layer);
    const int tid = threadIdx.x;
    for (int it = blockIdx.x; it < 2040; it += gridDim.x) {
        const int r = it * 2 + (tid >> 7), j = tid & 127;
        const int kv = r / 2040, rem = r % 2040, bg = rem / 255, n = rem % 255, b = bg >> 1, gg = bg & 1;
        const bf16* xr = c.BKV + ((size_t)(((kv * NB + b) * 2 + gg) * SEQ + 16 * n)) * 64;
        const float* w1 = c.cmp_w1 + (size_t)kv * 2048 * 128 + j; const float* ps = c.cmp_pos + kv * 2048;
        float acc = 0.f;
#pragma unroll 8
        for (int k = 0; k < 2048; ++k) acc += (bf2f(xr[k]) + ps[k]) * w1[(size_t)k * 128];
        __syncthreads();
        hbuf[(tid >> 7) * 128 + j] = siluf_(acc);
        __syncthreads();
        if (tid < 128) {
            const int rr = tid >> 6, d = tid & 63; const int r2 = it * 2 + rr;
            const int kv2 = r2 / 2040, rem2 = r2 % 2040, bg2 = rem2 / 255, n2 = rem2 % 255;
            const float* w2 = c.cmp_w2 + (size_t)kv2 * 128 * 64 + d; float o = 0.f;
#pragma unroll 8
            for (int jj = 0; jj < 128; ++jj) o += hbuf[rr * 128 + jj] * w2[jj * 64];
            c.KCMP[((size_t)((kv2 * 8 + bg2) * 256 + n2)) * 64 + d] = o;
            c.KCB[((size_t)((kv2 * 8 + bg2) * 256 + n2)) * 64 + d] = (bf16)f2bf(o);
            if (n2 == 254) c.KCB[((size_t)((kv2 * 8 + bg2) * 256 + 255)) * 64 + d] = 0;
        }
    }
}
__global__ void __launch_bounds__(256) k_mla_naive(Args args, int layer) {
    __shared__ float qsh[4][4 * 96];
    const Ctx c = make_ctx(args, layer);
    const int tid = threadIdx.x, lane = tid & 63, wave = tid >> 6;
    float* qs = qsh[wave];
    const int NGW = gridDim.x * 4, gw = blockIdx.x * 4 + wave;
    for (int task0 = gw; task0 < 32768; task0 += NGW) {
        const int bh = task0 & 31, tq0 = task0 >> 5, tq = (bh & 1) ? 1023 - tq0 : tq0;
        const int b = bh >> 3, h = bh & 7, s0 = tq * 4; const size_t t0 = (size_t)b * SEQ + s0;
        for (int e = lane; e < 4 * 96; e += 64) qs[e] = bf2f(c.QM[(t0 + e / 96) * 768 + h * 96 + (e % 96)]);
        float m[4], l[4], o[4];
#pragma unroll
        for (int r = 0; r < 4; ++r) { m[r] = -INFINITY; l[r] = 0.f; o[r] = 0.f; }
        const bf16* Kh = c.KN + (size_t)(b * 8 + h) * SEQ * 64; const bf16* Vh = c.VM + (size_t)(b * 8 + h) * SEQ * 64; const bf16* Krh = c.KR + (size_t)b * SEQ * 32;
        const int nkb = (s0 + 3) / 64 + 1;
        for (int kb = 0; kb < nkb; ++kb) {
            const int key = kb * 64 + lane; bool valid[4];
#pragma unroll
            for (int r = 0; r < 4; ++r) valid[r] = key <= s0 + r;
            nattn_block<4, true>(qs, Kh + (size_t)kb * 64 * 64, 64, Krh + (size_t)kb * 64 * 32, 32, Vh + (size_t)kb * 64 * 64, 64, valid, m, l, o, lane);
        }
#pragma unroll
        for (int r = 0; r < 4; ++r) c.QM[(t0 + r) * 768 + h * 96 + lane] = (bf16)f2bf(o[r] / l[r]);
    }
}
__global__ void __launch_bounds__(256) k_cmp_naive(Args args, int layer) {
    __shared__ float qsh[4][256 + 256];
    const Ctx c = make_ctx(args, layer);
    const int tid = threadIdx.x, lane = tid & 63, wave = tid >> 6;
    float* qs = qsh[wave]; float* psb = qs + 256;
    const int NGW = gridDim.x * 4, gw = blockIdx.x * 4 + wave;
    for (int task = gw; task < 32768; task += NGW) {
        const int bg = task >> 12, s = task & 4095, b = bg >> 1, gg = bg & 1; const size_t t = (size_t)b * SEQ + s;
        for (int e = lane; e < 256; e += 64) qs[e] = bf2f(c.BQ[t * 512 + gg * 256 + e]);
        const float* Kc = c.KCMP + (size_t)(0 * 8 + bg) * 256 * 64; const float* Vc = c.KCMP + (size_t)(1 * 8 + bg) * 256 * 64;
        float sc[4][4]; float mx[4] = {-INFINITY, -INFINITY, -INFINITY, -INFINITY};
#pragma unroll
        for (int kb = 0; kb < 4; ++kb) {
            const int n = kb * 64 + lane; const bool valid = (n < 255) && (16 * n + 31 <= s);
            const float* kr = Kc + (size_t)n * 64; float a[4] = {0.f, 0.f, 0.f, 0.f};
            for (int d0 = 0; d0 < 64; d0 += 4) {
                const f32x4 kd = *(const f32x4*)(kr + d0);
#pragma unroll
                for (int e = 0; e < 4; ++e)
#pragma unroll
                    for (int h = 0; h < 4; ++h) a[h] += qs[h * 64 + d0 + e] * kd[e];
            }
#pragma unroll
            for (int h = 0; h < 4; ++h) { sc[kb][h] = valid ? a[h] : -INFINITY; mx[h] = fmaxf(mx[h], sc[kb][h]); }
        }
        float o[4] = {0.f, 0.f, 0.f, 0.f}; float psum[4] = {0.f, 0.f, 0.f, 0.f};
#pragma unroll
        for (int h = 0; h < 4; ++h) {
            const float mh = wave_max(mx[h]);
            float e[4]; float ls = 0.f;
#pragma unroll
            for (int kb = 0; kb < 4; ++kb) { e[kb] = (mh == -INFINITY || sc[kb][h] == -INFINITY) ? 0.f : exp2f(sc[kb][h] - mh); ls += e[kb]; }
            ls = wave_sum(ls); const float inv = ls > 0.f ? 1.0f / ls : 0.f;
#pragma unroll
            for (int kb = 0; kb < 4; ++kb) { sc[kb][h] = e[kb] * inv; psum[kb] += sc[kb][h]; }
        }
#pragma unroll
        for (int kb = 0; kb < 4; ++kb) {
            for (int key = 0; key < 64; ++key) {
                const int n = kb * 64 + key; if (16 * n + 31 > s) break;
                const float vv = Vc[(size_t)n * 64 + lane];
#pragma unroll
                for (int h = 0; h < 4; ++h) o[h] += rdlane(sc[kb][h], key) * vv;
            }
        }
#pragma unroll
        for (int kb = 0; kb < 4; ++kb) psb[kb * 64 + lane] = psum[kb];
        __builtin_amdgcn_wave_barrier();
        float imp = 0.f;
#pragma unroll
        for (int q = -1; q < 4; ++q) { const int n = 4 * lane + q; if (n >= 0 && n < 255) imp += psb[n]; }
        const int cur = s >> 6;
        const bool vj = lane <= cur; const bool forced = (lane == 0) || (lane == cur) || (lane == cur - 1);
        const float score = vj ? imp + (forced ? 1e4f : 0.f) : -1.0f;
        int cnt = 0;
        for (int i2 = 0; i2 < 64; ++i2) { const float si = rdlane(score, i2); cnt += ((si > score) || (si == score && i2 < lane)) ? 1 : 0; }
        const bool selb = (cnt < 16) && (score > -0.5f);
        const unsigned long long mask = __ballot(selb);
        if (lane == 0) c.SEL[t * 2 + gg] = mask;
#pragma unroll
        for (int h = 0; h < 4; ++h) c.P1[t * 512 + (gg * 4 + h) * 64 + lane] = (bf16)f2bf(c.SM[t * 32 + 8 + (gg * 4 + h) * 3 + 0] * o[h]);
        __builtin_amdgcn_wave_barrier();
    }
}
__global__ void __launch_bounds__(256) k_selwin_naive(Args args, int layer) {
    __shared__ float qsh[4][256];
    const Ctx c = make_ctx(args, layer);
    const int tid = threadIdx.x, lane = tid & 63, wave = tid >> 6;
    float* qs = qsh[wave];
    const int NGW = gridDim.x * 4, gw = blockIdx.x * 4 + wave;
    for (int task = gw; task < 32768; task += NGW) {
        const int bg = task & 7, s = task >> 3, b = bg >> 1, gg = bg & 1; const size_t t = (size_t)b * SEQ + s;
        for (int e = lane; e < 256; e += 64) qs[e] = bf2f(c.BQ[t * 512 + gg * 256 + e]);
        const unsigned long long mk = c.SEL[t * 2 + gg];
        const unsigned mlo = __builtin_amdgcn_readfirstlane((unsigned)mk), mhi = __builtin_amdgcn_readfirstlane((unsigned)(mk >> 32));
        const bf16* Ks = c.BKV + (size_t)((2 * NB + b) * 2 + gg) * SEQ * 64; const bf16* Vs = c.BKV + (size_t)((3 * NB + b) * 2 + gg) * SEQ * 64;
        const bf16* Kw = c.BKV + (size_t)((4 * NB + b) * 2 + gg) * SEQ * 64; const bf16* Vw = c.BKV + (size_t)((5 * NB + b) * 2 + gg) * SEQ * 64;
        float m[4], l[4], o[4], osel[4];
#pragma unroll
        for (int r = 0; r < 4; ++r) { m[r] = -INFINITY; l[r] = 0.f; o[r] = 0.f; }
        for (int j = 0; j < 64; ++j) {
            const unsigned bit = j < 32 ? (mlo >> j) & 1u : (mhi >> (j - 32)) & 1u;
            if (!bit) continue;
            const bool vk = (j * 64 + lane) <= s; bool valid[4] = {vk, vk, vk, vk};
            nattn_block<4, false>(qs, Ks + (size_t)j * 64 * 64, 64, nullptr, 0, Vs + (size_t)j * 64 * 64, 64, valid, m, l, o, lane);
        }
#pragma unroll
        for (int r = 0; r < 4; ++r) { osel[r] = l[r] > 0.f ? o[r] / l[r] : 0.f; m[r] = -INFINITY; l[r] = 0.f; o[r] = 0.f; }
        const int jb0 = (s >= 511 ? s - 511 : 0) >> 6, jb1 = s >> 6;
        for (int j = jb0; j <= jb1; ++j) {
            const int key = j * 64 + lane; const bool vk = (key <= s) && (s - key < 512); bool valid[4] = {vk, vk, vk, vk};
            nattn_block<4, false>(qs, Kw + (size_t)j * 64 * 64, 64, nullptr, 0, Vw + (size_t)j * 64 * 64, 64, valid, m, l, o, lane);
        }
#pragma unroll
        for (int r = 0; r < 4; ++r) {
            const int hh = gg * 4 + r; const float ow = l[r] > 0.f ? o[r] / l[r] : 0.f;
            const float y = bf2f(c.P1[t * 512 + hh * 64 + lane]) + c.SM[t * 32 + 8 + hh * 3 + 1] * osel[r] + c.SM[t * 32 + 8 + hh * 3 + 2] * ow;
            c.BQ[t * 512 + hh * 64 + lane] = (bf16)f2bf(y);
        }
        __builtin_amdgcn_wave_barrier();
    }
}
__global__ void __launch_bounds__(128) k_mlstm_naive(Args args, int layer) {
    __shared__ float qk[128]; __shared__ float red[2];
    const Ctx c = make_ctx(args, layer);
    const int tid = threadIdx.x, lane = tid & 63, wave = tid >> 6;
    const int b = blockIdx.x >> 2, h = blockIdx.x & 3;
    float C[64], nv[64];
#pragma unroll
    for (int d = 0; d < 64; ++d) { C[d] = 0.f; nv[d] = 0.f; }
    float mstate = 0.f;
    const int ch = tid < 64 ? h * 64 + tid : 256 + h * 64 + (tid - 64);
    float cw[4];
#pragma unroll
    for (int kk = 0; kk < 4; ++kk) cw[kk] = c.m_conv[kk * 512 + ch];
    const float hn = c.m_hnorm[h * 128 + tid];
    for (int s = 0; s < SEQ; ++s) {
        const size_t t = (size_t)b * SEQ + s;
        {
            float a = 0.f;
#pragma unroll
            for (int kk = 0; kk < 4; ++kk) { const int sp = s - 3 + kk; if (sp >= 0) a += cw[kk] * bf2f(c.AQK[((size_t)b * SEQ + sp) * 512 + ch]); }
            float y = siluf_(a); if (tid < 64) y *= 0.125f;
            qk[tid] = y;
        }
        __syncthreads();
        const float li = c.SM[t * 32 + h], lf = c.SM[t * 32 + 4 + h];
        const float mn = fmaxf(lf + mstate, li); const float fp = expf(lf + mstate - mn), ip = expf(li - mn); mstate = mn;
        const float v = bf2f(c.AV[t * 512 + h * 128 + tid]); const float iv = ip * v;
        float num = 0.f, den = 0.f;
#pragma unroll
        for (int d = 0; d < 64; ++d) { const float kd = qk[64 + d], qd = qk[d]; C[d] = fp * C[d] + iv * kd; nv[d] = fp * nv[d] + ip * kd; num += C[d] * qd; den += nv[d] * qd; }
        const float hv = num / fmaxf(fabsf(den), expf(-mn));
        const float ss = wave_sum(hv * hv); if (lane == 0) red[wave] = ss;
        __syncthreads();
        const float rstd = rsqrtf((red[0] + red[1]) * (1.0f / 128.0f) + EPS);
        const float y = hv * rstd * hn * bf2f(c.AO[t * 512 + h * 128 + tid]);
        c.AV[t * 512 + h * 128 + tid] = (bf16)f2bf(y);
    }
}

extern "C" void kernel_launch(void* const* d_in, const int* in_sizes, int n_in, void* d_out, int out_size, void* d_ws, size_t ws_size, hipStream_t stream) {
    static int grid = 0;
    if (grid == 0) {
        if (n_in != 19 || out_size != T * DM || ws_size < WS_END) { fprintf(stderr, "kernel_launch: unexpected problem: n_in %d out %d ws %zu\n", n_in, out_size, ws_size); grid = -1; return; }
        int dev = 0, cus = 0;
        (void)hipGetDevice(&dev); (void)hipDeviceGetAttribute(&cus, hipDeviceAttributeMultiprocessorCount, dev);
        bool ok = true;
#define SETLDS(k) ok = ok && (hipFuncSetAttribute((const void*)k, hipFuncAttributeMaxDynamicSharedMemorySize, LDS_BYTES) == hipSuccess)
        SETLDS(k_phase<PH_P0>); SETLDS(k_phase<PH_A2>); SETLDS(k_phase<PH_B>); SETLDS(k_phase<PH_E>); SETLDS(k_phase<PH_F>); SETLDS(k_phase<PH_F2>); SETLDS(k_phase<PH_G>); SETLDS(k_phase<PH_H>); SETLDS(k_phase<PH_H2>); SETLDS(k_attn<0>); SETLDS(k_attn<1>); SETLDS(k_attn<2>); SETLDS(k_ml<0>); SETLDS(k_ml<1>); SETLDS(k_ml<2>); SETLDS(mega_fwd);
        { int per_cu = 0; (void)hipOccupancyMaxActiveBlocksPerMultiprocessor(&per_cu, (const void*)mega_fwd, 512, LDS_BYTES); (void)hipGetLastError(); if (per_cu < 1) { fprintf(stderr, "kernel_launch: occupancy query reports %d workgroups per CU\n", per_cu); grid = -1; return; } }
        if (!ok) { fprintf(stderr, "kernel_launch: hipFuncSetAttribute failed\n"); grid = -1; return; }
        grid = cus;
        if (grid != 256) { fprintf(stderr, "kernel_launch: built for 256 CUs, found %d\n", grid); grid = -1; return; }
    }
    if (grid < 0) return;
    Args a{};
    for (int i = 0; i < 19; ++i) a.in[i] = d_in[i];
    a.out = (float*)d_out; a.ws = (unsigned char*)d_ws;
#ifdef MK_MULTI
    for (int layer = 0; layer < 2; ++layer) {
        hipLaunchKernelGGL(k_phase<PH_P0>, dim3(grid), dim3(512), LDS_BYTES, stream, a, layer);
        hipLaunchKernelGGL(k_phase<PH_A2>, dim3(grid), dim3(512), LDS_BYTES, stream, a, layer);
        hipLaunchKernelGGL(k_phase<PH_B>, dim3(grid), dim3(512), LDS_BYTES, stream, a, layer);
        hipLaunchKernelGGL(k_attn<0>, dim3(grid), dim3(512), LDS_BYTES, stream, a, layer);
        hipLaunchKernelGGL(k_attn<2>, dim3(grid), dim3(512), LDS_BYTES, stream, a, layer);
        hipLaunchKernelGGL(k_attn<1>, dim3(grid), dim3(512), LDS_BYTES, stream, a, layer);
        hipLaunchKernelGGL(k_ml<0>, dim3(grid), dim3(512), LDS_BYTES, stream, a, layer);
        hipLaunchKernelGGL(k_ml<1>, dim3(grid), dim3(512), LDS_BYTES, stream, a, layer);
        hipLaunchKernelGGL(k_ml<2>, dim3(grid), dim3(512), LDS_BYTES, stream, a, layer);
        hipLaunchKernelGGL(k_phase<PH_E>, dim3(grid), dim3(512), LDS_BYTES, stream, a, layer);
        hipLaunchKernelGGL(k_phase<PH_F>, dim3(grid), dim3(512), LDS_BYTES, stream, a, layer);
        hipLaunchKernelGGL(k_phase<PH_F2>, dim3(grid), dim3(512), LDS_BYTES, stream, a, layer);
        hipLaunchKernelGGL(k_phase<PH_G>, dim3(grid), dim3(512), LDS_BYTES, stream, a, layer);
        hipLaunchKernelGGL(k_phase<PH_H>, dim3(grid), dim3(512), LDS_BYTES, stream, a, layer);
        hipLaunchKernelGGL(k_phase<PH_H2>, dim3(grid), dim3(512), LDS_BYTES, stream, a, layer);
    }
#else
    void* params[] = {&a};
    hipError_t e = hipLaunchCooperativeKernel((const void*)mega_fwd, dim3(grid), dim3(512), params, LDS_BYTES, stream);
    if (e != hipSuccess) fprintf(stderr, "kernel_launch: cooperative launch failed: %s (grid %d)\n", hipGetErrorString(e), grid);
#endif
}
```

```cpp
#include <hip/hip_runtime.h>
#include <hip/hip_cooperative_groups.h>
#include <cstdio>
#include <cstdint>
namespace cg = cooperative_groups;

#define LAS __attribute__((address_space(3)))
typedef unsigned short bf16;
typedef short bf16x8 __attribute__((ext_vector_type(8)));
typedef float f32x4 __attribute__((ext_vector_type(4)));
typedef unsigned u32x4 __attribute__((ext_vector_type(4)));
typedef unsigned u32x2 __attribute__((ext_vector_type(2)));

constexpr int NB = 4, SEQ = 4096, T = NB * SEQ, DM = 1024, DIN = 6592, DFF = 2816;
constexpr float EPS = 1e-6f;
constexpr float LOG2E = 1.4426950408889634f;
constexpr float QSCALE_NSA = 0.125f * LOG2E;
constexpr float QSCALE_MLA = 0.10206207261596577f * LOG2E;
constexpr int NZ = 3584;

constexpr size_t MiB = 1u << 20;
constexpr size_t WS_ROPE = 1 * MiB, WS_SM = 3 * MiB, WS_SSQ = 5 * MiB, WS_SEL = 7 * MiB, WS_KCMP = 7 * MiB + 256 * 1024, WS_KCB = 8 * MiB + 256 * 1024;
constexpr size_t WS_WIN = 9 * MiB, WS_WG = 16 * MiB, WS_WUQ = 22 * MiB, WS_WUKV = 22 * MiB + 640 * 1024, WS_WBR = 23 * MiB + 256 * 1024, WS_WOUT = 26 * MiB + 256 * 1024;
constexpr size_t WS_WC1 = 28 * MiB + 256 * 1024, WS_B1 = 6 * MiB + 512 * 1024;
constexpr size_t WS_XB = 31 * MiB, WS_AV = 63 * MiB, WS_AO = 79 * MiB, WS_BQ = 95 * MiB, WS_BKV = 111 * MiB, WS_AQK = 135 * MiB, WS_CQKV = 151 * MiB;
constexpr size_t WS_QM = 171 * MiB, WS_KN = 195 * MiB, WS_VM = 211 * MiB, WS_KR = 227 * MiB, WS_CL = 228 * MiB, WS_NL = 244 * MiB, WS_MSC = 244 * MiB + 512 * 1024;
constexpr size_t WS_P1 = 151 * MiB, WS_GT = 111 * MiB, WS_MERGED = 195 * MiB, WS_WGU = 63 * MiB, WS_WDN = 74 * MiB, WS_MIX = 95 * MiB, WS_U = 95 * MiB, WS_FD = 183 * MiB;
constexpr size_t WS_END = 247 * MiB;

constexpr int LDS_BYTES = 147456;

__device__ __forceinline__ unsigned f2bf(float f) { unsigned u = __builtin_bit_cast(unsigned, f); return (u + 0x7fffu + ((u >> 16) & 1u)) >> 16; }
__device__ __forceinline__ unsigned pk2(float lo, float hi) { return f2bf(lo) | (f2bf(hi) << 16); }
__device__ __forceinline__ float bf2f(unsigned short u) { return __builtin_bit_cast(float, (unsigned)u << 16); }
__device__ __forceinline__ float bflo(unsigned w) { return __builtin_bit_cast(float, w << 16); }
__device__ __forceinline__ float bfhi(unsigned w) { return __builtin_bit_cast(float, w & 0xffff0000u); }
__device__ __forceinline__ float wave_sum(float v) {
#pragma unroll
    for (int o = 1; o < 64; o <<= 1) v += __shfl_xor(v, o);
    return v;
}
__device__ __forceinline__ float wave_max(float v) {
#pragma unroll
    for (int o = 1; o < 64; o <<= 1) v = fmaxf(v, __shfl_xor(v, o));
    return v;
}
__device__ __forceinline__ float sigmoidf_(float x) { return 1.0f / (1.0f + __expf(-x)); }
__device__ __forceinline__ float siluf_(float x) { return x / (1.0f + __expf(-x)); }
__device__ __forceinline__ float logsigmoidf_(float x) { return x >= 0.f ? -log1pf(expf(-x)) : x - log1pf(expf(x)); }
__device__ __forceinline__ float rdlane(float v, int l) { return __builtin_bit_cast(float, __builtin_amdgcn_readlane(__builtin_bit_cast(int, v), l)); }

namespace pg8 {
constexpr int BM = 256, BK = 64, HALF = 128, HTB = HALF * BK * 2, STAGE_BYTES = 8 * HTB, NXCD = 8, WGM = 8;
__host__ __device__ __forceinline__ int lds_byte(int r, int c) { const int st = (r >> 4) * 2 + (c >> 5), rr = r & 15, cc = c & 31, ob = rr * 64 + cc * 2; return st * 1024 + (ob ^ (((ob >> 9) & 1) << 5)); }
__host__ __device__ __forceinline__ void stage_rc(int b, int& R, int& C) { const int st = b / 1024, sb = b % 1024, swz = sb ^ (((sb >> 9) & 1) << 5); R = (st >> 1) * 16 + swz / 64; C = (st & 1) * 32 + (swz % 64) / 2; }
__host__ __device__ __forceinline__ int perm32(int rho) { const int n = rho >> 4, i = rho & 15; return 8 * (i >> 2) + 4 * n + (i & 3); }

struct Unit { int pm, pn; };
struct Gemm { const bf16* A; const bf16* Bt; };

struct StaticOrder {
    int nM, nN, nwg, G, c;
    __host__ __device__ void init(int M, int N, int G_, int c_) { nM = M / BM; nN = N / BM; nwg = nM * nN; G = G_; c = c_; }
    __host__ __device__ bool next(int i, Unit& u) const {
        const long L = (long)i * G + c; if (L >= nwg) return false;
        int wgid = (int)L; { const int q = nwg / NXCD, r = nwg % NXCD, xcd = wgid % NXCD, off = wgid / NXCD; wgid = (xcd < r ? xcd * (q + 1) : r * (q + 1) + (xcd - r) * q) + off; }
        const int nig = WGM * nN, gid = wgid / nig, fm = gid * WGM, gsz = (nM - fm) < WGM ? (nM - fm) : WGM;
        u.pm = fm + ((wgid % nig) % gsz); u.pn = (wgid % nig) / gsz; return true;
    }
};

template <int GK, int LDA, int LDB, int KSTEPA, class Epi, class Sched>
__device__ __forceinline__ void gemm_phase(LAS unsigned char* lds, const Gemm g, const Sched& S, const Epi& E) {
    int tid_ = threadIdx.x; asm volatile("" : "+v"(tid_));
    const int tid = tid_, wid = __builtin_amdgcn_readfirstlane(tid >> 6), lane = tid & 63, wr = wid >> 2, wc = wid & 3, fr = lane & 15, fq = lane >> 4;
    constexpr int nt = GK / BK;
    unsigned voffA[2], voffB[2];
#pragma unroll
    for (int i = 0; i < 2; ++i) { int R, C; stage_rc(tid * 16 + i * 8192, R, C); const int Rb = Epi::PERM ? ((R & ~31) + perm32(R & 31)) : R;
        voffA[i] = (unsigned)(R * LDA + C) * 2u; voffB[i] = (unsigned)(Rb * LDB + C) * 2u; }
    constexpr size_t kstepA = (size_t)KSTEPA, kstepB = (size_t)(BK * 2);
    constexpr size_t hstepA = (size_t)HALF * LDA * 2, hstepB = (size_t)HALF * LDB * 2;
    constexpr size_t tstepA = 2 * hstepA, tstepB = 2 * hstepB;
    const unsigned ldsw = (unsigned)wid * 1024u;
    const int aoff = lds_byte(wr * 64 + fr, fq * 8), boff = lds_byte(wc * 32 + fr, fq * 8);
#define PG8_SA(b, h) (((b) * 2 + (h)) * HTB)
#define PG8_SB(b, h) ((4 + (b) * 2 + (h)) * HTB)
#define PG8_STAGE(bufoff, gbase, voff) do { _Pragma("unroll") for (int _i = 0; _i < 2; ++_i) \
        __builtin_amdgcn_global_load_lds((const unsigned*)((const char*)(gbase) + (voff)[_i]), (LAS unsigned*)(lds + (bufoff) + ldsw + _i * 8192), 16, 0, 0); } while (0)
#define PG8_LDA(dst, b, h) do { _Pragma("unroll") for (int m = 0; m < 4; ++m) _Pragma("unroll") for (int k = 0; k < 2; ++k) dst[m][k] = *(const LAS bf16x8*)(lds + PG8_SA(b, h) + aoff + m * 2048 + k * 1024); } while (0)
#define PG8_LDB(dst, b, h) do { _Pragma("unroll") for (int n = 0; n < 2; ++n) _Pragma("unroll") for (int k = 0; k < 2; ++k) dst[n][k] = *(const LAS bf16x8*)(lds + PG8_SB(b, h) + boff + n * 2048 + k * 1024); } while (0)
#define PG8_MMA(ai, bj, At, Bt) do { __builtin_amdgcn_s_setprio(1); _Pragma("unroll") for (int m = 0; m < 4; ++m) _Pragma("unroll") for (int n = 0; n < 2; ++n) _Pragma("unroll") for (int k = 0; k < 2; ++k) \
        acc[ai][bj][m][n] = __builtin_amdgcn_mfma_f32_16x16x32_bf16(Bt[n][k], At[m][k], acc[ai][bj][m][n], 0, 0, 0); __builtin_amdgcn_s_setprio(0); } while (0)
#define PG8_WAIT_V(n) asm volatile("s_waitcnt vmcnt(" #n ")" ::: "memory")
#define PG8_WAIT_L(n) asm volatile("s_waitcnt lgkmcnt(" #n ")" ::: "memory")
#define PG8_BAR __builtin_amdgcn_s_barrier()
#define PG8_SCHED __builtin_amdgcn_sched_barrier(0)
    Unit cur, nxt; int ui = 0;
    if (!S.next(0, cur)) return;
    f32x4 acc[2][2][4][2];
#pragma unroll
    for (int a = 0; a < 2; ++a)
#pragma unroll
        for (int b = 0; b < 2; ++b)
#pragma unroll
            for (int m = 0; m < 4; ++m)
#pragma unroll
                for (int n = 0; n < 2; ++n) acc[a][b][m][n] = (f32x4){0.f, 0.f, 0.f, 0.f};
    bf16x8 At[4][2], B0[2][2], B1[2][2];
    const char* cA = (const char*)g.A + (size_t)cur.pm * tstepA; const char* cB = (const char*)g.Bt + (size_t)cur.pn * tstepB;
    PG8_STAGE(PG8_SB(0, 0), cB, voffB); PG8_STAGE(PG8_SB(0, 1), cB + hstepB, voffB); PG8_STAGE(PG8_SA(0, 0), cA, voffA); PG8_STAGE(PG8_SA(0, 1), cA + hstepA, voffA);
    if (wr == 1) PG8_BAR;
    PG8_WAIT_V(2); PG8_BAR;
    PG8_STAGE(PG8_SB(1, 0), cB + kstepB, voffB); PG8_STAGE(PG8_SA(1, 0), cA + kstepA, voffA); PG8_STAGE(PG8_SB(1, 1), cB + hstepB + kstepB, voffB);
    PG8_WAIT_V(6); PG8_BAR;
    for (;;) {
        const bool has_next = S.next(ui + 1, nxt);
        const char* nA = has_next ? (const char*)g.A + (size_t)nxt.pm * tstepA : cA; const char* nB = has_next ? (const char*)g.Bt + (size_t)nxt.pn * tstepB : cB;
#pragma unroll 1
        for (int t = 0; t < nt; t += 2) {
            const bool last = (t == nt - 2);
            const char* a1 = cA + (size_t)(t + 1) * kstepA;
            const char* a2 = last ? nA : cA + (size_t)(t + 2) * kstepA; const char* b2 = last ? nB : cB + (size_t)(t + 2) * kstepB;
            const char* a3 = a2 + kstepA; const char* b3 = b2 + kstepB;
            PG8_LDB(B0, 0, 0); PG8_LDB(B1, 0, 1); PG8_SCHED; PG8_LDA(At, 0, 0); PG8_STAGE(PG8_SA(1, 1), a1 + hstepA, voffA);
            PG8_WAIT_V(8); PG8_WAIT_L(0); PG8_BAR; PG8_MMA(0, 0, At, B0); PG8_MMA(0, 1, At, B1); PG8_BAR; PG8_SCHED;
            PG8_LDA(At, 0, 1); PG8_STAGE(PG8_SB(0, 0), b2, voffB); PG8_STAGE(PG8_SB(0, 1), b2 + hstepB, voffB); PG8_STAGE(PG8_SA(0, 0), a2, voffA);
            PG8_WAIT_V(8); PG8_WAIT_L(0); PG8_BAR; PG8_MMA(1, 0, At, B0); PG8_MMA(1, 1, At, B1); PG8_BAR; PG8_SCHED;
            PG8_LDB(B0, 1, 0); PG8_LDB(B1, 1, 1); PG8_SCHED; PG8_LDA(At, 1, 0); PG8_STAGE(PG8_SA(0, 1), a2 + hstepA, voffA);
            PG8_WAIT_V(8); PG8_WAIT_L(0); PG8_BAR; PG8_MMA(0, 0, At, B0); PG8_MMA(0, 1, At, B1); PG8_BAR; PG8_SCHED;
            PG8_LDA(At, 1, 1); PG8_STAGE(PG8_SB(1, 0), b3, voffB); PG8_STAGE(PG8_SB(1, 1), b3 + hstepB, voffB); PG8_STAGE(PG8_SA(1, 0), a3, voffA);
            PG8_WAIT_V(8); PG8_WAIT_L(0); PG8_BAR; PG8_MMA(1, 0, At, B0); PG8_MMA(1, 1, At, B1); PG8_BAR; PG8_SCHED;
        }
        if (wr == 0) PG8_BAR;
        if constexpr (!Epi::AFTER_DRAIN) E(acc, cur, wr, wc, fr, fq);
        if (!has_next) break;
#pragma unroll
        for (int a = 0; a < 2; ++a)
#pragma unroll
            for (int b = 0; b < 2; ++b)
#pragma unroll
                for (int m = 0; m < 4; ++m)
#pragma unroll
                    for (int n = 0; n < 2; ++n) acc[a][b][m][n] = (f32x4){0.f, 0.f, 0.f, 0.f};
        cur = nxt; cA = nA; cB = nB; ++ui;
        if (wr == 1) PG8_BAR;
    }
    PG8_WAIT_V(0);
    PG8_BAR;
    if constexpr (Epi::AFTER_DRAIN) E.fused(acc, cur, wr, wc, fr, fq, lds, tid);
#undef PG8_SA
#undef PG8_SB
#undef PG8_STAGE
#undef PG8_LDA
#undef PG8_LDB
#undef PG8_MMA
#undef PG8_WAIT_V
#undef PG8_WAIT_L
#undef PG8_BAR
#undef PG8_SCHED
}
}
using pg8::Unit;
typedef const f32x4 (&AccRef)[2][2][4][2];

__device__ __forceinline__ u32x4 pack8(const f32x4 a, const f32x4 b) { u32x4 w; w.x = pk2(a[0], a[1]); w.y = pk2(a[2], a[3]); w.z = pk2(b[0], b[1]); w.w = pk2(b[2], b[3]); return w; }

struct EpiInProj {
    static constexpr bool PERM = true, AFTER_DRAIN = false;
    bf16 *AQK, *AV, *AO, *BQ, *BKV, *CQKV, *KR; float *SM, *SSQ; const float* ROPE; const float* gbias;
    __device__ __forceinline__ void operator()(AccRef acc, const Unit& u, int wr, int wc, int fr, int fq) const {
        const int pn = u.pn;
#pragma unroll
        for (int ai = 0; ai < 2; ++ai)
#pragma unroll
            for (int m = 0; m < 4; ++m) {
                const int row = u.pm * 256 + ai * 128 + wr * 64 + m * 16 + fr;
#pragma unroll
                for (int bj = 0; bj < 2; ++bj) {
                    f32x4 v0 = acc[ai][bj][m][0], v1 = acc[ai][bj][m][1];
                    const int cg = bj * 128 + wc * 32;
                    const int c0 = cg + 8 * fq;
                    if (pn < 8) {
                        const int region = pn >> 1; const int col = (pn & 1) * 256 + c0;
                        bf16* base = region == 0 ? AQK : region == 1 ? AV : region == 2 ? AO : BQ;
                        if (region == 2) {
#pragma unroll
                            for (int e = 0; e < 4; ++e) { v0[e] = sigmoidf_(v0[e]); v1[e] = sigmoidf_(v1[e]); }
                        }
                        *(u32x4*)(base + (size_t)row * 512 + col) = pack8(v0, v1);
                    } else if (pn < 11) {
                        const int cc = (pn - 8) * 256 + c0; const int i = cc >> 7, gg = (cc >> 6) & 1, d = cc & 63; const int b = row >> 12, s = row & 4095;
                        *(u32x4*)(BKV + ((size_t)(((i * NB + b) * 2 + gg) * SEQ + s)) * 64 + d) = pack8(v0, v1);
                    } else {
                        const int gb = (pn - 11) * 256 + cg;
                        if (gb < 640) {
                            *(u32x4*)(CQKV + (size_t)row * 640 + gb + 8 * fq) = pack8(v0, v1);
                            float ss = 0.f;
#pragma unroll
                            for (int e = 0; e < 4; ++e) ss += v0[e] * v0[e] + v1[e] * v1[e];
                            ss += __shfl_xor(ss, 16); ss += __shfl_xor(ss, 32);
                            if (fq == 0) SSQ[(size_t)row * 24 + (gb >> 5)] = ss;
                        } else if (gb == 640) {
                            float o[8];
#pragma unroll
                            for (int e = 0; e < 8; ++e) {
                                const float v = e < 4 ? v0[e] : v1[e - 4]; const float p = __shfl_xor(v, 32);
                                const int i = (8 * fq + e) & 15; const float cs = ROPE[((size_t)row * 16 + i) * 2], sn = ROPE[((size_t)row * 16 + i) * 2 + 1];
                                o[e] = fq < 2 ? v * cs - p * sn : p * sn + v * cs;
                            }
                            u32x4 w; w.x = pk2(o[0], o[1]); w.y = pk2(o[2], o[3]); w.z = pk2(o[4], o[5]); w.w = pk2(o[6], o[7]);
                            *(u32x4*)(KR + (size_t)row * 32 + 8 * fq) = w;
                        } else if (gb == 672) {
                            float o[8];
#pragma unroll
                            for (int e = 0; e < 8; ++e) {
                                const float v = e < 4 ? v0[e] : v1[e - 4];
                                if (fq == 0) { const float x = v + gbias[e]; o[e] = e < 4 ? x : logsigmoidf_(x); }
                                else o[e] = sigmoidf_(v);
                            }
                            float* dst = SM + (size_t)row * 32 + 8 * fq;
                            *(f32x4*)dst = (f32x4){o[0], o[1], o[2], o[3]}; *(f32x4*)(dst + 4) = (f32x4){o[4], o[5], o[6], o[7]};
                        }
                    }
                }
                asm volatile("" ::: "memory");
            }
    }
};

struct EpiMlaQ {
    static constexpr bool PERM = true, AFTER_DRAIN = false;
    bf16* QM; const float* SSQ; const float* ROPE;
    __device__ __forceinline__ void operator()(AccRef acc, const Unit& u, int wr, int wc, int fr, int fq) const {
#pragma unroll
        for (int ai = 0; ai < 2; ++ai)
#pragma unroll
            for (int m = 0; m < 4; ++m) {
                const int row = u.pm * 256 + ai * 128 + wr * 64 + m * 16 + fr;
                const f32x4* sp = (const f32x4*)(SSQ + (size_t)row * 24);
                const f32x4 s0 = sp[0], s1 = sp[1], s2 = sp[2];
                const float ss = (s0[0] + s0[1] + s0[2] + s0[3]) + (s1[0] + s1[1] + s1[2] + s1[3]) + (s2[0] + s2[1] + s2[2] + s2[3]);
                const float rstd = rsqrtf(ss * (1.0f / 384.0f) + EPS);
#pragma unroll
                for (int bj = 0; bj < 2; ++bj) {
                    const int cgi = u.pn * 8 + bj * 4 + wc;
                    f32x4 v0 = acc[ai][bj][m][0] * rstd, v1 = acc[ai][bj][m][1] * rstd;
                    if (cgi % 3 == 2) {
                        float o[8];
#pragma unroll
                        for (int e = 0; e < 8; ++e) {
                            const float v = e < 4 ? v0[e] : v1[e - 4]; const float p = __shfl_xor(v, 32);
                            const int i = (8 * fq + e) & 15; const float cs = ROPE[((size_t)row * 16 + i) * 2], sn = ROPE[((size_t)row * 16 + i) * 2 + 1];
                            o[e] = fq < 2 ? v * cs - p * sn : p * sn + v * cs;
                        }
                        v0 = (f32x4){o[0], o[1], o[2], o[3]}; v1 = (f32x4){o[4], o[5], o[6], o[7]};
                    }
                    *(u32x4*)(QM + (size_t)row * 768 + cgi * 32 + 8 * fq) = pack8(v0, v1);
                }
                asm volatile("" ::: "memory");
            }
    }
};
struct EpiMlaKV {
    static constexpr bool PERM = true, AFTER_DRAIN = false;
    bf16 *KN, *VM; const float* SSQ;
    __device__ __forceinline__ void operator()(AccRef acc, const Unit& u, int wr, int wc, int fr, int fq) const {
#pragma unroll
        for (int ai = 0; ai < 2; ++ai)
#pragma unroll
            for (int m = 0; m < 4; ++m) {
                const int row = u.pm * 256 + ai * 128 + wr * 64 + m * 16 + fr;
                const f32x4* sp = (const f32x4*)(SSQ + (size_t)row * 24 + 12);
                const f32x4 s0 = sp[0], s1 = sp[1];
                const float ss = (s0[0] + s0[1] + s0[2] + s0[3]) + (s1[0] + s1[1] + s1[2] + s1[3]);
                const float rstd = rsqrtf(ss * (1.0f / 256.0f) + EPS);
                const int b = row >> 12, s = row & 4095;
#pragma unroll
                for (int bj = 0; bj < 2; ++bj) {
                    const int h = u.pn * 2 + bj; const int j = wc * 32 + 8 * fq;
                    const f32x4 v0 = acc[ai][bj][m][0] * rstd, v1 = acc[ai][bj][m][1] * rstd;
                    bf16* dst = (j < 64 ? KN : VM) + ((size_t)((b * 8 + h) * SEQ + s)) * 64 + (j & 63);
                    *(u32x4*)dst = pack8(v0, v1);
                }
                asm volatile("" ::: "memory");
            }
    }
};
struct EpiGate {
    static constexpr bool PERM = true, AFTER_DRAIN = false;
    bf16* GT;
    __device__ __forceinline__ void operator()(AccRef acc, const Unit& u, int wr, int wc, int fr, int fq) const {
        int tid = threadIdx.x; asm volatile("" : "+v"(tid));
#pragma unroll
        for (int ai = 0; ai < 2; ++ai)
#pragma unroll
            for (int bj = 0; bj < 2; ++bj)
#pragma unroll
                for (int m = 0; m < 4; ++m) {
                    f32x4 v0 = acc[ai][bj][m][0], v1 = acc[ai][bj][m][1];
#pragma unroll
                    for (int e = 0; e < 4; ++e) { v0[e] = sigmoidf_(v0[e]); v1[e] = sigmoidf_(v1[e]); }
                    const int q = (ai * 2 + bj) * 4 + m;
                    *(u32x4*)(GT + ((size_t)q * 512 + tid) * 8) = pack8(v0, v1);
                    asm volatile("" ::: "memory");
                }
    }
};
struct EpiBranch {
    static constexpr bool PERM = true, AFTER_DRAIN = false;
    const bf16* GT; bf16* MG; int first;
    __device__ __forceinline__ void operator()(AccRef acc, const Unit& u, int wr, int wc, int fr, int fq) const {
        int tid = threadIdx.x; asm volatile("" : "+v"(tid));
#pragma unroll
        for (int ai = 0; ai < 2; ++ai)
#pragma unroll
            for (int m = 0; m < 4; ++m) {
                const int row = u.pm * 256 + ai * 128 + wr * 64 + m * 16 + fr;
#pragma unroll
                for (int bj = 0; bj < 2; ++bj) {
                    const int col = u.pn * 256 + bj * 128 + wc * 32 + 8 * fq;
                    const int q = (ai * 2 + bj) * 4 + m;
                    const u32x4 gw = *(const u32x4*)(GT + ((size_t)q * 512 + tid) * 8);
                    f32x4 v0 = acc[ai][bj][m][0], v1 = acc[ai][bj][m][1];
                    v0[0] *= bflo(gw.x); v0[1] *= bfhi(gw.x); v0[2] *= bflo(gw.y); v0[3] *= bfhi(gw.y);
                    v1[0] *= bflo(gw.z); v1[1] *= bfhi(gw.z); v1[2] *= bflo(gw.w); v1[3] *= bfhi(gw.w);
                    bf16* dst = MG + (size_t)row * 1024 + col;
                    if (!first) {
                        const u32x4 ow = *(const u32x4*)dst;
                        v0[0] += bflo(ow.x); v0[1] += bfhi(ow.x); v0[2] += bflo(ow.y); v0[3] += bfhi(ow.y);
                        v1[0] += bflo(ow.z); v1[1] += bfhi(ow.z); v1[2] += bflo(ow.w); v1[3] += bfhi(ow.w);
                    }
                    *(u32x4*)dst = pack8(v0, v1);
                }
                asm volatile("" ::: "memory");
            }
    }
};
struct EpiF32 {
    static constexpr bool PERM = false, AFTER_DRAIN = false;
    float* C; int ldc;
    __device__ __forceinline__ void operator()(AccRef acc, const Unit& u, int wr, int wc, int fr, int fq) const {
        const int row0 = u.pm * 256 + wr * 64 + fr, col0 = u.pn * 256 + wc * 32 + 4 * fq;
#pragma unroll
        for (int ai = 0; ai < 2; ++ai)
#pragma unroll
            for (int m = 0; m < 4; ++m) { float* rowp = C + (size_t)(row0 + ai * 128 + m * 16) * ldc + col0;
#pragma unroll
                for (int bj = 0; bj < 2; ++bj)
#pragma unroll
                    for (int n = 0; n < 2; ++n) *(f32x4*)(rowp + bj * 128 + n * 16) = acc[ai][bj][m][n]; }
    }
};
struct EpiSwiGLU {
    static constexpr bool PERM = true, AFTER_DRAIN = false;
    bf16* U;
    __device__ __forceinline__ void operator()(AccRef acc, const Unit& u, int wr, int wc, int fr, int fq) const {
#pragma unroll
        for (int ai = 0; ai < 2; ++ai)
#pragma unroll
            for (int m = 0; m < 4; ++m) {
                const int row = u.pm * 256 + ai * 128 + wr * 64 + m * 16 + fr;
                f32x4 g0 = acc[ai][0][m][0], g1 = acc[ai][0][m][1]; const f32x4 u0 = acc[ai][1][m][0], u1 = acc[ai][1][m][1];
#pragma unroll
                for (int e = 0; e < 4; ++e) { g0[e] = siluf_(g0[e]) * u0[e]; g1[e] = siluf_(g1[e]) * u1[e]; }
                *(u32x4*)(U + (size_t)row * DFF + u.pn * 128 + wc * 32 + 8 * fq) = pack8(g0, g1);
                asm volatile("" ::: "memory");
            }
    }
};

struct RangeOrder {
    int nM, first, cnt, c;
    __device__ bool next(int i, Unit& u) const { const int L = (c - first) + i * cnt; if (c < first || c >= first + cnt || L >= nM) return false; u.pm = L; u.pn = 0; return true; }
};
struct EpiCompress {
    static constexpr bool PERM = false, AFTER_DRAIN = true;
    const float* b1; const float* w2; bf16* out;
    __device__ __forceinline__ void fused(AccRef acc, const Unit& u, int wr, int wc, int fr, int fq, LAS unsigned char* lds, int tid) const {
        constexpr int HST = 272;
#pragma unroll
        for (int ai = 0; ai < 2; ++ai)
#pragma unroll
            for (int m = 0; m < 4; ++m) {
                const int row = ai * 128 + wr * 64 + m * 16 + fr;
#pragma unroll
                for (int n = 0; n < 2; ++n) {
                    const int col = wc * 32 + 16 * n + 4 * fq;
                    const f32x4 bv = *(const f32x4*)(b1 + col); const f32x4 v = acc[ai][0][m][n] + bv;
                    u32x2 w; w.x = pk2(siluf_(v[0]), siluf_(v[1])); w.y = pk2(siluf_(v[2]), siluf_(v[3]));
                    *(LAS u32x2*)(lds + row * HST + col * 2) = w;
                }
            }
        __syncthreads();
        const int row = tid >> 1, d0 = (tid & 1) * 32;
        float o[32];
#pragma unroll
        for (int d = 0; d < 32; ++d) o[d] = 0.f;
#pragma unroll 2
        for (int j = 0; j < 128; ++j) {
            const float hv = bf2f(*(const LAS unsigned short*)(lds + row * HST + j * 2));
#pragma unroll
            for (int q = 0; q < 8; ++q) { const f32x4 wv = *(const f32x4*)(w2 + j * 64 + d0 + 4 * q); o[4 * q] += hv * wv[0]; o[4 * q + 1] += hv * wv[1]; o[4 * q + 2] += hv * wv[2]; o[4 * q + 3] += hv * wv[3]; }
        }
        bf16* dst = out + ((size_t)(u.pm * 256 + row)) * 64 + d0;
        const float z = row == 255 ? 0.f : 1.f;
#pragma unroll
        for (int q = 0; q < 4; ++q) {
            u32x4 w; w.x = pk2(o[8 * q] * z, o[8 * q + 1] * z); w.y = pk2(o[8 * q + 2] * z, o[8 * q + 3] * z); w.z = pk2(o[8 * q + 4] * z, o[8 * q + 5] * z); w.w = pk2(o[8 * q + 6] * z, o[8 * q + 7] * z);
            *(u32x4*)(dst + 8 * q) = w;
        }
        __syncthreads();
    }
};

struct ColSrc { const float* p; float cs; };
template <class Map>
__device__ __forceinline__ void tr_item(const Map& mp, int ldw, const float* kscale, bf16* WT, int ldt, int nblk, int item, LAS float* scr, int lane) {
    const int kb = item / nblk, nb = item % nblk, k0 = 64 * kb, n0 = 32 * nb;
    const ColSrc cs = mp(n0 + (lane & 31));
#pragma unroll 8
    for (int i = 0; i < 32; ++i) { const int kk = 2 * i + (lane >> 5); const int k = k0 + kk;
        float v = 0.f; if (cs.p) { v = cs.p[(size_t)k * ldw] * cs.cs; if (kscale) v *= kscale[k]; }
        scr[kk * 33 + (lane & 31)] = v; }
    asm volatile("s_waitcnt lgkmcnt(0)" ::: "memory");
    const int c = lane & 7;
#pragma unroll
    for (int j = 0; j < 4; ++j) { const int n = (lane >> 3) + 8 * j; const LAS float* s = scr + (8 * c) * 33 + n;
        u32x4 o; o.x = pk2(s[0 * 33], s[1 * 33]); o.y = pk2(s[2 * 33], s[3 * 33]); o.z = pk2(s[4 * 33], s[5 * 33]); o.w = pk2(s[6 * 33], s[7 * 33]);
        *(u32x4*)(WT + (size_t)(n0 + n) * ldt + k0 + 8 * c) = o; }
    asm volatile("s_waitcnt lgkmcnt(0)" ::: "memory");
}
struct MapIn {
    const float* W;
    __device__ __forceinline__ ColSrc operator()(int n) const {
        int src; float cs = 1.f;
        if (n < 1536) src = n;
        else if (n < 2048) { src = 1544 + (n - 1536); cs = QSCALE_NSA; }
        else if (n < 2816) src = 2056 + (n - 2048);
        else if (n < 3200) src = 2848 + (n - 2816);
        else if (n < 3488) src = 3232 + (n - 3200);
        else if (n < 3496) src = 1536 + (n - 3488);
        else if (n < 3520) src = 2824 + (n - 3496);
        else src = -1;
        ColSrc r; r.p = src >= 0 ? W + src : nullptr; r.cs = cs; return r;
    }
};
struct MapPlain { const float* W; int off; float cs; __device__ __forceinline__ ColSrc operator()(int n) const { ColSrc r; r.p = W + off + n; r.cs = cs; return r; } };
struct MapPad { const float* W; int nvalid; __device__ __forceinline__ ColSrc operator()(int n) const { ColSrc r; r.p = n < nvalid ? W + n : nullptr; r.cs = 1.f; return r; } };
struct MapGU { const float* Wg; const float* Wu; __device__ __forceinline__ ColSrc operator()(int n) const { const int j = n >> 8, w = n & 255; ColSrc r; r.p = (w < 128 ? Wg : Wu) + 128 * j + (w & 127); r.cs = 1.f; return r; } };

__device__ __forceinline__ void row_resnorm(const float* xin, const float* delta, const float* gain, float* xout, bf16* xb, int lane) {
    f32x4 v[4];
#pragma unroll
    for (int j = 0; j < 4; ++j) v[j] = ((const f32x4*)xin)[lane + 64 * j];
    if (delta) {
        f32x4 d[4]; float s = 0.f;
#pragma unroll
        for (int j = 0; j < 4; ++j) { d[j] = ((const f32x4*)delta)[lane + 64 * j]; s += (d[j][0] * d[j][0] + d[j][1] * d[j][1]) + (d[j][2] * d[j][2] + d[j][3] * d[j][3]); }
        const float rstd = rsqrtf(wave_sum(s) * (1.0f / DM) + EPS);
#pragma unroll
        for (int j = 0; j < 4; ++j) { const f32x4 g = ((const f32x4*)gain)[lane + 64 * j]; v[j] = v[j] + g * d[j] * rstd; }
    }
    if (xout) {
#pragma unroll
        for (int j = 0; j < 4; ++j) ((f32x4*)xout)[lane + 64 * j] = v[j];
    }
    float s2 = 0.f;
#pragma unroll
    for (int j = 0; j < 4; ++j) s2 += (v[j][0] * v[j][0] + v[j][1] * v[j][1]) + (v[j][2] * v[j][2] + v[j][3] * v[j][3]);
    const float r2 = rsqrtf(wave_sum(s2) * (1.0f / DM) + EPS);
#pragma unroll
    for (int j = 0; j < 4; ++j) { u32x2 w; w.x = pk2(v[j][0] * r2, v[j][1] * r2); w.y = pk2(v[j][2] * r2, v[j][3] * r2); ((u32x2*)xb)[lane + 64 * j] = w; }
}

template <int NH, bool EXT>
__device__ __forceinline__ void nattn_block(const float* qs, const bf16* Kb, int ldk, const bf16* K2b, int ldk2, const bf16* Vb, int ldv,
                                            const bool (&valid)[NH], float (&m)[NH], float (&l)[NH], float (&o)[NH], int lane) {
    constexpr int QD = EXT ? 96 : 64;
    float s[NH];
#pragma unroll
    for (int h = 0; h < NH; ++h) s[h] = 0.f;
    const u32x4* kp = (const u32x4*)(Kb + (size_t)lane * ldk);
#pragma unroll
    for (int c = 0; c < 8; ++c) {
        asm volatile("" ::: "memory");
        const u32x4 kk = kp[c];
        const float kf[8] = {bflo(kk.x), bfhi(kk.x), bflo(kk.y), bfhi(kk.y), bflo(kk.z), bfhi(kk.z), bflo(kk.w), bfhi(kk.w)};
#pragma unroll
        for (int h = 0; h < NH; ++h)
#pragma unroll
            for (int e = 0; e < 8; ++e) s[h] += qs[h * QD + 8 * c + e] * kf[e];
    }
    if (EXT) {
        const u32x4* k2 = (const u32x4*)(K2b + (size_t)lane * ldk2);
#pragma unroll
        for (int c = 0; c < 4; ++c) {
            asm volatile("" ::: "memory");
            const u32x4 kk = k2[c];
            const float kf[8] = {bflo(kk.x), bfhi(kk.x), bflo(kk.y), bfhi(kk.y), bflo(kk.z), bfhi(kk.z), bflo(kk.w), bfhi(kk.w)};
#pragma unroll
            for (int h = 0; h < NH; ++h)
#pragma unroll
                for (int e = 0; e < 8; ++e) s[h] += qs[h * QD + 64 + 8 * c + e] * kf[e];
        }
    }
    float p[NH];
#pragma unroll
    for (int h = 0; h < NH; ++h) {
        const float sv = valid[h] ? s[h] : -INFINITY;
        const float bm = wave_max(sv);
        const float mn = fmaxf(m[h], bm);
        if (mn == -INFINITY) { p[h] = 0.f; continue; }
        const float alpha = exp2f(m[h] - mn);
        p[h] = valid[h] ? exp2f(s[h] - mn) : 0.f;
        l[h] = l[h] * alpha + wave_sum(p[h]); o[h] *= alpha; m[h] = mn;
    }
#pragma unroll 8
    for (int key = 0; key < 64; ++key) {
        const float vv = bf2f(Vb[(size_t)key * ldv + lane]);
#pragma unroll
        for (int h = 0; h < NH; ++h) o[h] += rdlane(p[h], key) * vv;
    }
}

struct Args { const void* in[19]; float* out; unsigned char* ws; };

struct Ctx {
    const float *x_in; const int* positions; float* XS;
    float *ROPE, *SM, *SSQ; unsigned long long* SEL; float* KCMP; bf16* KCB; bf16* CL; float *NL, *MLOC, *BLV, *MS; bf16* W_C1; float* B1;
    bf16 *W_IN, *W_G, *W_UQ, *W_UKV, *W_BR, *W_OUT, *W_GU, *W_DN;
    bf16 *XB, *AV, *AO, *BQ, *BKV, *AQK, *CQKV, *QM, *KN, *VM, *KR, *P1, *GTall, *MERGED, *U; float *MIX, *FD;
    const float *gains, *w_in, *m_conv, *m_gbias, *m_hnorm, *cmp_pos, *cmp_w1, *cmp_w2, *q_norm, *kv_norm, *w_uq, *w_ukv, *w_branch, *w_out, *w_fg, *w_fu, *w_fd;
};
__device__ __forceinline__ Ctx make_ctx(const Args& args, int layer) {
    Ctx c; unsigned char* ws = args.ws;
    c.x_in = (const float*)args.in[0]; c.positions = (const int*)args.in[1]; c.XS = args.out;
    c.ROPE = (float*)(ws + WS_ROPE); c.SM = (float*)(ws + WS_SM); c.SSQ = (float*)(ws + WS_SSQ); c.SEL = (unsigned long long*)(ws + WS_SEL); c.KCMP = (float*)(ws + WS_KCMP); c.KCB = (bf16*)(ws + WS_KCB); c.CL = (bf16*)(ws + WS_CL); c.NL = (float*)(ws + WS_NL); c.MLOC = (float*)(ws + WS_MSC); c.BLV = c.MLOC + 1024; c.MS = c.MLOC + 2048; c.W_C1 = (bf16*)(ws + WS_WC1); c.B1 = (float*)(ws + WS_B1);
    c.W_IN = (bf16*)(ws + WS_WIN); c.W_G = (bf16*)(ws + WS_WG); c.W_UQ = (bf16*)(ws + WS_WUQ); c.W_UKV = (bf16*)(ws + WS_WUKV);
    c.W_BR = (bf16*)(ws + WS_WBR); c.W_OUT = (bf16*)(ws + WS_WOUT); c.W_GU = (bf16*)(ws + WS_WGU); c.W_DN = (bf16*)(ws + WS_WDN);
    c.XB = (bf16*)(ws + WS_XB); c.AV = (bf16*)(ws + WS_AV); c.AO = (bf16*)(ws + WS_AO); c.BQ = (bf16*)(ws + WS_BQ); c.BKV = (bf16*)(ws + WS_BKV);
    c.AQK = (bf16*)(ws + WS_AQK); c.CQKV = (bf16*)(ws + WS_CQKV); c.QM = (bf16*)(ws + WS_QM); c.KN = (bf16*)(ws + WS_KN); c.VM = (bf16*)(ws + WS_VM);
    c.KR = (bf16*)(ws + WS_KR); c.P1 = (bf16*)(ws + WS_P1); c.GTall = (bf16*)(ws + WS_GT); c.MERGED = (bf16*)(ws + WS_MERGED);
    c.MIX = (float*)(ws + WS_MIX); c.U = (bf16*)(ws + WS_U); c.FD = (float*)(ws + WS_FD);
    c.gains = (const float*)args.in[2] + (size_t)layer * 4 * DM;
    c.w_in = (const float*)args.in[3] + (size_t)layer * DM * DIN;
    c.m_conv = (const float*)args.in[4] + (size_t)layer * 4 * 512;
    c.m_gbias = (const float*)args.in[5] + layer * 8;
    c.m_hnorm = (const float*)args.in[6] + layer * 512;
    c.cmp_pos = (const float*)args.in[7] + (size_t)layer * 2 * 2048;
    c.cmp_w1 = (const float*)args.in[8] + (size_t)layer * 2 * 2048 * 128;
    c.cmp_w2 = (const float*)args.in[9] + (size_t)layer * 2 * 128 * 64;
    c.q_norm = (const float*)args.in[10] + layer * 384;
    c.kv_norm = (const float*)args.in[11] + layer * 256;
    c.w_uq = (const float*)args.in[12] + (size_t)layer * 384 * 768;
    c.w_ukv = (const float*)args.in[13] + (size_t)layer * 256 * 1024;
    c.w_branch = (const float*)args.in[14] + (size_t)layer * 3 * 512 * 1024;
    c.w_out = (const float*)args.in[15] + (size_t)layer * DM * DM;
    c.w_fg = (const float*)args.in[16] + (size_t)layer * DM * DFF;
    c.w_fu = (const float*)args.in[17] + (size_t)layer * DM * DFF;
    c.w_fd = (const float*)args.in[18] + (size_t)layer * DFF * DM;
    return c;
}

#define PHASE_IDS int tid_o = threadIdx.x; asm volatile("" : "+v"(tid_o)); const int tid = tid_o, lane = tid & 63, wave = __builtin_amdgcn_readfirstlane(tid >> 6), gw = blk * 8 + wave; \
    LAS float* wscr = (LAS float*)(lds + wave * 16384); (void)wscr; (void)gw; (void)lane; (void)tid

enum { PH_P0 = 0, PH_A2, PH_B, PH_E, PH_F, PH_F2, PH_G, PH_H, PH_H2 };

template <int PH>
__device__ __forceinline__ void run_phase(const Args& args, int layer, unsigned char* lds_raw) {
    LAS unsigned char* lds = (LAS unsigned char*)lds_raw;
    const int G = gridDim.x, blk = blockIdx.x, NGW = G * 8;
    const Ctx c = make_ctx(args, layer);
    if constexpr (PH == PH_P0) {
        PHASE_IDS;
        constexpr int I_IN = (DM / 64) * (NZ / 32), I_G = (DM / 64) * (3072 / 32), I_UQ = (384 / 64) * (768 / 32), I_UKV = (256 / 64) * (1024 / 32);
        constexpr int I_BR = (512 / 64) * (1024 / 32), I_OUT = (DM / 64) * (DM / 32);
        constexpr int I_C1 = (2048 / 64) * (256 / 32);
        constexpr int NIT = I_IN + I_G + I_UQ + I_UKV + 3 * I_BR + I_OUT + 2 * I_C1;
#pragma unroll 1
        for (int it = gw; it < NIT; it += NGW) {
            int r = it;
            if (r < I_IN) { tr_item(MapIn{c.w_in}, DIN, c.gains, c.W_IN, DM, NZ / 32, r, wscr, lane); continue; } r -= I_IN;
            if (r < I_G) { tr_item(MapPlain{c.w_in, 3520, 1.f}, DIN, c.gains, c.W_G, DM, 3072 / 32, r, wscr, lane); continue; } r -= I_G;
            if (r < I_UQ) { tr_item(MapPlain{c.w_uq, 0, QSCALE_MLA}, 768, c.q_norm, c.W_UQ, 384, 768 / 32, r, wscr, lane); continue; } r -= I_UQ;
            if (r < I_UKV) { tr_item(MapPlain{c.w_ukv, 0, 1.f}, 1024, c.kv_norm, c.W_UKV, 256, 1024 / 32, r, wscr, lane); continue; } r -= I_UKV;
            if (r < 3 * I_BR) { const int br = r / I_BR; tr_item(MapPlain{c.w_branch + (size_t)br * 512 * 1024, 0, 1.f}, 1024, nullptr, c.W_BR + (size_t)br * 1024 * 512, 512, 1024 / 32, r % I_BR, wscr, lane); continue; } r -= 3 * I_BR;
            if (r < I_OUT) { tr_item(MapPlain{c.w_out, 0, 1.f}, DM, nullptr, c.W_OUT, DM, DM / 32, r, wscr, lane); continue; } r -= I_OUT;
            { const int kv = r / I_C1; tr_item(MapPad{c.cmp_w1 + (size_t)kv * 2048 * 128, 128}, 128, nullptr, c.W_C1 + (size_t)kv * 256 * 2048, 2048, 256 / 32, r % I_C1, wscr, lane); }
        }
#pragma unroll 1
        for (int o = gw; o < 256; o += NGW) {
            const int kv = o >> 7, j = o & 127; float a = 0.f;
            for (int k = lane; k < 2048; k += 64) a += c.cmp_pos[kv * 2048 + k] * c.cmp_w1[((size_t)kv * 2048 + k) * 128 + j];
            a = wave_sum(a); if (lane == 0) c.B1[o] = a;
        }
        if (layer == 0) {
#pragma unroll 1
            for (int i = blk * 512 + tid; i < T * 16; i += G * 512) {
                const int t = i >> 4, d = i & 15;
                const double f4 = (d & 3) == 0 ? 1.0 : (d & 3) == 1 ? 0.5623413251903491 : (d & 3) == 2 ? 0.31622776601683794 : 0.1778279410038923;
                const double f1 = (d >> 2) == 0 ? 1.0 : (d >> 2) == 1 ? 0.1 : (d >> 2) == 2 ? 0.01 : 0.001;
                const double ang = (double)c.positions[t] * (f4 * f1);
                const double q = rint(ang * 0.6366197723675814);
                const double y = fma(-q, 6.123233995736766e-17, fma(-q, 1.5707963267948966, ang));
                const double y2 = y * y;
                const double sy = y * (1.0 + y2 * (-1.0 / 6 + y2 * (1.0 / 120 + y2 * (-1.0 / 5040 + y2 * (1.0 / 362880 + y2 * (-1.0 / 39916800))))));
                const double cy = 1.0 + y2 * (-0.5 + y2 * (1.0 / 24 + y2 * (-1.0 / 720 + y2 * (1.0 / 40320 + y2 * (-1.0 / 3628800 + y2 * (1.0 / 479001600))))));
                const int qi = (int)q & 3;
                const double cs = qi == 0 ? cy : qi == 1 ? -sy : qi == 2 ? -cy : sy;
                const double sn = qi == 0 ? sy : qi == 1 ? cy : qi == 2 ? -sy : -cy;
                c.ROPE[2 * (size_t)i] = (float)cs; c.ROPE[2 * (size_t)i + 1] = (float)sn;
            }
#pragma unroll 1
            for (int m = gw; m < T; m += NGW) row_resnorm(c.x_in + (size_t)m * DM, nullptr, nullptr, nullptr, c.XB + (size_t)m * DM, lane);
        }
    }
    if constexpr (PH == PH_A2) {
        pg8::Gemm g{c.XB, c.W_IN}; pg8::StaticOrder S; S.init(T, NZ, G, blk);
        EpiInProj E{c.AQK, c.AV, c.AO, c.BQ, c.BKV, c.CQKV, c.KR, c.SM, c.SSQ, c.ROPE, c.m_gbias};
        pg8::gemm_phase<DM, DM, DM, 128>(lds, g, S, E);
    }
    if constexpr (PH == PH_B) {
        { pg8::Gemm g{c.CQKV, c.W_UQ}; pg8::StaticOrder S; S.init(T, 768, G, blk); EpiMlaQ E{c.QM, c.SSQ, c.ROPE}; pg8::gemm_phase<384, 640, 384, 128>(lds, g, S, E); }
        { pg8::Gemm g{c.CQKV + 384, c.W_UKV}; pg8::StaticOrder S; S.init(T, 1024, G, blk); EpiMlaKV E{c.KN, c.VM, c.SSQ}; pg8::gemm_phase<256, 640, 256, 128>(lds, g, S, E); }
        { pg8::Gemm g{c.BKV, c.W_C1}; RangeOrder S{8, G - 16, 8, blk}; EpiCompress E{c.B1, c.cmp_w2, c.KCB}; pg8::gemm_phase<2048, 1024, 2048, 128>(lds, g, S, E); }
        { pg8::Gemm g{c.BKV + (size_t)NB * 2 * SEQ * 64, c.W_C1 + (size_t)256 * 2048}; RangeOrder S{8, G - 8, 8, blk}; EpiCompress E{c.B1 + 128, c.cmp_w2 + 128 * 64, c.KCB + (size_t)8 * 256 * 64}; pg8::gemm_phase<2048, 1024, 2048, 128>(lds, g, S, E); }
    }
    if constexpr (PH == PH_E) {
        pg8::StaticOrder S; S.init(T, DM, G, blk);
        bf16* GT = c.GTall + (size_t)blk * 65536;
        { pg8::Gemm g{c.XB, c.W_G}; EpiGate E{GT}; pg8::gemm_phase<DM, DM, DM, 128>(lds, g, S, E); }
        { pg8::Gemm g{c.AV, c.W_BR}; EpiBranch E{GT, c.MERGED, 1}; pg8::gemm_phase<512, 512, 512, 128>(lds, g, S, E); }
        { pg8::Gemm g{c.XB, c.W_G + (size_t)1024 * 1024}; EpiGate E{GT}; pg8::gemm_phase<DM, DM, DM, 128>(lds, g, S, E); }
        { pg8::Gemm g{c.BQ, c.W_BR + (size_t)1024 * 512}; EpiBranch E{GT, c.MERGED, 0}; pg8::gemm_phase<512, 512, 512, 128>(lds, g, S, E); }
        { pg8::Gemm g{c.XB, c.W_G + (size_t)2 * 1024 * 1024}; EpiGate E{GT}; pg8::gemm_phase<DM, DM, DM, 128>(lds, g, S, E); }
        { pg8::Gemm g{c.QM, c.W_BR + (size_t)2 * 1024 * 512}; EpiBranch E{GT, c.MERGED, 0}; pg8::gemm_phase<512, 768, 512, 192>(lds, g, S, E); }
    }
    if constexpr (PH == PH_F) {
        {
            PHASE_IDS;
            constexpr int I_GU = (DM / 64) * (2 * DFF / 32), I_DN = (DFF / 64) * (DM / 32);
#pragma unroll 1
            for (int it = gw; it < I_GU + I_DN; it += NGW) {
                if (it < I_GU) {
                    const int n0 = 32 * (it % (2 * DFF / 32)), j = n0 >> 8, w = n0 & 255;
                    if (w < 128) tr_item(MapPlain{c.w_fg, 128 * j + w - n0, 1.f}, DFF, c.gains + 2 * DM, c.W_GU, DM, 2 * DFF / 32, it, wscr, lane);
                    else tr_item(MapPlain{c.w_fu, 128 * j + (w - 128) - n0, 1.f}, DFF, c.gains + 2 * DM, c.W_GU, DM, 2 * DFF / 32, it, wscr, lane);
                }
                else tr_item(MapPlain{c.w_fd, 0, 1.f}, DM, nullptr, c.W_DN, DFF, DM / 32, it - I_GU, wscr, lane);
            }
        }
        __syncthreads();
        pg8::Gemm g{c.MERGED, c.W_OUT}; pg8::StaticOrder S; S.init(T, DM, G, blk); EpiF32 E{c.MIX, DM};
        pg8::gemm_phase<DM, DM, DM, 128>(lds, g, S, E);
    }
    if constexpr (PH == PH_F2) {
        PHASE_IDS;
#pragma unroll 1
        for (int m = gw; m < T; m += NGW) row_resnorm((layer == 0 ? c.x_in : c.XS) + (size_t)m * DM, c.MIX + (size_t)m * DM, c.gains + DM, c.XS + (size_t)m * DM, c.XB + (size_t)m * DM, lane);
    }
    if constexpr (PH == PH_G) {
        pg8::Gemm g{c.XB, c.W_GU}; pg8::StaticOrder S; S.init(T, 2 * DFF, G, blk); EpiSwiGLU E{c.U};
        pg8::gemm_phase<DM, DM, DM, 128>(lds, g, S, E);
    }
    if constexpr (PH == PH_H) {
        pg8::Gemm g{c.U, c.W_DN}; pg8::StaticOrder S; S.init(T, DM, G, blk); EpiF32 E{c.FD, DM};
        pg8::gemm_phase<DFF, DFF, DFF, 128>(lds, g, S, E);
    }
    if constexpr (PH == PH_H2) {
        PHASE_IDS;
#pragma unroll 1
        for (int m = gw; m < T; m += NGW) row_resnorm(c.XS + (size_t)m * DM, c.FD + (size_t)m * DM, c.gains + 3 * DM, c.XS + (size_t)m * DM, c.XB + (size_t)m * DM, lane);
    }
}
template <int PH>
__global__ void __launch_bounds__(512, 2) k_phase(Args args, int layer) {
    extern __shared__ __attribute__((aligned(16))) unsigned char lds_raw[];
    run_phase<PH>(args, layer, lds_raw);
}

namespace att {
typedef float f32x16 __attribute__((ext_vector_type(16)));
typedef short s16x4 __attribute__((ext_vector_type(4)));
constexpr int VST = 192;
__device__ __forceinline__ int crow(int r, int hi) { return (r & 3) + 8 * (r >> 2) + 4 * hi; }
__device__ __forceinline__ s16x4 vtr(const LAS unsigned char* p) { return __builtin_bit_cast(s16x4, __builtin_amdgcn_ds_read_tr16_b64_v4i16((LAS s16x4*)p)); }
__device__ __forceinline__ bf16x8 pack8f(const f32x16& p, int b) {
    u32x4 w; w.x = pk2(p[b], p[b + 1]); w.y = pk2(p[b + 2], p[b + 3]); w.z = pk2(p[b + 4], p[b + 5]); w.w = pk2(p[b + 6], p[b + 7]);
    return __builtin_bit_cast(bf16x8, w);
}
struct Pass {
    f32x16 o[2]; float l;
};
template <int DQK, int MODE>
__device__ __forceinline__ Pass attn_pass(LAS unsigned char* lds, const bf16x8* qf, const bf16* K1, int ld1, const bf16* K2, int ld2, const bf16* V, int ldv,
                                          unsigned long long tmask, int qpos, unsigned long long sel, int q0) {
    constexpr int KST = DQK == 96 ? 208 : 144;
    constexpr int KBYTES = 64 * KST, VBYTES = 64 * VST, BUF = KBYTES + VBYTES;
    int tid_o = threadIdx.x; asm volatile("" : "+v"(tid_o));
    const int tid = tid_o, lane = tid & 63, hi = lane >> 5, r32 = lane & 31;
    Pass R; R.o[0] = f32x16{}; R.o[1] = f32x16{}; float m = -INFINITY, l = 0.f;
    const int skey = tid >> 3, sch = tid & 7;
    u32x4 kreg, vreg, k2reg;
    unsigned mlo = (unsigned)tmask, mhi = (unsigned)(tmask >> 32);
    auto next_tile = [&]() -> int {
        int j;
        if (mlo) { j = __builtin_ctz(mlo); mlo &= mlo - 1; } else if (mhi) { j = 32 + __builtin_ctz(mhi); mhi &= mhi - 1; } else j = -1;
        return j;
    };
    int jcur = next_tile();
    if (jcur < 0) { R.l = 0.f; return R; }
    auto gload = [&](int j) {
        kreg = *(const u32x4*)(K1 + (size_t)(j * 64 + skey) * ld1 + sch * 8);
        vreg = *(const u32x4*)(V + (size_t)(j * 64 + skey) * ldv + sch * 8);
        if (DQK == 96) { if (tid < 256) k2reg = *(const u32x4*)(K2 + (size_t)(j * 64 + (tid >> 2)) * ld2 + (tid & 3) * 8); }
    };
    auto lstore = [&](int buf) {
        LAS unsigned char* kb = lds + buf * BUF; LAS unsigned char* vb = kb + KBYTES;
        *(LAS u32x4*)(kb + skey * KST + sch * 16) = kreg;
        *(LAS u32x4*)(vb + skey * VST + sch * 16) = vreg;
        if (DQK == 96) { if (tid < 256) *(LAS u32x4*)(kb + (tid >> 2) * KST + 128 + (tid & 3) * 16) = k2reg; }
    };
    gload(jcur); lstore(0);
    __syncthreads();
    int buf = 0;
    const int vlane = (4 * hi + ((lane & 15) >> 2)) * VST + (16 * ((lane >> 4) & 1) + 4 * (lane & 3)) * 2;
    while (jcur >= 0) {
        const int jnext = next_tile();
        if (jnext >= 0) gload(jnext);
        const LAS unsigned char* kb = lds + buf * BUF; const LAS unsigned char* vb = kb + KBYTES;
        f32x16 p0 = f32x16{}, p1 = f32x16{};
#pragma unroll
        for (int s = 0; s < DQK / 16; ++s) {
            const bf16x8 k0 = *(const LAS bf16x8*)(kb + r32 * KST + s * 32 + hi * 16);
            const bf16x8 k1 = *(const LAS bf16x8*)(kb + (32 + r32) * KST + s * 32 + hi * 16);
            p0 = __builtin_amdgcn_mfma_f32_32x32x16_bf16(k0, qf[s], p0, 0, 0, 0);
            p1 = __builtin_amdgcn_mfma_f32_32x32x16_bf16(k1, qf[s], p1, 0, 0, 0);
        }
        bool need = true;
        if (MODE == 0) need = (jcur * 64 + 63 > q0);
        if (need) {
            const int kbase = jcur * 64 + 4 * hi;
            bool rowok = true;
            if (MODE == 1) rowok = (sel >> jcur) & 1ull;
#pragma unroll
            for (int r = 0; r < 16; ++r) {
                const int k0i = kbase + (r & 3) + 8 * (r >> 2), k1i = k0i + 32;
                bool ok0 = rowok && (k0i <= qpos), ok1 = rowok && (k1i <= qpos);
                if (MODE == 2) { ok0 = ok0 && (qpos - k0i < 512); ok1 = ok1 && (qpos - k1i < 512); }
                if (!ok0) p0[r] = -INFINITY;
                if (!ok1) p1[r] = -INFINITY;
            }
        }
        float rm = fmaxf(p0[0], p1[0]);
#pragma unroll
        for (int r = 1; r < 16; ++r) rm = fmaxf(rm, fmaxf(p0[r], p1[r]));
        rm = fmaxf(rm, __shfl_xor(rm, 32));
        const float mn = fmaxf(m, rm);
        const float ms = (mn == -INFINITY) ? 0.f : mn;
        const float alpha = exp2f(m - ms);
        m = mn;
        float ps = 0.f;
#pragma unroll
        for (int r = 0; r < 16; ++r) { p0[r] = exp2f(p0[r] - ms); p1[r] = exp2f(p1[r] - ms); ps += p0[r] + p1[r]; }
        l = l * alpha + ps;
#pragma unroll
        for (int r = 0; r < 16; ++r) { R.o[0][r] *= alpha; R.o[1][r] *= alpha; }
        bf16x8 pb[4];
        pb[0] = pack8f(p0, 0); pb[1] = pack8f(p0, 8); pb[2] = pack8f(p1, 0); pb[3] = pack8f(p1, 8);
#pragma unroll
        for (int db = 0; db < 2; ++db)
#pragma unroll
            for (int ks = 0; ks < 4; ++ks) {
                const LAS unsigned char* vp = vb + ks * 16 * VST + db * 64 + vlane;
                const s16x4 lo = vtr(vp), hh = vtr(vp + 8 * VST);
                const bf16x8 vf = (bf16x8){lo[0], lo[1], lo[2], lo[3], hh[0], hh[1], hh[2], hh[3]};
                R.o[db] = __builtin_amdgcn_mfma_f32_32x32x16_bf16(vf, pb[ks], R.o[db], 0, 0, 0);
            }
        if (jnext >= 0) lstore(buf ^ 1);
        __syncthreads();
        buf ^= 1; jcur = jnext;
    }
    R.l = l + __shfl_xor(l, 32);
    return R;
}
}

constexpr int ATT_LDS = 2 * (64 * 208 + 64 * att::VST);

__device__ __forceinline__ void mla_attn_phase(const Ctx& c, LAS unsigned char* lds) {
    const int blk = blockIdx.x;
    const int bh = blk >> 3, b = bh >> 3, h = bh & 7;
    const bf16* Kh = c.KN + (size_t)(b * 8 + h) * SEQ * 64; const bf16* Vh = c.VM + (size_t)(b * 8 + h) * SEQ * 64; const bf16* Krh = c.KR + (size_t)b * SEQ * 32;
#pragma unroll 1
    for (int u = 0; u < 2; ++u) {
        int tid_o = threadIdx.x; asm volatile("" : "+v"(tid_o));
        const int tid = tid_o, lane = tid & 63, wave = tid >> 6, hi = lane >> 5, r32 = lane & 31;
        const int qb = u == 0 ? (blk & 7) : 15 - (blk & 7);
        const int q0 = qb * 256, qpos = q0 + wave * 32 + r32;
        bf16* qrow = c.QM + ((size_t)b * SEQ + qpos) * 768 + h * 96;
        bf16x8 qf[6];
#pragma unroll
        for (int s = 0; s < 6; ++s) qf[s] = *(const bf16x8*)(qrow + s * 16 + hi * 8);
        const int nt = (q0 + 256) / 64;
        const unsigned long long tmask = nt >= 64 ? ~0ull : ((1ull << nt) - 1ull);
        const att::Pass R = att::attn_pass<96, 0>(lds, qf, Kh, 64, Krh, 32, Vh, 64, tmask, qpos, 0ull, q0);
        const float inv = 1.0f / R.l;
#pragma unroll
        for (int db = 0; db < 2; ++db)
#pragma unroll
            for (int g4 = 0; g4 < 4; ++g4) {
                u32x2 w; w.x = pk2(R.o[db][4 * g4] * inv, R.o[db][4 * g4 + 1] * inv); w.y = pk2(R.o[db][4 * g4 + 2] * inv, R.o[db][4 * g4 + 3] * inv);
                *(u32x2*)(qrow + db * 32 + 8 * g4 + 4 * hi) = w;
            }
    }
}
__device__ __forceinline__ void nsa_attn_phase(const Ctx& c, LAS unsigned char* lds) {
    const int blk = blockIdx.x;
    const int bg = blk >> 5, b = bg >> 1, gg = bg & 1;
    const bf16* Ks = c.BKV + (size_t)((2 * NB + b) * 2 + gg) * SEQ * 64; const bf16* Vs = c.BKV + (size_t)((3 * NB + b) * 2 + gg) * SEQ * 64;
    const bf16* Kw = c.BKV + (size_t)((4 * NB + b) * 2 + gg) * SEQ * 64; const bf16* Vw = c.BKV + (size_t)((5 * NB + b) * 2 + gg) * SEQ * 64;
#pragma unroll 1
    for (int u = 0; u < 2; ++u) {
        int tid_o = threadIdx.x; asm volatile("" : "+v"(tid_o));
        const int tid = tid_o, lane = tid & 63, wave = tid >> 6, hi = lane >> 5, r32 = lane & 31;
        const int tt = u == 0 ? (blk & 31) : 63 - (blk & 31);
        const int q0 = tt * 64, row = wave * 32 + r32, qpos = q0 + (row >> 2), hh = gg * 4 + (row & 3);
        const size_t t = (size_t)b * SEQ + qpos;
        bf16* qrow = c.BQ + t * 512 + hh * 64;
        bf16x8 qf[4];
#pragma unroll
        for (int s = 0; s < 4; ++s) qf[s] = *(const bf16x8*)(qrow + s * 16 + hi * 8);
        const unsigned long long sel = c.SEL[t * 2 + gg];
        unsigned long long um = sel;
#pragma unroll
        for (int o = 1; o < 64; o <<= 1) { const unsigned lo = __shfl_xor((unsigned)um, o), hx = __shfl_xor((unsigned)(um >> 32), o); um |= ((unsigned long long)hx << 32) | lo; }
        LAS unsigned long long* ux = (LAS unsigned long long*)(lds + ATT_LDS);
        if (lane == 0) ux[wave] = um;
        __syncthreads();
        unsigned long long uall = 0ull;
#pragma unroll
        for (int w = 0; w < 8; ++w) uall |= ux[w];
        const unsigned ulo = __builtin_amdgcn_readfirstlane((unsigned)uall), uhi = __builtin_amdgcn_readfirstlane((unsigned)(uall >> 32));
        const unsigned long long tm_sel = (((unsigned long long)uhi << 32) | ulo) & (tt >= 63 ? ~0ull : ((1ull << (tt + 1)) - 1ull));
        const att::Pass Rs = att::attn_pass<64, 1>(lds, qf, Ks, 64, nullptr, 0, Vs, 64, tm_sel, qpos, sel, q0);
        const float gs = c.SM[t * 32 + 8 + hh * 3 + 1], gwn = c.SM[t * 32 + 8 + hh * 3 + 2];
        const float fs = Rs.l > 0.f ? gs / Rs.l : 0.f;
        att::f32x16 res[2];
#pragma unroll
        for (int db = 0; db < 2; ++db)
#pragma unroll
            for (int r = 0; r < 16; ++r) res[db][r] = Rs.o[db][r] * fs;
        const int j0 = tt >= 8 ? tt - 8 : 0;
        const unsigned long long tm_win = (tt >= 63 ? ~0ull : ((1ull << (tt + 1)) - 1ull)) & ~((1ull << j0) - 1ull);
        const att::Pass Rw = att::attn_pass<64, 2>(lds, qf, Kw, 64, nullptr, 0, Vw, 64, tm_win, qpos, 0ull, q0);
        const float fw = Rw.l > 0.f ? gwn / Rw.l : 0.f;
        const bf16* p1row = c.P1 + t * 512 + hh * 64;
#pragma unroll
        for (int db = 0; db < 2; ++db)
#pragma unroll
            for (int g4 = 0; g4 < 4; ++g4) {
                const u32x2 pw = *(const u32x2*)(p1row + db * 32 + 8 * g4 + 4 * hi);
                const float y0 = res[db][4 * g4] + Rw.o[db][4 * g4] * fw + bflo(pw.x), y1 = res[db][4 * g4 + 1] + Rw.o[db][4 * g4 + 1] * fw + bfhi(pw.x);
                const float y2 = res[db][4 * g4 + 2] + Rw.o[db][4 * g4 + 2] * fw + bflo(pw.y), y3 = res[db][4 * g4 + 3] + Rw.o[db][4 * g4 + 3] * fw + bfhi(pw.y);
                u32x2 w; w.x = pk2(y0, y1); w.y = pk2(y2, y3);
                *(u32x2*)(qrow + db * 32 + 8 * g4 + 4 * hi) = w;
            }
        __syncthreads();
    }
}
__device__ __forceinline__ void cmp_attn_phase(const Ctx& c, LAS unsigned char* lds) {
    using att::f32x16;
    constexpr int KST = 144, VST = att::VST, KOFF = 0, VOFF = 256 * KST, GOFF = VOFF + 256 * VST, LOFF = GOFF + 64 * 64 * 4;
    const int blk = blockIdx.x;
    const int bg = blk >> 5, b = bg >> 1, gg = bg & 1;
    const bf16* Kc = c.KCB + (size_t)(0 * 8 + bg) * 256 * 64; const bf16* Vc = c.KCB + (size_t)(1 * 8 + bg) * 256 * 64;
#pragma unroll 1
    for (int u = 0; u < 2; ++u) {
        int tid_o = threadIdx.x; asm volatile("" : "+v"(tid_o));
        const int tid = tid_o, lane = tid & 63, wave = tid >> 6, hi = lane >> 5, r32 = lane & 31;
        const int tt = u == 0 ? (blk & 31) : 63 - (blk & 31);
        const int q0 = tt * 64, row = wave * 32 + r32, qpos = q0 + (row >> 2), hh = gg * 4 + (row & 3);
        const size_t t = (size_t)b * SEQ + qpos;
        const bf16* qrow = c.BQ + t * 512 + hh * 64;
        bf16x8 qf[4];
#pragma unroll
        for (int s = 0; s < 4; ++s) qf[s] = *(const bf16x8*)(qrow + s * 16 + hi * 8);
        int ntile = ((q0 + 32) >> 4) / 64 + 1; if (ntile > 4) ntile = 4;
        for (int idx = tid; idx < ntile * 512; idx += 512) {
            const int key = idx >> 3, ch = idx & 7;
            *(LAS u32x4*)(lds + KOFF + key * KST + ch * 16) = *(const u32x4*)(Kc + (size_t)key * 64 + ch * 8);
            *(LAS u32x4*)(lds + VOFF + key * VST + ch * 16) = *(const u32x4*)(Vc + (size_t)key * 64 + ch * 8);
        }
        LAS float* Gs = (LAS float*)(lds + GOFF); LAS float* Ls = (LAS float*)(lds + LOFF);
#pragma unroll
        for (int i = 0; i < 8; ++i) { Gs[tid + 512 * i] = 0.f; Ls[tid + 512 * i] = 0.f; }
        __syncthreads();
        float m = -INFINITY, l = 0.f;
#pragma unroll 1
        for (int pass = 0; pass < 2; ++pass) {
            const float ms = (m == -INFINITY) ? 0.f : m;
            float inv = 0.f;
            if (pass == 1) { const float lt = l + __shfl_xor(l, 32); inv = lt > 0.f ? 1.0f / lt : 0.f; }
            f32x16 o0 = f32x16{}, o1 = f32x16{};
#pragma unroll 1
            for (int kt = 0; kt < ntile; ++kt) {
                const LAS unsigned char* kb = lds + KOFF + kt * 64 * KST;
                f32x16 p0 = f32x16{}, p1 = f32x16{};
#pragma unroll
                for (int s = 0; s < 4; ++s) {
                    const bf16x8 k0 = *(const LAS bf16x8*)(kb + r32 * KST + s * 32 + hi * 16);
                    const bf16x8 k1 = *(const LAS bf16x8*)(kb + (32 + r32) * KST + s * 32 + hi * 16);
                    p0 = __builtin_amdgcn_mfma_f32_32x32x16_bf16(k0, qf[s], p0, 0, 0, 0);
                    p1 = __builtin_amdgcn_mfma_f32_32x32x16_bf16(k1, qf[s], p1, 0, 0, 0);
                }
                const int nb0 = kt * 64 + 4 * hi;
#pragma unroll
                for (int r = 0; r < 16; ++r) {
                    const int n0 = nb0 + (r & 3) + 8 * (r >> 2), n1 = n0 + 32;
                    if (!((16 * n0 + 31 <= qpos) && n0 < 255)) p0[r] = -INFINITY;
                    if (!((16 * n1 + 31 <= qpos) && n1 < 255)) p1[r] = -INFINITY;
                }
                if (pass == 0) {
                    float rm = fmaxf(p0[0], p1[0]);
#pragma unroll
                    for (int r = 1; r < 16; ++r) rm = fmaxf(rm, fmaxf(p0[r], p1[r]));
                    rm = fmaxf(rm, __shfl_xor(rm, 32));
                    const float mn = fmaxf(m, rm); const float msn = (mn == -INFINITY) ? 0.f : mn;
                    const float alpha = exp2f(m - msn); m = mn;
                    float ps = 0.f;
#pragma unroll
                    for (int r = 0; r < 16; ++r) ps += exp2f(p0[r] - msn) + exp2f(p1[r] - msn);
                    l = l * alpha + ps;
                } else {
#pragma unroll
                    for (int r = 0; r < 16; ++r) { p0[r] = exp2f(p0[r] - ms) * inv; p1[r] = exp2f(p1[r] - ms) * inv; }
#pragma unroll
                    for (int hf = 0; hf < 2; ++hf)
#pragma unroll
                        for (int g = 0; g < 4; ++g) {
                            const f32x16& p = hf == 0 ? p0 : p1;
                            float G = (p[4 * g] + p[4 * g + 1]) + (p[4 * g + 2] + p[4 * g + 3]), L = p[4 * g + 3];
                            G += __shfl_xor(G, 1); G += __shfl_xor(G, 2); L += __shfl_xor(L, 1); L += __shfl_xor(L, 2);
                            if ((lane & 3) == 0) { const int j = 16 * kt + 8 * hf + 2 * g + hi; Gs[(row >> 2) * 64 + j] = G; Ls[(row >> 2) * 64 + j] = L; }
                        }
                    bf16x8 pb[4];
                    pb[0] = att::pack8f(p0, 0); pb[1] = att::pack8f(p0, 8); pb[2] = att::pack8f(p1, 0); pb[3] = att::pack8f(p1, 8);
                    const int vlane = (4 * hi + ((lane & 15) >> 2)) * VST + (16 * ((lane >> 4) & 1) + 4 * (lane & 3)) * 2;
                    const LAS unsigned char* vb = lds + VOFF + kt * 64 * VST;
#pragma unroll
                    for (int ks = 0; ks < 4; ++ks) {
                        const LAS unsigned char* vp = vb + ks * 16 * VST + vlane;
                        const att::s16x4 lo0 = att::vtr(vp), hh0 = att::vtr(vp + 8 * VST), lo1 = att::vtr(vp + 64), hh1 = att::vtr(vp + 64 + 8 * VST);
                        const bf16x8 vf0 = (bf16x8){lo0[0], lo0[1], lo0[2], lo0[3], hh0[0], hh0[1], hh0[2], hh0[3]};
                        const bf16x8 vf1 = (bf16x8){lo1[0], lo1[1], lo1[2], lo1[3], hh1[0], hh1[1], hh1[2], hh1[3]};
                        o0 = __builtin_amdgcn_mfma_f32_32x32x16_bf16(vf0, pb[ks], o0, 0, 0, 0);
                        o1 = __builtin_amdgcn_mfma_f32_32x32x16_bf16(vf1, pb[ks], o1, 0, 0, 0);
                    }
                }
            }
            if (pass == 1) {
                const float gc = c.SM[t * 32 + 8 + hh * 3 + 0];
                bf16* prow = c.P1 + t * 512 + hh * 64;
#pragma unroll
                for (int g4 = 0; g4 < 4; ++g4) {
                    u32x2 w; w.x = pk2(o0[4 * g4] * gc, o0[4 * g4 + 1] * gc); w.y = pk2(o0[4 * g4 + 2] * gc, o0[4 * g4 + 3] * gc);
                    *(u32x2*)(prow + 8 * g4 + 4 * hi) = w;
                    u32x2 w2; w2.x = pk2(o1[4 * g4] * gc, o1[4 * g4 + 1] * gc); w2.y = pk2(o1[4 * g4 + 2] * gc, o1[4 * g4 + 3] * gc);
                    *(u32x2*)(prow + 32 + 8 * g4 + 4 * hi) = w2;
                }
            }
        }
        __syncthreads();
#pragma unroll 1
        for (int i = 0; i < 8; ++i) {
            const int tok = wave * 8 + i, s = q0 + tok;
            const float imp = Gs[tok * 64 + lane] + (lane > 0 ? Ls[tok * 64 + lane - 1] : 0.f);
            const int cur = s >> 6;
            const bool vj = lane <= cur; const bool forced = (lane == 0) || (lane == cur) || (lane == cur - 1);
            const float score = vj ? imp + (forced ? 1e4f : 0.f) : -1.0f;
            int cnt = 0;
#pragma unroll 8
            for (int i2 = 0; i2 < 64; ++i2) { const float si = rdlane(score, i2); cnt += ((si > score) || (si == score && i2 < lane)) ? 1 : 0; }
            const bool selb = (cnt < 16) && (score > -0.5f);
            const unsigned long long mask = __ballot(selb);
            if (lane == 0) c.SEL[((size_t)b * SEQ + s) * 2 + gg] = mask;
        }
        __syncthreads();
    }
}
namespace ml {
using att::f32x16; using att::s16x4;
constexpr int QST = 144, KTST = 192, VST2 = 320, CST = 144;
__device__ __forceinline__ float scan_add(float v, int lane) {
#pragma unroll
    for (int o = 1; o < 64; o <<= 1) { const float u = __shfl_up(v, o); if (lane >= o) v += u; }
    return v;
}
__device__ __forceinline__ float scan_max(float v, int lane) {
#pragma unroll
    for (int o = 1; o < 64; o <<= 1) { const float u = __shfl_up(v, o); if (lane >= o) v = fmaxf(v, u); }
    return v;
}
__device__ __forceinline__ void conv8(const bf16* AQK, const float* m_conv, int b, int s, int ch0, float scale, float (&out)[8]) {
    float a[8] = {0.f, 0.f, 0.f, 0.f, 0.f, 0.f, 0.f, 0.f};
#pragma unroll
    for (int kk = 0; kk < 4; ++kk) {
        const int sp = s - 3 + kk;
        if (sp >= 0) {
            const u32x4 xv = *(const u32x4*)(AQK + ((size_t)b * SEQ + sp) * 512 + ch0);
            const f32x4 w0 = *(const f32x4*)(m_conv + kk * 512 + ch0), w1 = *(const f32x4*)(m_conv + kk * 512 + ch0 + 4);
            a[0] += w0[0] * bflo(xv.x); a[1] += w0[1] * bfhi(xv.x); a[2] += w0[2] * bflo(xv.y); a[3] += w0[3] * bfhi(xv.y);
            a[4] += w1[0] * bflo(xv.z); a[5] += w1[1] * bfhi(xv.z); a[6] += w1[2] * bflo(xv.w); a[7] += w1[3] * bfhi(xv.w);
        }
    }
#pragma unroll
    for (int e = 0; e < 8; ++e) out[e] = siluf_(a[e]) * scale;
}
__device__ __forceinline__ void ml1_phase(const Ctx& c, LAS unsigned char* lds) {
    constexpr int KOFF = 0, VOFF = 64 * KTST, SOFF = VOFF + 64 * VST2;
#pragma unroll 1
    for (int unit = blockIdx.x; unit < 1024; unit += gridDim.x) {
        int tid_o = threadIdx.x; asm volatile("" : "+v"(tid_o));
        const int tid = tid_o, lane = tid & 63, wave = tid >> 6, hi = lane >> 5, r32 = lane & 31;
        const int bh = unit >> 6, ch = unit & 63, b = bh >> 2, h = bh & 3, s0 = ch * 64;
        LAS float* wv = (LAS float*)(lds + SOFF);
        if (wave == 0) {
            const size_t t = (size_t)b * SEQ + s0 + lane;
            const float lf = c.SM[t * 32 + 4 + h], li = c.SM[t * 32 + h];
            const float bc = scan_add(lf, lane); const float g = li - bc;
            const float gmax = wave_max(g); const float bL = rdlane(bc, 63);
            wv[lane] = __expf(g - gmax);
            if (lane == 0) { c.MLOC[unit] = bL + gmax; c.BLV[unit] = bL; }
        }
        {
            const int tk = tid >> 3, cc = (tid & 7) * 16;
            const bf16* vsrc = c.AV + ((size_t)b * SEQ + s0 + tk) * 512 + h * 128 + cc;
            *(LAS u32x4*)(lds + VOFF + tk * VST2 + cc * 2) = *(const u32x4*)vsrc;
            *(LAS u32x4*)(lds + VOFF + tk * VST2 + cc * 2 + 16) = *(const u32x4*)(vsrc + 8);
        }
        __syncthreads();
        {
            const int tk = tid >> 3, cc = (tid & 7) * 8;
            float kf[8]; conv8(c.AQK, c.m_conv, b, s0 + tk, 256 + h * 64 + cc, 1.0f, kf);
            const float w = wv[tk];
            u32x4 o; o.x = pk2(kf[0] * w, kf[1] * w); o.y = pk2(kf[2] * w, kf[3] * w); o.z = pk2(kf[4] * w, kf[5] * w); o.w = pk2(kf[6] * w, kf[7] * w);
            *(LAS u32x4*)(lds + KOFF + tk * KTST + cc * 2) = o;
        }
        __syncthreads();
        if (tid < 64) {
            float a = 0.f;
#pragma unroll 8
            for (int tk = 0; tk < 64; ++tk) a += bf2f(*(const LAS unsigned short*)(lds + KOFF + tk * KTST + tid * 2));
            c.NL[(size_t)unit * 64 + tid] = a;
        }
        const int vb = wave >> 1, kb2 = wave & 1;
        const int tro = (8 * hi + ((lane & 15) >> 2)), tco = (16 * ((lane >> 4) & 1) + 4 * (lane & 3)) * 2;
        f32x16 acc = f32x16{};
#pragma unroll
        for (int ks = 0; ks < 4; ++ks) {
            const LAS unsigned char* vp = lds + VOFF + (16 * ks + tro) * VST2 + vb * 64 + tco;
            const LAS unsigned char* kp = lds + KOFF + (16 * ks + tro) * KTST + kb2 * 64 + tco;
            const s16x4 a0 = att::vtr(vp), a1 = att::vtr(vp + 4 * VST2), b0 = att::vtr(kp), b1 = att::vtr(kp + 4 * KTST);
            const bf16x8 af = (bf16x8){a0[0], a0[1], a0[2], a0[3], a1[0], a1[1], a1[2], a1[3]};
            const bf16x8 bf = (bf16x8){b0[0], b0[1], b0[2], b0[3], b1[0], b1[1], b1[2], b1[3]};
            acc = __builtin_amdgcn_mfma_f32_32x32x16_bf16(af, bf, acc, 0, 0, 0);
        }
        bf16* dst = c.CL + (size_t)unit * 8192 + kb2 * 32 + r32;
#pragma unroll
        for (int r = 0; r < 16; ++r) dst[(size_t)(vb * 32 + att::crow(r, hi)) * 64] = (bf16)f2bf(acc[r]);
        __syncthreads();
    }
}
__device__ __forceinline__ void ml2_phase(const Ctx& c) {
    const int gt = blockIdx.x * 512 + threadIdx.x;
    const int NT = gridDim.x * 512;
#pragma unroll 1
    for (int e0 = gt; e0 < 16 * 8192 + 16 * 64; e0 += NT) {
        const bool isn = e0 >= 16 * 8192;
        const int bh = isn ? (e0 - 16 * 8192) >> 6 : e0 >> 13, e = isn ? (e0 & 63) : (e0 & 8191);
        float m = 0.f, C = 0.f;
#pragma unroll 4
        for (int ch = 0; ch < 64; ++ch) {
            const int unit = bh * 64 + ch;
            const float ml = c.MLOC[unit], bl = c.BLV[unit];
            float cl;
            if (isn) { float* p = c.NL + (size_t)unit * 64 + e; cl = *p; *p = C; }
            else { bf16* p = c.CL + (size_t)unit * 8192 + e; cl = bf2f(*p); *p = (bf16)f2bf(C); }
            if (e == 0 && !isn) c.MS[unit] = m;
            const float mn = fmaxf(bl + m, ml);
            C = __expf(bl + m - mn) * C + __expf(ml - mn) * cl; m = mn;
        }
    }
}
__device__ __forceinline__ void ml3_phase(const Ctx& c, LAS unsigned char* lds) {
    constexpr int QOFF = 0, KOFF = 64 * QST, VOFF = KOFF + 64 * QST, COFF = VOFF + 64 * VST2, SOFF = COFF + 128 * CST;
#pragma unroll 1
    for (int unit = blockIdx.x; unit < 1024; unit += gridDim.x) {
        int tid_o = threadIdx.x; asm volatile("" : "+v"(tid_o));
        const int tid = tid_o, lane = tid & 63, wave = tid >> 6, hi = lane >> 5, r32 = lane & 31;
        const int bh = unit >> 6, ch = unit & 63, b = bh >> 2, h = bh & 3, s0 = ch * 64;
        LAS float* gS = (LAS float*)(lds + SOFF); LAS float* bS = gS + 64; LAS float* MS_ = gS + 128; LAS float* nS = gS + 192; LAS float* red = gS + 256;
        const float mc = c.MS[unit];
        if (wave == 0) {
            const size_t t = (size_t)b * SEQ + s0 + lane;
            const float lf = c.SM[t * 32 + 4 + h], li = c.SM[t * 32 + h];
            const float bc = scan_add(lf, lane); const float g = li - bc;
            const float pm = scan_max(g, lane);
            gS[lane] = g; bS[lane] = bc; MS_[lane] = fmaxf(mc, pm);
            nS[lane] = c.NL[(size_t)unit * 64 + lane];
        }
        {
            const int tk = tid >> 3, cc = (tid & 7) * 16;
            const bool isk = cc >= 64; const int c0 = isk ? 256 + h * 64 + (cc - 64) : h * 64 + cc;
            float f0[8], f1[8];
            conv8(c.AQK, c.m_conv, b, s0 + tk, c0, isk ? 1.0f : 0.125f, f0); conv8(c.AQK, c.m_conv, b, s0 + tk, c0 + 8, isk ? 1.0f : 0.125f, f1);
            u32x4 o0, o1; o0.x = pk2(f0[0], f0[1]); o0.y = pk2(f0[2], f0[3]); o0.z = pk2(f0[4], f0[5]); o0.w = pk2(f0[6], f0[7]);
            o1.x = pk2(f1[0], f1[1]); o1.y = pk2(f1[2], f1[3]); o1.z = pk2(f1[4], f1[5]); o1.w = pk2(f1[6], f1[7]);
            LAS unsigned char* dstp = lds + (isk ? KOFF : QOFF) + tk * QST + (isk ? cc - 64 : cc) * 2;
            *(LAS u32x4*)dstp = o0; *(LAS u32x4*)(dstp + 16) = o1;
            const bf16* vsrc = c.AV + ((size_t)b * SEQ + s0 + tk) * 512 + h * 128 + cc;
            *(LAS u32x4*)(lds + VOFF + tk * VST2 + cc * 2) = *(const u32x4*)vsrc;
            *(LAS u32x4*)(lds + VOFF + tk * VST2 + cc * 2 + 16) = *(const u32x4*)(vsrc + 8);
            const int vv = tid >> 2, kc = (tid & 3) * 16;
            const bf16* csrc = c.CL + (size_t)unit * 8192 + vv * 64 + kc;
            *(LAS u32x4*)(lds + COFF + vv * CST + kc * 2) = *(const u32x4*)csrc;
            *(LAS u32x4*)(lds + COFF + vv * CST + kc * 2 + 16) = *(const u32x4*)(csrc + 8);
        }
        __syncthreads();
        const int vb = wave >> 1, tb = wave & 1;
        const int tl = tb * 32 + r32;
        bf16x8 qf[4];
#pragma unroll
        for (int s = 0; s < 4; ++s) qf[s] = *(const LAS bf16x8*)(lds + QOFF + tl * QST + s * 32 + hi * 16);
        f32x16 p0 = f32x16{}, p1 = f32x16{};
#pragma unroll
        for (int s = 0; s < 4; ++s) {
            const bf16x8 k0 = *(const LAS bf16x8*)(lds + KOFF + r32 * QST + s * 32 + hi * 16);
            const bf16x8 k1 = *(const LAS bf16x8*)(lds + KOFF + (32 + r32) * QST + s * 32 + hi * 16);
            p0 = __builtin_amdgcn_mfma_f32_32x32x16_bf16(k0, qf[s], p0, 0, 0, 0);
            p1 = __builtin_amdgcn_mfma_f32_32x32x16_bf16(k1, qf[s], p1, 0, 0, 0);
        }
        const float Mt = MS_[tl], bt = bS[tl];
        float dsum = 0.f;
#pragma unroll
        for (int r = 0; r < 16; ++r) {
            const int sa = att::crow(r, hi), sb = sa + 32;
            const float wa = sa <= tl ? __expf(gS[sa] - Mt) : 0.f, wb = sb <= tl ? __expf(gS[sb] - Mt) : 0.f;
            p0[r] *= wa; p1[r] *= wb; dsum += p0[r] + p1[r];
        }
        dsum += __shfl_xor(dsum, 32);
        f32x16 acc = f32x16{};
#pragma unroll
        for (int s = 0; s < 4; ++s) {
            const bf16x8 cf = *(const LAS bf16x8*)(lds + COFF + (vb * 32 + r32) * CST + s * 32 + hi * 16);
            acc = __builtin_amdgcn_mfma_f32_32x32x16_bf16(cf, qf[s], acc, 0, 0, 0);
        }
        const float at = __expf(mc - Mt);
#pragma unroll
        for (int r = 0; r < 16; ++r) acc[r] *= at;
        float nq = 0.f;
#pragma unroll
        for (int s = 0; s < 4; ++s)
#pragma unroll
            for (int e = 0; e < 8; ++e) nq += nS[16 * s + 8 * hi + e] * bf2f((unsigned short)qf[s][e]);
        nq += __shfl_xor(nq, 32);
        bf16x8 pb[4];
        pb[0] = att::pack8f(p0, 0); pb[1] = att::pack8f(p0, 8); pb[2] = att::pack8f(p1, 0); pb[3] = att::pack8f(p1, 8);
        const int vlane = (4 * hi + ((lane & 15) >> 2)) * VST2 + (16 * ((lane >> 4) & 1) + 4 * (lane & 3)) * 2;
#pragma unroll
        for (int ks = 0; ks < 4; ++ks) {
            const LAS unsigned char* vp = lds + VOFF + ks * 16 * VST2 + vb * 64 + vlane;
            const s16x4 lo = att::vtr(vp), hh = att::vtr(vp + 8 * VST2);
            const bf16x8 vf = (bf16x8){lo[0], lo[1], lo[2], lo[3], hh[0], hh[1], hh[2], hh[3]};
            acc = __builtin_amdgcn_mfma_f32_32x32x16_bf16(vf, pb[ks], acc, 0, 0, 0);
        }
        const float den = at * nq + dsum;
        const float rdn = 1.0f / fmaxf(fabsf(den), __expf(-(bt + Mt)));
        float ss = 0.f;
#pragma unroll
        for (int r = 0; r < 16; ++r) { acc[r] *= rdn; ss += acc[r] * acc[r]; }
        ss += __shfl_xor(ss, 32);
        if (hi == 0) red[vb * 64 + tl] = ss;
        __syncthreads();
        const float rstd = rsqrtf((red[tl] + red[64 + tl] + red[128 + tl] + red[192 + tl]) * (1.0f / 128.0f) + EPS);
        const size_t t = (size_t)b * SEQ + s0 + tl;
#pragma unroll
        for (int g4 = 0; g4 < 4; ++g4) {
            const int v0 = vb * 32 + 8 * g4 + 4 * hi;
            const u32x2 aw = *(const u32x2*)(c.AO + t * 512 + h * 128 + v0);
            const f32x4 hn = *(const f32x4*)(c.m_hnorm + h * 128 + v0);
            u32x2 w; w.x = pk2(acc[4 * g4] * rstd * hn[0] * bflo(aw.x), acc[4 * g4 + 1] * rstd * hn[1] * bfhi(aw.x));
            w.y = pk2(acc[4 * g4 + 2] * rstd * hn[2] * bflo(aw.y), acc[4 * g4 + 3] * rstd * hn[3] * bfhi(aw.y));
            *(u32x2*)(c.AV + t * 512 + h * 128 + v0) = w;
        }
        __syncthreads();
    }
}
}
template <int WHICH>
__global__ void __launch_bounds__(512, 2) k_ml(Args args, int layer) {
    extern __shared__ __attribute__((aligned(16))) unsigned char lds_raw[];
    const Ctx c = make_ctx(args, layer);
    if (WHICH == 0) ml::ml1_phase(c, (LAS unsigned char*)lds_raw); else if (WHICH == 1) ml::ml2_phase(c); else ml::ml3_phase(c, (LAS unsigned char*)lds_raw);
}

template <int WHICH>
__global__ void __launch_bounds__(512, 2) k_attn(Args args, int layer) {
    extern __shared__ __attribute__((aligned(16))) unsigned char lds_raw[];
    const Ctx c = make_ctx(args, layer);
    if (WHICH == 0) mla_attn_phase(c, (LAS unsigned char*)lds_raw); else if (WHICH == 1) nsa_attn_phase(c, (LAS unsigned char*)lds_raw); else cmp_attn_phase(c, (LAS unsigned char*)lds_raw);
}

#define XB_TMO      128
#define XB_XCNT(j)  (256  + 64 * (j))
#define XB_XSUB(j)  (1280 + 64 * (j))
#define XB_XGEN(j)  (2304 + 64 * (j))
#define XB_TOP      3328
#define XB_TOPGEN   3392
#define XCD_BAR_WORDS 3456
#define XB_SPIN_CAP (1u << 22)
__device__ __forceinline__ unsigned xb_ld(unsigned* p)              { return __hip_atomic_load(p, __ATOMIC_RELAXED, __HIP_MEMORY_SCOPE_AGENT); }
__device__ __forceinline__ unsigned xb_add(unsigned* p, unsigned v) { return __hip_atomic_fetch_add(p, v, __ATOMIC_RELAXED, __HIP_MEMORY_SCOPE_AGENT); }
__device__ __forceinline__ unsigned xb_xcc_id() { return (unsigned)__builtin_amdgcn_s_getreg((3 << 11) | 20) & 0xFu; }
#define XB_SPIN(cond, bar) do { unsigned _sp = 0; while (cond) { __builtin_amdgcn_s_sleep(1); \
    if ((++_sp & 255u) == 0u) { if (xb_ld(&(bar)[XB_TMO])) break; if (_sp > XB_SPIN_CAP) { atomicAdd(&(bar)[XB_TMO], 1u); break; } } } } while (0)
struct XcdBarrier { unsigned* bar; unsigned x; volatile LAS unsigned* st; };
__device__ __forceinline__ XcdBarrier xcd_barrier_post(unsigned* bar, volatile LAS unsigned* st) {
    XcdBarrier b; b.bar = bar; b.x = xb_xcc_id(); b.st = st;
    if (threadIdx.x == 0) (void)xb_add(&bar[XB_XCNT(b.x)], 1u);
    return b;
}
__device__ __forceinline__ void xcd_barrier_complete(unsigned* bar, unsigned x, unsigned& nloc, unsigned& nx) {
    const unsigned G = gridDim.x * gridDim.y * gridDim.z;
    unsigned sum, cnt, mine, sp = 0u;
    for (;;) {
        sum = 0u; cnt = 0u; mine = 0u;
#pragma unroll
        for (unsigned j = 0; j < 16; ++j) { const unsigned c = xb_ld(&bar[XB_XCNT(j)]); sum += c; cnt += (c > 0u) ? 1u : 0u; mine = (j == x) ? c : mine; }
        if (sum == G) break;
        __builtin_amdgcn_s_sleep(1);
        if ((++sp & 255u) == 0u) { if (xb_ld(&bar[XB_TMO])) break; if (sp > XB_SPIN_CAP) { atomicAdd(&bar[XB_TMO], 1u); break; } }
    }
    nloc = mine > 0u ? mine : 1u; nx = cnt > 0u ? cnt : 1u;
}
__device__ __forceinline__ void xcd_barrier(const XcdBarrier& b) {
    asm volatile("s_waitcnt vmcnt(0)" ::: "memory");
    __syncthreads();
    if (threadIdx.x == 0) {
        unsigned* bar = b.bar;
        __builtin_amdgcn_s_waitcnt(0);
        unsigned nloc = b.st[0], nx = b.st[1];
        if (nloc == 0u) { xcd_barrier_complete(bar, b.x, nloc, nx); b.st[0] = nloc; b.st[1] = nx; }
        const unsigned old = xb_add(&bar[XB_XSUB(b.x)], 1u);
        const unsigned gen = old / nloc;
        if (old + 1u == (gen + 1u) * nloc) {
            __builtin_amdgcn_fence(__ATOMIC_RELEASE, "agent");
            asm volatile("s_waitcnt vmcnt(0)" ::: "memory");
            const unsigned og = xb_add(&bar[XB_TOP], 1u);
            const unsigned tg = og / nx;
            if (og + 1u == (tg + 1u) * nx) xb_add(&bar[XB_TOPGEN], 1u);
            else XB_SPIN(xb_ld(&bar[XB_TOPGEN]) == tg, bar);
            __builtin_amdgcn_fence(__ATOMIC_ACQUIRE, "agent");
            xb_add(&bar[XB_XGEN(b.x)], 1u);
            asm volatile("s_waitcnt vmcnt(0)" ::: "memory");
        } else {
            XB_SPIN(xb_ld(&bar[XB_XGEN(b.x)]) == gen, bar);
            __builtin_amdgcn_fence(__ATOMIC_ACQUIRE, "agent");
            asm volatile("s_waitcnt vmcnt(0)" ::: "memory");
        }
    }
    __syncthreads();
}

template <int LAYER>
__device__ __forceinline__ void mega_layer(const Args& args, unsigned char* lds_raw, cg::grid_group& grid, const XcdBarrier& xbar) {
    LAS unsigned char* lds = (LAS unsigned char*)lds_raw;
    run_phase<PH_P0>(args, LAYER, lds_raw); if (LAYER == 0) grid.sync(); else xcd_barrier(xbar);
    run_phase<PH_A2>(args, LAYER, lds_raw); xcd_barrier(xbar);
    run_phase<PH_B>(args, LAYER, lds_raw);
    { const Ctx c = make_ctx(args, LAYER); ml::ml1_phase(c, lds); }
    xcd_barrier(xbar);
    { const Ctx c = make_ctx(args, LAYER); mla_attn_phase(c, lds); }
    { const Ctx c = make_ctx(args, LAYER); cmp_attn_phase(c, lds); }
    { const Ctx c = make_ctx(args, LAYER); ml::ml2_phase(c); }
    xcd_barrier(xbar);
    { const Ctx c = make_ctx(args, LAYER); nsa_attn_phase(c, lds); }
    { const Ctx c = make_ctx(args, LAYER); ml::ml3_phase(c, lds); }
    xcd_barrier(xbar);
    run_phase<PH_E>(args, LAYER, lds_raw); xcd_barrier(xbar);
    run_phase<PH_F>(args, LAYER, lds_raw); xcd_barrier(xbar);
    run_phase<PH_F2>(args, LAYER, lds_raw); xcd_barrier(xbar);
    run_phase<PH_G>(args, LAYER, lds_raw); xcd_barrier(xbar);
    run_phase<PH_H>(args, LAYER, lds_raw); xcd_barrier(xbar);
    run_phase<PH_H2>(args, LAYER, lds_raw);
    if (LAYER == 0) xcd_barrier(xbar);
}
__global__ void __launch_bounds__(512, 2) mega_fwd(Args args) {
    extern __shared__ __attribute__((aligned(16))) unsigned char lds_raw[];
    cg::grid_group grid = cg::this_grid();
    volatile LAS unsigned* st = (volatile LAS unsigned*)((LAS unsigned char*)lds_raw + (LDS_BYTES - 64));
    if (threadIdx.x < 2) st[threadIdx.x] = 0u;
    __syncthreads();
    const XcdBarrier xbar = xcd_barrier_post((unsigned*)args.ws, st);
    mega_layer<0>(args, lds_raw, grid, xbar);
    mega_layer<1>(args, lds_raw, grid, xbar);
}

__global__ void __launch_bounds__(256) k_compress(Args args, int layer) {
    __shared__ float hbuf[2 * 128];
    const Ctx c = make_ctx(args, layer);
    const int tid = threadIdx.x;
    for (int it = blockIdx.x; it < 2040; it += gridDim.x) {
        const int r = it * 2 + (tid >> 7), j = tid & 127;
        const int kv = r / 2040, rem = r % 2040, bg = rem / 255, n = rem % 255, b = bg >> 1, gg = bg & 1;
        const bf16* xr = c.BKV + ((size_t)(((kv * NB + b) * 2 + gg) * SEQ + 16 * n)) * 64;
        const float* w1 = c.cmp_w1 + (size_t)kv * 2048 * 128 + j; const float* ps = c.cmp_pos + kv * 2048;
        float acc = 0.f;
#pragma unroll 8
        for (int k = 0; k < 2048; ++k) acc += (bf2f(xr[k]) + ps[k]) * w1[(size_t)k * 128];
        __syncthreads();
        hbuf[(tid >> 7) * 128 + j] = siluf_(acc);
        __syncthreads();
        if (tid < 128) {
            const int rr = tid >> 6, d = tid & 63; const int r2 = it * 2 + rr;
            const int kv2 = r2 / 2040, rem2 = r2 % 2040, bg2 = rem2 / 255, n2 = rem2 % 255;
            const float* w2 = c.cmp_w2 + (size_t)kv2 * 128 * 64 + d; float o = 0.f;
#pragma unroll 8
            for (int jj = 0; jj < 128; ++jj) o += hbuf[rr * 128 + jj] * w2[jj * 64];
            c.KCMP[((size_t)((kv2 * 8 + bg2) * 256 + n2)) * 64 + d] = o;
            c.KCB[((size_t)((kv2 * 8 + bg2) * 256 + n2)) * 64 + d] = (bf16)f2bf(o);
            if (n2 == 254) c.KCB[((size_t)((kv2 * 8 + bg2) * 256 + 255)) * 64 + d] = 0;
        }
    }
}
__global__ void __launch_bounds__(256) k_mla_naive(Args args, int layer) {
    __shared__ float qsh[4][4 * 96];
    const Ctx c = make_ctx(args, layer);
    const int tid = threadIdx.x, lane = tid & 63, wave = tid >> 6;
    float* qs = qsh[wave];
    const int NGW = gridDim.x * 4, gw = blockIdx.x * 4 + wave;
    for (int task0 = gw; task0 < 32768; task0 += NGW) {
        const int bh = task0 & 31, tq0 = task0 >> 5, tq = (bh & 1) ? 1023 - tq0 : tq0;
        const int b = bh >> 3, h = bh & 7, s0 = tq * 4; const size_t t0 = (size_t)b * SEQ + s0;
        for (int e = lane; e < 4 * 96; e += 64) qs[e] = bf2f(c.QM[(t0 + e / 96) * 768 + h * 96 + (e % 96)]);
        float m[4], l[4], o[4];
#pragma unroll
        for (int r = 0; r < 4; ++r) { m[r] = -INFINITY; l[r] = 0.f; o[r] = 0.f; }
        const bf16* Kh = c.KN + (size_t)(b * 8 + h) * SEQ * 64; const bf16* Vh = c.VM + (size_t)(b * 8 + h) * SEQ * 64; const bf16* Krh = c.KR + (size_t)b * SEQ * 32;
        const int nkb = (s0 + 3) / 64 + 1;
        for (int kb = 0; kb < nkb; ++kb) {
            const int key = kb * 64 + lane; bool valid[4];
#pragma unroll
            for (int r = 0; r < 4; ++r) valid[r] = key <= s0 + r;
            nattn_block<4, true>(qs, Kh + (size_t)kb * 64 * 64, 64, Krh + (size_t)kb * 64 * 32, 32, Vh + (size_t)kb * 64 * 64, 64, valid, m, l, o, lane);
        }
#pragma unroll
        for (int r = 0; r < 4; ++r) c.QM[(t0 + r) * 768 + h * 96 + lane] = (bf16)f2bf(o[r] / l[r]);
    }
}
__global__ void __launch_bounds__(256) k_cmp_naive(Args args, int layer) {
    __shared__ float qsh[4][256 + 256];
    const Ctx c = make_ctx(args, layer);
    const int tid = threadIdx.x, lane = tid & 63, wave = tid >> 6;
    float* qs = qsh[wave]; float* psb = qs + 256;
    const int NGW = gridDim.x * 4, gw = blockIdx.x * 4 + wave;
    for (int task = gw; task < 32768; task += NGW) {
        const int bg = task >> 12, s = task & 4095, b = bg >> 1, gg = bg & 1; const size_t t = (size_t)b * SEQ + s;
        for (int e = lane; e < 256; e += 64) qs[e] = bf2f(c.BQ[t * 512 + gg * 256 + e]);
        const float* Kc = c.KCMP + (size_t)(0 * 8 + bg) * 256 * 64; const float* Vc = c.KCMP + (size_t)(1 * 8 + bg) * 256 * 64;
        float sc[4][4]; float mx[4] = {-INFINITY, -INFINITY, -INFINITY, -INFINITY};
#pragma unroll
        for (int kb = 0; kb < 4; ++kb) {
            const int n = kb * 64 + lane; const bool valid = (n < 255) && (16 * n + 31 <= s);
            const float* kr = Kc + (size_t)n * 64; float a[4] = {0.f, 0.f, 0.f, 0.f};
            for (int d0 = 0; d0 < 64; d0 += 4) {
                const f32x4 kd = *(const f32x4*)(kr + d0);
#pragma unroll
                for (int e = 0; e < 4; ++e)
#pragma unroll
                    for (int h = 0; h < 4; ++h) a[h] += qs[h * 64 + d0 + e] * kd[e];
            }
#pragma unroll
            for (int h = 0; h < 4; ++h) { sc[kb][h] = valid ? a[h] : -INFINITY; mx[h] = fmaxf(mx[h], sc[kb][h]); }
        }
        float o[4] = {0.f, 0.f, 0.f, 0.f}; float psum[4] = {0.f, 0.f, 0.f, 0.f};
#pragma unroll
        for (int h = 0; h < 4; ++h) {
            const float mh = wave_max(mx[h]);
            float e[4]; float ls = 0.f;
#pragma unroll
            for (int kb = 0; kb < 4; ++kb) { e[kb] = (mh == -INFINITY || sc[kb][h] == -INFINITY) ? 0.f : exp2f(sc[kb][h] - mh); ls += e[kb]; }
            ls = wave_sum(ls); const float inv = ls > 0.f ? 1.0f / ls : 0.f;
#pragma unroll
            for (int kb = 0; kb < 4; ++kb) { sc[kb][h] = e[kb] * inv; psum[kb] += sc[kb][h]; }
        }
#pragma unroll
        for (int kb = 0; kb < 4; ++kb) {
            for (int key = 0; key < 64; ++key) {
                const int n = kb * 64 + key; if (16 * n + 31 > s) break;
                const float vv = Vc[(size_t)n * 64 + lane];
#pragma unroll
                for (int h = 0; h < 4; ++h) o[h] += rdlane(sc[kb][h], key) * vv;
            }
        }
#pragma unroll
        for (int kb = 0; kb < 4; ++kb) psb[kb * 64 + lane] = psum[kb];
        __builtin_amdgcn_wave_barrier();
        float imp = 0.f;
#pragma unroll
        for (int q = -1; q < 4; ++q) { const int n = 4 * lane + q; if (n >= 0 && n < 255) imp += psb[n]; }
        const int cur = s >> 6;
        const bool vj = lane <= cur; const bool forced = (lane == 0) || (lane == cur) || (lane == cur - 1);
        const float score = vj ? imp + (forced ? 1e4f : 0.f) : -1.0f;
        int cnt = 0;
        for (int i2 = 0; i2 < 64; ++i2) { const float si = rdlane(score, i2); cnt += ((si > score) || (si == score && i2 < lane)) ? 1 : 0; }
        const bool selb = (cnt < 16) && (score > -0.5f);
        const unsigned long long mask = __ballot(selb);
        if (lane == 0) c.SEL[t * 2 + gg] = mask;
#pragma unroll
        for (int h = 0; h < 4; ++h) c.P1[t * 512 + (gg * 4 + h) * 64 + lane] = (bf16)f2bf(c.SM[t * 32 + 8 + (gg * 4 + h) * 3 + 0] * o[h]);
        __builtin_amdgcn_wave_barrier();
    }
}
__global__ void __launch_bounds__(256) k_selwin_naive(Args args, int layer) {
    __shared__ float qsh[4][256];
    const Ctx c = make_ctx(args, layer);
    const int tid = threadIdx.x, lane = tid & 63, wave = tid >> 6;
    float* qs = qsh[wave];
    const int NGW = gridDim.x * 4, gw = blockIdx.x * 4 + wave;
    for (int task = gw; task < 32768; task += NGW) {
        const int bg = task & 7, s = task >> 3, b = bg >> 1, gg = bg & 1; const size_t t = (size_t)b * SEQ + s;
        for (int e = lane; e < 256; e += 64) qs[e] = bf2f(c.BQ[t * 512 + gg * 256 + e]);
        const unsigned long long mk = c.SEL[t * 2 + gg];
        const unsigned mlo = __builtin_amdgcn_readfirstlane((unsigned)mk), mhi = __builtin_amdgcn_readfirstlane((unsigned)(mk >> 32));
        const bf16* Ks = c.BKV + (size_t)((2 * NB + b) * 2 + gg) * SEQ * 64; const bf16* Vs = c.BKV + (size_t)((3 * NB + b) * 2 + gg) * SEQ * 64;
        const bf16* Kw = c.BKV + (size_t)((4 * NB + b) * 2 + gg) * SEQ * 64; const bf16* Vw = c.BKV + (size_t)((5 * NB + b) * 2 + gg) * SEQ * 64;
        float m[4], l[4], o[4], osel[4];
#pragma unroll
        for (int r = 0; r < 4; ++r) { m[r] = -INFINITY; l[r] = 0.f; o[r] = 0.f; }
        for (int j = 0; j < 64; ++j) {
            const unsigned bit = j < 32 ? (mlo >> j) & 1u : (mhi >> (j - 32)) & 1u;
            if (!bit) continue;
            const bool vk = (j * 64 + lane) <= s; bool valid[4] = {vk, vk, vk, vk};
            nattn_block<4, false>(qs, Ks + (size_t)j * 64 * 64, 64, nullptr, 0, Vs + (size_t)j * 64 * 64, 64, valid, m, l, o, lane);
        }
#pragma unroll
        for (int r = 0; r < 4; ++r) { osel[r] = l[r] > 0.f ? o[r] / l[r] : 0.f; m[r] = -INFINITY; l[r] = 0.f; o[r] = 0.f; }
        const int jb0 = (s >= 511 ? s - 511 : 0) >> 6, jb1 = s >> 6;
        for (int j = jb0; j <= jb1; ++j) {
            const int key = j * 64 + lane; const bool vk = (key <= s) && (s - key < 512); bool valid[4] = {vk, vk, vk, vk};
            nattn_block<4, false>(qs, Kw + (size_t)j * 64 * 64, 64, nullptr, 0, Vw + (size_t)j * 64 * 64, 64, valid, m, l, o, lane);
        }
#pragma unroll
        for (int r = 0; r < 4; ++r) {
            const int hh = gg * 4 + r; const float ow = l[r] > 0.f ? o[r] / l[r] : 0.f;
            const float y = bf2f(c.P1[t * 512 + hh * 64 + lane]) + c.SM[t * 32 + 8 + hh * 3 + 1] * osel[r] + c.SM[t * 32 + 8 + hh * 3 + 2] * ow;
            c.BQ[t * 512 + hh * 64 + lane] = (bf16)f2bf(y);
        }
        __builtin_amdgcn_wave_barrier();
    }
}
__global__ void __launch_bounds__(128) k_mlstm_naive(Args args, int layer) {
    __shared__ float qk[128]; __shared__ float red[2];
    const Ctx c = make_ctx(args, layer);
    const int tid = threadIdx.x, lane = tid & 63, wave = tid >> 6;
    const int b = blockIdx.x >> 2, h = blockIdx.x & 3;
    float C[64], nv[64];
#pragma unroll
    for (int d = 0; d < 64; ++d) { C[d] = 0.f; nv[d] = 0.f; }
    float mstate = 0.f;
    const int ch = tid < 64 ? h * 64 + tid : 256 + h * 64 + (tid - 64);
    float cw[4];
#pragma unroll
    for (int kk = 0; kk < 4; ++kk) cw[kk] = c.m_conv[kk * 512 + ch];
    const float hn = c.m_hnorm[h * 128 + tid];
    for (int s = 0; s < SEQ; ++s) {
        const size_t t = (size_t)b * SEQ + s;
        {
            float a = 0.f;
#pragma unroll
            for (int kk = 0; kk < 4; ++kk) { const int sp = s - 3 + kk; if (sp >= 0) a += cw[kk] * bf2f(c.AQK[((size_t)b * SEQ + sp) * 512 + ch]); }
            float y = siluf_(a); if (tid < 64) y *= 0.125f;
            qk[tid] = y;
        }
        __syncthreads();
        const float li = c.SM[t * 32 + h], lf = c.SM[t * 32 + 4 + h];
        const float mn = fmaxf(lf + mstate, li); const float fp = expf(lf + mstate - mn), ip = expf(li - mn); mstate = mn;
        const float v = bf2f(c.AV[t * 512 + h * 128 + tid]); const float iv = ip * v;
        float num = 0.f, den = 0.f;
#pragma unroll
        for (int d = 0; d < 64; ++d) { const float kd = qk[64 + d], qd = qk[d]; C[d] = fp * C[d] + iv * kd; nv[d] = fp * nv[d] + ip * kd; num += C[d] * qd; den += nv[d] * qd; }
        const float hv = num / fmaxf(fabsf(den), expf(-mn));
        const float ss = wave_sum(hv * hv); if (lane == 0) red[wave] = ss;
        __syncthreads();
        const float rstd = rsqrtf((red[0] + red[1]) * (1.0f / 128.0f) + EPS);
        const float y = hv * rstd * hn * bf2f(c.AO[t * 512 + h * 128 + tid]);
        c.AV[t * 512 + h * 128 + tid] = (bf16)f2bf(y);
    }
}

extern "C" void kernel_launch(void* const* d_in, const int* in_sizes, int n_in, void* d_out, int out_size, void* d_ws, size_t ws_size, hipStream_t stream) {
    static int grid = 0;
    if (grid == 0) {
        if (n_in != 19 || out_size != T * DM || ws_size < WS_END) { fprintf(stderr, "kernel_launch: unexpected problem: n_in %d out %d ws %zu\n", n_in, out_size, ws_size); grid = -1; return; }
        int dev = 0, cus = 0;
        (void)hipGetDevice(&dev); (void)hipDeviceGetAttribute(&cus, hipDeviceAttributeMultiprocessorCount, dev);
        bool ok = true;
#define SETLDS(k) ok = ok && (hipFuncSetAttribute((const void*)k, hipFuncAttributeMaxDynamicSharedMemorySize, LDS_BYTES) == hipSuccess)
        SETLDS(k_phase<PH_P0>); SETLDS(k_phase<PH_A2>); SETLDS(k_phase<PH_B>); SETLDS(k_phase<PH_E>); SETLDS(k_phase<PH_F>); SETLDS(k_phase<PH_F2>); SETLDS(k_phase<PH_G>); SETLDS(k_phase<PH_H>); SETLDS(k_phase<PH_H2>); SETLDS(k_attn<0>); SETLDS(k_attn<1>); SETLDS(k_attn<2>); SETLDS(k_ml<0>); SETLDS(k_ml<1>); SETLDS(k_ml<2>); SETLDS(mega_fwd);
        { int per_cu = 0; (void)hipOccupancyMaxActiveBlocksPerMultiprocessor(&per_cu, (const void*)mega_fwd, 512, LDS_BYTES); (void)hipGetLastError(); if (per_cu < 1) { fprintf(stderr, "kernel_launch: occupancy query reports %d workgroups per CU\n", per_cu); grid = -1; return; } }
        if (!ok) { fprintf(stderr, "kernel_launch: hipFuncSetAttribute failed\n"); grid = -1; return; }
        grid = cus;
        if (grid != 256) { fprintf(stderr, "kernel_launch: built for 256 CUs, found %d\n", grid); grid = -1; return; }
    }
    if (grid < 0) return;
    Args a{};
    for (int i = 0; i < 19; ++i) a.in[i] = d_in[i];
    a.out = (float*)d_out; a.ws = (unsigned char*)d_ws;
#ifdef MK_MULTI
    for (int layer = 0; layer < 2; ++layer) {
        hipLaunchKernelGGL(k_phase<PH_P0>, dim3(grid), dim3(512), LDS_BYTES, stream, a, layer);
        hipLaunchKernelGGL(k_phase<PH_A2>, dim3(grid), dim3(512), LDS_BYTES, stream, a, layer);
        hipLaunchKernelGGL(k_phase<PH_B>, dim3(grid), dim3(512), LDS_BYTES, stream, a, layer);
        hipLaunchKernelGGL(k_attn<0>, dim3(grid), dim3(512), LDS_BYTES, stream, a, layer);
        hipLaunchKernelGGL(k_attn<2>, dim3(grid), dim3(512), LDS_BYTES, stream, a, layer);
        hipLaunchKernelGGL(k_attn<1>, dim3(grid), dim3(512), LDS_BYTES, stream, a, layer);
        hipLaunchKernelGGL(k_ml<0>, dim3(grid), dim3(512), LDS_BYTES, stream, a, layer);
        hipLaunchKernelGGL(k_ml<1>, dim3(grid), dim3(512), LDS_BYTES, stream, a, layer);
        hipLaunchKernelGGL(k_ml<2>, dim3(grid), dim3(512), LDS_BYTES, stream, a, layer);
        hipLaunchKernelGGL(k_phase<PH_E>, dim3(grid), dim3(512), LDS_BYTES, stream, a, layer);
        hipLaunchKernelGGL(k_phase<PH_F>, dim3(grid), dim3(512), LDS_BYTES, stream, a, layer);
        hipLaunchKernelGGL(k_phase<PH_F2>, dim3(grid), dim3(512), LDS_BYTES, stream, a, layer);
        hipLaunchKernelGGL(k_phase<PH_G>, dim3(grid), dim3(512), LDS_BYTES, stream, a, layer);
        hipLaunchKernelGGL(k_phase<PH_H>, dim3(grid), dim3(512), LDS_BYTES, stream, a, layer);
        hipLaunchKernelGGL(k_phase<PH_H2>, dim3(grid), dim3(512), LDS_BYTES, stream, a, layer);
    }
#else
    if (hipMemsetAsync(d_ws, 0, 16384, stream) != hipSuccess) { fprintf(stderr, "kernel_launch: memset of the barrier words failed\n"); return; }
    void* params[] = {&a};
    hipError_t e = hipLaunchCooperativeKernel((const void*)mega_fwd, dim3(grid), dim3(512), params, LDS_BYTES, stream);
    if (e != hipSuccess) fprintf(stderr, "kernel_launch: cooperative launch failed: %s (grid %d)\n", hipGetErrorString(e), grid);
#endif
}
```

```cpp
#include <hip/hip_runtime.h>
#include <hip/hip_cooperative_groups.h>
#include <cstdio>
#include <cstdint>
namespace cg = cooperative_groups;

#define LAS __attribute__((address_space(3)))
typedef unsigned short bf16;
typedef short bf16x8 __attribute__((ext_vector_type(8)));
typedef float f32x4 __attribute__((ext_vector_type(4)));
typedef unsigned u32x4 __attribute__((ext_vector_type(4)));
typedef unsigned u32x2 __attribute__((ext_vector_type(2)));

constexpr int NB = 4, SEQ = 4096, T = NB * SEQ, DM = 1024, DIN = 6592, DFF = 2816;
constexpr float EPS = 1e-6f;
constexpr float LOG2E = 1.4426950408889634f;
constexpr float QSCALE_NSA = 0.125f * LOG2E;
constexpr float QSCALE_MLA = 0.10206207261596577f * LOG2E;
constexpr int NZ = 3584;

constexpr size_t MiB = 1u << 20;
constexpr size_t WS_ROPE = 1 * MiB, WS_SM = 3 * MiB, WS_SSQ = 5 * MiB, WS_SEL = 7 * MiB, WS_KCMP = 7 * MiB + 256 * 1024, WS_KCB = 8 * MiB + 256 * 1024;
constexpr size_t WS_WIN = 9 * MiB, WS_WG = 16 * MiB, WS_WUQ = 22 * MiB, WS_WUKV = 22 * MiB + 640 * 1024, WS_WBR = 23 * MiB + 256 * 1024, WS_WOUT = 26 * MiB + 256 * 1024;
constexpr size_t WS_WC1 = 28 * MiB + 256 * 1024, WS_B1 = 6 * MiB + 512 * 1024;
constexpr size_t WS_XB = 31 * MiB, WS_AV = 63 * MiB, WS_AO = 79 * MiB, WS_BQ = 95 * MiB, WS_BKV = 111 * MiB, WS_AQK = 135 * MiB, WS_CQKV = 151 * MiB;
constexpr size_t WS_QM = 171 * MiB, WS_KN = 195 * MiB, WS_VM = 211 * MiB, WS_KR = 227 * MiB, WS_CL = 228 * MiB, WS_NL = 244 * MiB, WS_MSC = 244 * MiB + 512 * 1024;
constexpr size_t WS_P1 = 151 * MiB, WS_GT = 111 * MiB, WS_MERGED = 195 * MiB, WS_WGU = 63 * MiB, WS_WDN = 74 * MiB, WS_MIX = 95 * MiB, WS_U = 95 * MiB, WS_FD = 183 * MiB;
constexpr size_t WS_END = 247 * MiB;

constexpr int LDS_BYTES = 147456;

__device__ __forceinline__ unsigned f2bf(float f) { unsigned u = __builtin_bit_cast(unsigned, f); return (u + 0x7fffu + ((u >> 16) & 1u)) >> 16; }
typedef float f32x2_t __attribute__((ext_vector_type(2))); typedef __bf16 bf16x2_t __attribute__((ext_vector_type(2)));
__device__ __forceinline__ unsigned pk2(float lo, float hi) { const f32x2_t v = {lo, hi}; const bf16x2_t b = __builtin_convertvector(v, bf16x2_t); return __builtin_bit_cast(unsigned, b); }
__device__ __forceinline__ float ex2(float x) { return __builtin_amdgcn_exp2f(x); }
__device__ __forceinline__ float bf2f(unsigned short u) { return __builtin_bit_cast(float, (unsigned)u << 16); }
__device__ __forceinline__ float bflo(unsigned w) { return __builtin_bit_cast(float, w << 16); }
__device__ __forceinline__ float bfhi(unsigned w) { return __builtin_bit_cast(float, w & 0xffff0000u); }
__device__ __forceinline__ float wave_sum(float v) {
#pragma unroll
    for (int o = 1; o < 64; o <<= 1) v += __shfl_xor(v, o);
    return v;
}
__device__ __forceinline__ float wave_max(float v) {
#pragma unroll
    for (int o = 1; o < 64; o <<= 1) v = fmaxf(v, __shfl_xor(v, o));
    return v;
}
__device__ __forceinline__ float sigmoidf_(float x) { return __builtin_amdgcn_rcpf(1.0f + ex2(-LOG2E * x)); }
__device__ __forceinline__ float siluf_(float x) { return x * __builtin_amdgcn_rcpf(1.0f + ex2(-LOG2E * x)); }
__device__ __forceinline__ float logsigmoidf_(float x) { return x >= 0.f ? -log1pf(expf(-x)) : x - log1pf(expf(x)); }
__device__ __forceinline__ float rdlane(float v, int l) { return __builtin_bit_cast(float, __builtin_amdgcn_readlane(__builtin_bit_cast(int, v), l)); }

namespace pg8 {
constexpr int BM = 256, BK = 64, HALF = 128, HTB = HALF * BK * 2, STAGE_BYTES = 8 * HTB, NXCD = 8, WGM = 8;
__host__ __device__ __forceinline__ int lds_byte(int r, int c) { const int st = (r >> 4) * 2 + (c >> 5), rr = r & 15, cc = c & 31, ob = rr * 64 + cc * 2; return st * 1024 + (ob ^ (((ob >> 9) & 1) << 5)); }
__host__ __device__ __forceinline__ void stage_rc(int b, int& R, int& C) { const int st = b / 1024, sb = b % 1024, swz = sb ^ (((sb >> 9) & 1) << 5); R = (st >> 1) * 16 + swz / 64; C = (st & 1) * 32 + (swz % 64) / 2; }
__host__ __device__ __forceinline__ int perm32(int rho) { const int n = rho >> 4, i = rho & 15; return 8 * (i >> 2) + 4 * n + (i & 3); }

struct Unit { int pm, pn; };
struct Gemm { const bf16* A; const bf16* Bt; };

struct StaticOrder {
    int nM, nN, nwg, G, c;
    __host__ __device__ void init(int M, int N, int G_, int c_) { nM = M / BM; nN = N / BM; nwg = nM * nN; G = G_; c = c_; }
    __host__ __device__ bool next(int i, Unit& u) const {
        const long L = (long)i * G + c; if (L >= nwg) return false;
        int wgid = (int)L; { const int q = nwg / NXCD, r = nwg % NXCD, xcd = wgid % NXCD, off = wgid / NXCD; wgid = (xcd < r ? xcd * (q + 1) : r * (q + 1) + (xcd - r) * q) + off; }
        const int nig = WGM * nN, gid = wgid / nig, fm = gid * WGM, gsz = (nM - fm) < WGM ? (nM - fm) : WGM;
        u.pm = fm + ((wgid % nig) % gsz); u.pn = (wgid % nig) / gsz; return true;
    }
};

template <int GK, int LDA, int LDB, int KSTEPA, class Epi, class Sched>
__device__ __forceinline__ void gemm_phase(LAS unsigned char* lds, const Gemm g, const Sched& S, const Epi& E) {
    int tid_ = threadIdx.x; asm volatile("" : "+v"(tid_));
    const int tid = tid_, wid = __builtin_amdgcn_readfirstlane(tid >> 6), lane = tid & 63, wr = wid >> 2, wc = wid & 3, fr = lane & 15, fq = lane >> 4;
    constexpr int nt = GK / BK;
    unsigned voffA[2], voffB[2];
#pragma unroll
    for (int i = 0; i < 2; ++i) { int R, C; stage_rc(tid * 16 + i * 8192, R, C); const int Rb = Epi::PERM ? ((R & ~31) + perm32(R & 31)) : R;
        voffA[i] = (unsigned)(R * LDA + C) * 2u; voffB[i] = (unsigned)(Rb * LDB + C) * 2u; }
    constexpr size_t kstepA = (size_t)KSTEPA, kstepB = (size_t)(BK * 2);
    constexpr size_t hstepA = (size_t)HALF * LDA * 2, hstepB = (size_t)HALF * LDB * 2;
    constexpr size_t tstepA = 2 * hstepA, tstepB = 2 * hstepB;
    const unsigned ldsw = (unsigned)wid * 1024u;
    const int aoff = lds_byte(wr * 64 + fr, fq * 8), boff = lds_byte(wc * 32 + fr, fq * 8);
#define PG8_SA(b, h) (((b) * 2 + (h)) * HTB)
#define PG8_SB(b, h) ((4 + (b) * 2 + (h)) * HTB)
#define PG8_STAGE(bufoff, gbase, voff) do { _Pragma("unroll") for (int _i = 0; _i < 2; ++_i) \
        __builtin_amdgcn_global_load_lds((const unsigned*)((const char*)(gbase) + (voff)[_i]), (LAS unsigned*)(lds + (bufoff) + ldsw + _i * 8192), 16, 0, 0); } while (0)
#define PG8_LDA(dst, b, h) do { _Pragma("unroll") for (int m = 0; m < 4; ++m) _Pragma("unroll") for (int k = 0; k < 2; ++k) dst[m][k] = *(const LAS bf16x8*)(lds + PG8_SA(b, h) + aoff + m * 2048 + k * 1024); } while (0)
#define PG8_LDB(dst, b, h) do { _Pragma("unroll") for (int n = 0; n < 2; ++n) _Pragma("unroll") for (int k = 0; k < 2; ++k) dst[n][k] = *(const LAS bf16x8*)(lds + PG8_SB(b, h) + boff + n * 2048 + k * 1024); } while (0)
#define PG8_MMA(ai, bj, At, Bt) do { __builtin_amdgcn_s_setprio(1); _Pragma("unroll") for (int m = 0; m < 4; ++m) _Pragma("unroll") for (int n = 0; n < 2; ++n) _Pragma("unroll") for (int k = 0; k < 2; ++k) \
        acc[ai][bj][m][n] = __builtin_amdgcn_mfma_f32_16x16x32_bf16(Bt[n][k], At[m][k], acc[ai][bj][m][n], 0, 0, 0); __builtin_amdgcn_s_setprio(0); } while (0)
#define PG8_WAIT_V(n) asm volatile("s_waitcnt vmcnt(" #n ")" ::: "memory")
#define PG8_WAIT_L(n) asm volatile("s_waitcnt lgkmcnt(" #n ")" ::: "memory")
#define PG8_BAR __builtin_amdgcn_s_barrier()
#define PG8_SCHED __builtin_amdgcn_sched_barrier(0)
    Unit cur, nxt; int ui = 0;
    if (!S.next(0, cur)) return;
    f32x4 acc[2][2][4][2];
#pragma unroll
    for (int a = 0; a < 2; ++a)
#pragma unroll
        for (int b = 0; b < 2; ++b)
#pragma unroll
            for (int m = 0; m < 4; ++m)
#pragma unroll
                for (int n = 0; n < 2; ++n) acc[a][b][m][n] = (f32x4){0.f, 0.f, 0.f, 0.f};
    bf16x8 At[4][2], B0[2][2], B1[2][2];
    const char* cA = (const char*)g.A + (size_t)cur.pm * tstepA; const char* cB = (const char*)g.Bt + (size_t)cur.pn * tstepB;
    PG8_STAGE(PG8_SB(0, 0), cB, voffB); PG8_STAGE(PG8_SB(0, 1), cB + hstepB, voffB); PG8_STAGE(PG8_SA(0, 0), cA, voffA); PG8_STAGE(PG8_SA(0, 1), cA + hstepA, voffA);
    if (wr == 1) PG8_BAR;
    PG8_WAIT_V(2); PG8_BAR;
    PG8_STAGE(PG8_SB(1, 0), cB + kstepB, voffB); PG8_STAGE(PG8_SA(1, 0), cA + kstepA, voffA); PG8_STAGE(PG8_SB(1, 1), cB + hstepB + kstepB, voffB);
    PG8_WAIT_V(6); PG8_BAR;
    for (;;) {
        const bool has_next = S.next(ui + 1, nxt);
        const char* nA = has_next ? (const char*)g.A + (size_t)nxt.pm * tstepA : cA; const char* nB = has_next ? (const char*)g.Bt + (size_t)nxt.pn * tstepB : cB;
#pragma unroll 1
        for (int t = 0; t < nt; t += 2) {
            const bool last = (t == nt - 2);
            const char* a1 = cA + (size_t)(t + 1) * kstepA;
            const char* a2 = last ? nA : cA + (size_t)(t + 2) * kstepA; const char* b2 = last ? nB : cB + (size_t)(t + 2) * kstepB;
            const char* a3 = a2 + kstepA; const char* b3 = b2 + kstepB;
            PG8_LDB(B0, 0, 0); PG8_LDB(B1, 0, 1); PG8_SCHED; PG8_LDA(At, 0, 0); PG8_STAGE(PG8_SA(1, 1), a1 + hstepA, voffA);
            PG8_WAIT_V(8); PG8_WAIT_L(0); PG8_BAR; PG8_MMA(0, 0, At, B0); PG8_MMA(0, 1, At, B1); PG8_BAR; PG8_SCHED;
            PG8_LDA(At, 0, 1); PG8_STAGE(PG8_SB(0, 0), b2, voffB); PG8_STAGE(PG8_SB(0, 1), b2 + hstepB, voffB); PG8_STAGE(PG8_SA(0, 0), a2, voffA);
            PG8_WAIT_V(8); PG8_WAIT_L(0); PG8_BAR; PG8_MMA(1, 0, At, B0); PG8_MMA(1, 1, At, B1); PG8_BAR; PG8_SCHED;
            PG8_LDB(B0, 1, 0); PG8_LDB(B1, 1, 1); PG8_SCHED; PG8_LDA(At, 1, 0); PG8_STAGE(PG8_SA(0, 1), a2 + hstepA, voffA);
            PG8_WAIT_V(8); PG8_WAIT_L(0); PG8_BAR; PG8_MMA(0, 0, At, B0); PG8_MMA(0, 1, At, B1); PG8_BAR; PG8_SCHED;
            PG8_LDA(At, 1, 1); PG8_STAGE(PG8_SB(1, 0), b3, voffB); PG8_STAGE(PG8_SB(1, 1), b3 + hstepB, voffB); PG8_STAGE(PG8_SA(1, 0), a3, voffA);
            PG8_WAIT_V(8); PG8_WAIT_L(0); PG8_BAR; PG8_MMA(1, 0, At, B0); PG8_MMA(1, 1, At, B1); PG8_BAR; PG8_SCHED;
        }
        if (wr == 0) PG8_BAR;
        if constexpr (!Epi::AFTER_DRAIN) E(acc, cur, wr, wc, fr, fq);
        if (!has_next) break;
#pragma unroll
        for (int a = 0; a < 2; ++a)
#pragma unroll
            for (int b = 0; b < 2; ++b)
#pragma unroll
                for (int m = 0; m < 4; ++m)
#pragma unroll
                    for (int n = 0; n < 2; ++n) acc[a][b][m][n] = (f32x4){0.f, 0.f, 0.f, 0.f};
        cur = nxt; cA = nA; cB = nB; ++ui;
        if (wr == 1) PG8_BAR;
    }
    PG8_WAIT_V(0);
    PG8_BAR;
    if constexpr (Epi::AFTER_DRAIN) E.fused(acc, cur, wr, wc, fr, fq, lds, tid);
#undef PG8_SA
#undef PG8_SB
#undef PG8_STAGE
#undef PG8_LDA
#undef PG8_LDB
#undef PG8_MMA
#undef PG8_WAIT_V
#undef PG8_WAIT_L
#undef PG8_BAR
#undef PG8_SCHED
}
}
using pg8::Unit;
typedef const f32x4 (&AccRef)[2][2][4][2];

__device__ __forceinline__ u32x4 pack8(const f32x4 a, const f32x4 b) { u32x4 w; w.x = pk2(a[0], a[1]); w.y = pk2(a[2], a[3]); w.z = pk2(b[0], b[1]); w.w = pk2(b[2], b[3]); return w; }

struct EpiInProj {
    static constexpr bool PERM = true, AFTER_DRAIN = false;
    bf16 *AQK, *AV, *AO, *BQ, *BKV, *CQKV, *KR; float *SM, *SSQ; const float* ROPE; const float* gbias;
    __device__ __forceinline__ void operator()(AccRef acc, const Unit& u, int wr, int wc, int fr, int fq) const {
        const int pn = u.pn;
#pragma unroll
        for (int ai = 0; ai < 2; ++ai)
#pragma unroll
            for (int m = 0; m < 4; ++m) {
                const int row = u.pm * 256 + ai * 128 + wr * 64 + m * 16 + fr;
#pragma unroll
                for (int bj = 0; bj < 2; ++bj) {
                    f32x4 v0 = acc[ai][bj][m][0], v1 = acc[ai][bj][m][1];
                    const int cg = bj * 128 + wc * 32;
                    const int c0 = cg + 8 * fq;
                    if (pn < 8) {
                        const int region = pn >> 1; const int col = (pn & 1) * 256 + c0;
                        bf16* base = region == 0 ? AQK : region == 1 ? AV : region == 2 ? AO : BQ;
                        if (region == 2) {
#pragma unroll
                            for (int e = 0; e < 4; ++e) { v0[e] = sigmoidf_(v0[e]); v1[e] = sigmoidf_(v1[e]); }
                        }
                        *(u32x4*)(base + (size_t)row * 512 + col) = pack8(v0, v1);
                    } else if (pn < 11) {
                        const int cc = (pn - 8) * 256 + c0; const int i = cc >> 7, gg = (cc >> 6) & 1, d = cc & 63; const int b = row >> 12, s = row & 4095;
                        *(u32x4*)(BKV + ((size_t)(((i * NB + b) * 2 + gg) * SEQ + s)) * 64 + d) = pack8(v0, v1);
                    } else {
                        const int gb = (pn - 11) * 256 + cg;
                        if (gb < 640) {
                            *(u32x4*)(CQKV + (size_t)row * 640 + gb + 8 * fq) = pack8(v0, v1);
                            float ss = 0.f;
#pragma unroll
                            for (int e = 0; e < 4; ++e) ss += v0[e] * v0[e] + v1[e] * v1[e];
                            ss += __shfl_xor(ss, 16); ss += __shfl_xor(ss, 32);
                            if (fq == 0) SSQ[(size_t)row * 24 + (gb >> 5)] = ss;
                        } else if (gb == 640) {
                            float o[8];
#pragma unroll
                            for (int e = 0; e < 8; ++e) {
                                const float v = e < 4 ? v0[e] : v1[e - 4]; const float p = __shfl_xor(v, 32);
                                const int i = (8 * fq + e) & 15; const float cs = ROPE[((size_t)row * 16 + i) * 2], sn = ROPE[((size_t)row * 16 + i) * 2 + 1];
                                o[e] = fq < 2 ? v * cs - p * sn : p * sn + v * cs;
                            }
                            u32x4 w; w.x = pk2(o[0], o[1]); w.y = pk2(o[2], o[3]); w.z = pk2(o[4], o[5]); w.w = pk2(o[6], o[7]);
                            *(u32x4*)(KR + (size_t)row * 32 + 8 * fq) = w;
                        } else if (gb == 672) {
                            float o[8];
#pragma unroll
                            for (int e = 0; e < 8; ++e) {
                                const float v = e < 4 ? v0[e] : v1[e - 4];
                                if (fq == 0) { const float x = v + gbias[e]; o[e] = e < 4 ? x : logsigmoidf_(x); }
                                else o[e] = sigmoidf_(v);
                            }
                            float* dst = SM + (size_t)row * 32 + 8 * fq;
                            *(f32x4*)dst = (f32x4){o[0], o[1], o[2], o[3]}; *(f32x4*)(dst + 4) = (f32x4){o[4], o[5], o[6], o[7]};
                        }
                    }
                }
                asm volatile("" ::: "memory");
            }
    }
};

struct EpiMlaQ {
    static constexpr bool PERM = true, AFTER_DRAIN = false;
    bf16* QM; const float* SSQ; const float* ROPE;
    __device__ __forceinline__ void operator()(AccRef acc, const Unit& u, int wr, int wc, int fr, int fq) const {
#pragma unroll
        for (int ai = 0; ai < 2; ++ai)
#pragma unroll
            for (int m = 0; m < 4; ++m) {
                const int row = u.pm * 256 + ai * 128 + wr * 64 + m * 16 + fr;
                const f32x4* sp = (const f32x4*)(SSQ + (size_t)row * 24);
                const f32x4 s0 = sp[0], s1 = sp[1], s2 = sp[2];
                const float ss = (s0[0] + s0[1] + s0[2] + s0[3]) + (s1[0] + s1[1] + s1[2] + s1[3]) + (s2[0] + s2[1] + s2[2] + s2[3]);
                const float rstd = rsqrtf(ss * (1.0f / 384.0f) + EPS);
#pragma unroll
                for (int bj = 0; bj < 2; ++bj) {
                    const int cgi = u.pn * 8 + bj * 4 + wc;
                    f32x4 v0 = acc[ai][bj][m][0] * rstd, v1 = acc[ai][bj][m][1] * rstd;
                    if (cgi % 3 == 2) {
                        float o[8];
#pragma unroll
                        for (int e = 0; e < 8; ++e) {
                            const float v = e < 4 ? v0[e] : v1[e - 4]; const float p = __shfl_xor(v, 32);
                            const int i = (8 * fq + e) & 15; const float cs = ROPE[((size_t)row * 16 + i) * 2], sn = ROPE[((size_t)row * 16 + i) * 2 + 1];
                            o[e] = fq < 2 ? v * cs - p * sn : p * sn + v * cs;
                        }
                        v0 = (f32x4){o[0], o[1], o[2], o[3]}; v1 = (f32x4){o[4], o[5], o[6], o[7]};
                    }
                    *(u32x4*)(QM + (size_t)row * 768 + cgi * 32 + 8 * fq) = pack8(v0, v1);
                }
                asm volatile("" ::: "memory");
            }
    }
};
struct EpiMlaKV {
    static constexpr bool PERM = true, AFTER_DRAIN = false;
    bf16 *KN, *VM; const float* SSQ;
    __device__ __forceinline__ void operator()(AccRef acc, const Unit& u, int wr, int wc, int fr, int fq) const {
#pragma unroll
        for (int ai = 0; ai < 2; ++ai)
#pragma unroll
            for (int m = 0; m < 4; ++m) {
                const int row = u.pm * 256 + ai * 128 + wr * 64 + m * 16 + fr;
                const f32x4* sp = (const f32x4*)(SSQ + (size_t)row * 24 + 12);
                const f32x4 s0 = sp[0], s1 = sp[1];
                const float ss = (s0[0] + s0[1] + s0[2] + s0[3]) + (s1[0] + s1[1] + s1[2] + s1[3]);
                const float rstd = rsqrtf(ss * (1.0f / 256.0f) + EPS);
                const int b = row >> 12, s = row & 4095;
#pragma unroll
                for (int bj = 0; bj < 2; ++bj) {
                    const int h = u.pn * 2 + bj; const int j = wc * 32 + 8 * fq;
                    const f32x4 v0 = acc[ai][bj][m][0] * rstd, v1 = acc[ai][bj][m][1] * rstd;
                    bf16* dst = (j < 64 ? KN : VM) + ((size_t)((b * 8 + h) * SEQ + s)) * 64 + (j & 63);
                    *(u32x4*)dst = pack8(v0, v1);
                }
                asm volatile("" ::: "memory");
            }
    }
};
struct EpiGate {
    static constexpr bool PERM = true, AFTER_DRAIN = false;
    bf16* GT;
    __device__ __forceinline__ void operator()(AccRef acc, const Unit& u, int wr, int wc, int fr, int fq) const {
        int tid = threadIdx.x; asm volatile("" : "+v"(tid));
#pragma unroll
        for (int ai = 0; ai < 2; ++ai)
#pragma unroll
            for (int bj = 0; bj < 2; ++bj)
#pragma unroll
                for (int m = 0; m < 4; ++m) {
                    f32x4 v0 = acc[ai][bj][m][0], v1 = acc[ai][bj][m][1];
#pragma unroll
                    for (int e = 0; e < 4; ++e) { v0[e] = sigmoidf_(v0[e]); v1[e] = sigmoidf_(v1[e]); }
                    const int q = (ai * 2 + bj) * 4 + m;
                    *(u32x4*)(GT + ((size_t)q * 512 + tid) * 8) = pack8(v0, v1);
                    asm volatile("" ::: "memory");
                }
    }
};
struct EpiBranch {
    static constexpr bool PERM = true, AFTER_DRAIN = false;
    const bf16* GT; bf16* MG; int first;
    __device__ __forceinline__ void operator()(AccRef acc, const Unit& u, int wr, int wc, int fr, int fq) const {
        int tid = threadIdx.x; asm volatile("" : "+v"(tid));
#pragma unroll
        for (int ai = 0; ai < 2; ++ai)
#pragma unroll
            for (int m = 0; m < 4; ++m) {
                const int row = u.pm * 256 + ai * 128 + wr * 64 + m * 16 + fr;
#pragma unroll
                for (int bj = 0; bj < 2; ++bj) {
                    const int col = u.pn * 256 + bj * 128 + wc * 32 + 8 * fq;
                    const int q = (ai * 2 + bj) * 4 + m;
                    const u32x4 gw = *(const u32x4*)(GT + ((size_t)q * 512 + tid) * 8);
                    f32x4 v0 = acc[ai][bj][m][0], v1 = acc[ai][bj][m][1];
                    v0[0] *= bflo(gw.x); v0[1] *= bfhi(gw.x); v0[2] *= bflo(gw.y); v0[3] *= bfhi(gw.y);
                    v1[0] *= bflo(gw.z); v1[1] *= bfhi(gw.z); v1[2] *= bflo(gw.w); v1[3] *= bfhi(gw.w);
                    bf16* dst = MG + (size_t)row * 1024 + col;
                    if (!first) {
                        const u32x4 ow = *(const u32x4*)dst;
                        v0[0] += bflo(ow.x); v0[1] += bfhi(ow.x); v0[2] += bflo(ow.y); v0[3] += bfhi(ow.y);
                        v1[0] += bflo(ow.z); v1[1] += bfhi(ow.z); v1[2] += bflo(ow.w); v1[3] += bfhi(ow.w);
                    }
                    *(u32x4*)dst = pack8(v0, v1);
                }
                asm volatile("" ::: "memory");
            }
    }
};
struct EpiF32 {
    static constexpr bool PERM = false, AFTER_DRAIN = false;
    float* C; int ldc;
    __device__ __forceinline__ void operator()(AccRef acc, const Unit& u, int wr, int wc, int fr, int fq) const {
        const int row0 = u.pm * 256 + wr * 64 + fr, col0 = u.pn * 256 + wc * 32 + 4 * fq;
#pragma unroll
        for (int ai = 0; ai < 2; ++ai)
#pragma unroll
            for (int m = 0; m < 4; ++m) { float* rowp = C + (size_t)(row0 + ai * 128 + m * 16) * ldc + col0;
#pragma unroll
                for (int bj = 0; bj < 2; ++bj)
#pragma unroll
                    for (int n = 0; n < 2; ++n) *(f32x4*)(rowp + bj * 128 + n * 16) = acc[ai][bj][m][n]; }
    }
};
struct EpiSwiGLU {
    static constexpr bool PERM = true, AFTER_DRAIN = false;
    bf16* U;
    __device__ __forceinline__ void operator()(AccRef acc, const Unit& u, int wr, int wc, int fr, int fq) const {
#pragma unroll
        for (int ai = 0; ai < 2; ++ai)
#pragma unroll
            for (int m = 0; m < 4; ++m) {
                const int row = u.pm * 256 + ai * 128 + wr * 64 + m * 16 + fr;
                f32x4 g0 = acc[ai][0][m][0], g1 = acc[ai][0][m][1]; const f32x4 u0 = acc[ai][1][m][0], u1 = acc[ai][1][m][1];
#pragma unroll
                for (int e = 0; e < 4; ++e) { g0[e] = siluf_(g0[e]) * u0[e]; g1[e] = siluf_(g1[e]) * u1[e]; }
                *(u32x4*)(U + (size_t)row * DFF + u.pn * 128 + wc * 32 + 8 * fq) = pack8(g0, g1);
                asm volatile("" ::: "memory");
            }
    }
};

struct RangeOrder {
    int nM, first, cnt, c;
    __device__ bool next(int i, Unit& u) const { const int L = (c - first) + i * cnt; if (c < first || c >= first + cnt || L >= nM) return false; u.pm = L; u.pn = 0; return true; }
};
struct EpiCompress {
    static constexpr bool PERM = false, AFTER_DRAIN = true;
    const float* b1; const float* w2; bf16* out;
    __device__ __forceinline__ void fused(AccRef acc, const Unit& u, int wr, int wc, int fr, int fq, LAS unsigned char* lds, int tid) const {
        constexpr int HST = 272;
#pragma unroll
        for (int ai = 0; ai < 2; ++ai)
#pragma unroll
            for (int m = 0; m < 4; ++m) {
                const int row = ai * 128 + wr * 64 + m * 16 + fr;
#pragma unroll
                for (int n = 0; n < 2; ++n) {
                    const int col = wc * 32 + 16 * n + 4 * fq;
                    const f32x4 bv = *(const f32x4*)(b1 + col); const f32x4 v = acc[ai][0][m][n] + bv;
                    u32x2 w; w.x = pk2(siluf_(v[0]), siluf_(v[1])); w.y = pk2(siluf_(v[2]), siluf_(v[3]));
                    *(LAS u32x2*)(lds + row * HST + col * 2) = w;
                }
            }
        LAS float* w2s = (LAS float*)(lds + 256 * HST);
#pragma unroll
        for (int i = 0; i < 4; ++i) *(LAS f32x4*)(w2s + (tid + 512 * i) * 4) = *(const f32x4*)(w2 + (tid + 512 * i) * 4);
        __syncthreads();
        const int row = tid >> 1, d0 = (tid & 1) * 32;
        float o[32];
#pragma unroll
        for (int d = 0; d < 32; ++d) o[d] = 0.f;
#pragma unroll 2
        for (int j = 0; j < 128; ++j) {
            const float hv = bf2f(*(const LAS unsigned short*)(lds + row * HST + j * 2));
#pragma unroll
            for (int q = 0; q < 8; ++q) { const f32x4 wv = *(const LAS f32x4*)(w2s + j * 64 + d0 + 4 * q); o[4 * q] += hv * wv[0]; o[4 * q + 1] += hv * wv[1]; o[4 * q + 2] += hv * wv[2]; o[4 * q + 3] += hv * wv[3]; }
        }
        bf16* dst = out + ((size_t)(u.pm * 256 + row)) * 64 + d0;
        const float z = row == 255 ? 0.f : 1.f;
#pragma unroll
        for (int q = 0; q < 4; ++q) {
            u32x4 w; w.x = pk2(o[8 * q] * z, o[8 * q + 1] * z); w.y = pk2(o[8 * q + 2] * z, o[8 * q + 3] * z); w.z = pk2(o[8 * q + 4] * z, o[8 * q + 5] * z); w.w = pk2(o[8 * q + 6] * z, o[8 * q + 7] * z);
            *(u32x4*)(dst + 8 * q) = w;
        }
        __syncthreads();
    }
};

struct ColSrc { const float* p; float cs; };
template <class Map>
__device__ __forceinline__ void tr_item(const Map& mp, int ldw, const float* kscale, bf16* WT, int ldt, int nblk, int item, LAS float* scr, int lane) {
    const int kb = item / nblk, nb = item % nblk, k0 = 64 * kb, n0 = 32 * nb;
    const ColSrc cs = mp(n0 + (lane & 31));
#pragma unroll 8
    for (int i = 0; i < 32; ++i) { const int kk = 2 * i + (lane >> 5); const int k = k0 + kk;
        float v = 0.f; if (cs.p) { v = cs.p[(size_t)k * ldw] * cs.cs; if (kscale) v *= kscale[k]; }
        scr[kk * 33 + (lane & 31)] = v; }
    asm volatile("s_waitcnt lgkmcnt(0)" ::: "memory");
    const int c = lane & 7;
#pragma unroll
    for (int j = 0; j < 4; ++j) { const int n = (lane >> 3) + 8 * j; const LAS float* s = scr + (8 * c) * 33 + n;
        u32x4 o; o.x = pk2(s[0 * 33], s[1 * 33]); o.y = pk2(s[2 * 33], s[3 * 33]); o.z = pk2(s[4 * 33], s[5 * 33]); o.w = pk2(s[6 * 33], s[7 * 33]);
        *(u32x4*)(WT + (size_t)(n0 + n) * ldt + k0 + 8 * c) = o; }
    asm volatile("s_waitcnt lgkmcnt(0)" ::: "memory");
}
struct MapIn {
    const float* W;
    __device__ __forceinline__ ColSrc operator()(int n) const {
        int src; float cs = 1.f;
        if (n < 1536) src = n;
        else if (n < 2048) { src = 1544 + (n - 1536); cs = QSCALE_NSA; }
        else if (n < 2816) src = 2056 + (n - 2048);
        else if (n < 3200) src = 2848 + (n - 2816);
        else if (n < 3488) src = 3232 + (n - 3200);
        else if (n < 3496) src = 1536 + (n - 3488);
        else if (n < 3520) src = 2824 + (n - 3496);
        else src = -1;
        ColSrc r; r.p = src >= 0 ? W + src : nullptr; r.cs = cs; return r;
    }
};
struct MapPlain { const float* W; int off; float cs; __device__ __forceinline__ ColSrc operator()(int n) const { ColSrc r; r.p = W + off + n; r.cs = cs; return r; } };
struct MapPad { const float* W; int nvalid; __device__ __forceinline__ ColSrc operator()(int n) const { ColSrc r; r.p = n < nvalid ? W + n : nullptr; r.cs = 1.f; return r; } };
struct MapGU { const float* Wg; const float* Wu; __device__ __forceinline__ ColSrc operator()(int n) const { const int j = n >> 8, w = n & 255; ColSrc r; r.p = (w < 128 ? Wg : Wu) + 128 * j + (w & 127); r.cs = 1.f; return r; } };

__device__ __forceinline__ void row_resnorm(const float* xin, const float* delta, const float* gain, float* xout, bf16* xb, int lane) {
    f32x4 v[4];
#pragma unroll
    for (int j = 0; j < 4; ++j) v[j] = ((const f32x4*)xin)[lane + 64 * j];
    if (delta) {
        f32x4 d[4]; float s = 0.f;
#pragma unroll
        for (int j = 0; j < 4; ++j) { d[j] = ((const f32x4*)delta)[lane + 64 * j]; s += (d[j][0] * d[j][0] + d[j][1] * d[j][1]) + (d[j][2] * d[j][2] + d[j][3] * d[j][3]); }
        const float rstd = rsqrtf(wave_sum(s) * (1.0f / DM) + EPS);
#pragma unroll
        for (int j = 0; j < 4; ++j) { const f32x4 g = ((const f32x4*)gain)[lane + 64 * j]; v[j] = v[j] + g * d[j] * rstd; }
    }
    if (xout) {
#pragma unroll
        for (int j = 0; j < 4; ++j) ((f32x4*)xout)[lane + 64 * j] = v[j];
    }
    float s2 = 0.f;
#pragma unroll
    for (int j = 0; j < 4; ++j) s2 += (v[j][0] * v[j][0] + v[j][1] * v[j][1]) + (v[j][2] * v[j][2] + v[j][3] * v[j][3]);
    const float r2 = rsqrtf(wave_sum(s2) * (1.0f / DM) + EPS);
#pragma unroll
    for (int j = 0; j < 4; ++j) { u32x2 w; w.x = pk2(v[j][0] * r2, v[j][1] * r2); w.y = pk2(v[j][2] * r2, v[j][3] * r2); ((u32x2*)xb)[lane + 64 * j] = w; }
}

template <int NH, bool EXT>
__device__ __forceinline__ void nattn_block(const float* qs, const bf16* Kb, int ldk, const bf16* K2b, int ldk2, const bf16* Vb, int ldv,
                                            const bool (&valid)[NH], float (&m)[NH], float (&l)[NH], float (&o)[NH], int lane) {
    constexpr int QD = EXT ? 96 : 64;
    float s[NH];
#pragma unroll
    for (int h = 0; h < NH; ++h) s[h] = 0.f;
    const u32x4* kp = (const u32x4*)(Kb + (size_t)lane * ldk);
#pragma unroll
    for (int c = 0; c < 8; ++c) {
        asm volatile("" ::: "memory");
        const u32x4 kk = kp[c];
        const float kf[8] = {bflo(kk.x), bfhi(kk.x), bflo(kk.y), bfhi(kk.y), bflo(kk.z), bfhi(kk.z), bflo(kk.w), bfhi(kk.w)};
#pragma unroll
        for (int h = 0; h < NH; ++h)
#pragma unroll
            for (int e = 0; e < 8; ++e) s[h] += qs[h * QD + 8 * c + e] * kf[e];
    }
    if (EXT) {
        const u32x4* k2 = (const u32x4*)(K2b + (size_t)lane * ldk2);
#pragma unroll
        for (int c = 0; c < 4; ++c) {
            asm volatile("" ::: "memory");
            const u32x4 kk = k2[c];
            const float kf[8] = {bflo(kk.x), bfhi(kk.x), bflo(kk.y), bfhi(kk.y), bflo(kk.z), bfhi(kk.z), bflo(kk.w), bfhi(kk.w)};
#pragma unroll
            for (int h = 0; h < NH; ++h)
#pragma unroll
                for (int e = 0; e < 8; ++e) s[h] += qs[h * QD + 64 + 8 * c + e] * kf[e];
        }
    }
    float p[NH];
#pragma unroll
    for (int h = 0; h < NH; ++h) {
        const float sv = valid[h] ? s[h] : -INFINITY;
        const float bm = wave_max(sv);
        const float mn = fmaxf(m[h], bm);
        if (mn == -INFINITY) { p[h] = 0.f; continue; }
        const float alpha = exp2f(m[h] - mn);
        p[h] = valid[h] ? exp2f(s[h] - mn) : 0.f;
        l[h] = l[h] * alpha + wave_sum(p[h]); o[h] *= alpha; m[h] = mn;
    }
#pragma unroll 8
    for (int key = 0; key < 64; ++key) {
        const float vv = bf2f(Vb[(size_t)key * ldv + lane]);
#pragma unroll
        for (int h = 0; h < NH; ++h) o[h] += rdlane(p[h], key) * vv;
    }
}

struct Args { const void* in[19]; float* out; unsigned char* ws; };

struct Ctx {
    const float *x_in; const int* positions; float* XS;
    float *ROPE, *SM, *SSQ; unsigned long long* SEL; float* KCMP; bf16* KCB; bf16* CL; float *NL, *MLOC, *BLV, *MS; bf16* W_C1; float* B1;
    bf16 *W_IN, *W_G, *W_UQ, *W_UKV, *W_BR, *W_OUT, *W_GU, *W_DN;
    bf16 *XB, *AV, *AO, *BQ, *BKV, *AQK, *CQKV, *QM, *KN, *VM, *KR, *P1, *GTall, *MERGED, *U; float *MIX, *FD;
    const float *gains, *w_in, *m_conv, *m_gbias, *m_hnorm, *cmp_pos, *cmp_w1, *cmp_w2, *q_norm, *kv_norm, *w_uq, *w_ukv, *w_branch, *w_out, *w_fg, *w_fu, *w_fd;
};
__device__ __forceinline__ Ctx make_ctx(const Args& args, int layer) {
    Ctx c; unsigned char* ws = args.ws;
    c.x_in = (const float*)args.in[0]; c.positions = (const int*)args.in[1]; c.XS = args.out;
    c.ROPE = (float*)(ws + WS_ROPE); c.SM = (float*)(ws + WS_SM); c.SSQ = (float*)(ws + WS_SSQ); c.SEL = (unsigned long long*)(ws + WS_SEL); c.KCMP = (float*)(ws + WS_KCMP); c.KCB = (bf16*)(ws + WS_KCB); c.CL = (bf16*)(ws + WS_CL); c.NL = (float*)(ws + WS_NL); c.MLOC = (float*)(ws + WS_MSC); c.BLV = c.MLOC + 1024; c.MS = c.MLOC + 2048; c.W_C1 = (bf16*)(ws + WS_WC1); c.B1 = (float*)(ws + WS_B1);
    c.W_IN = (bf16*)(ws + WS_WIN); c.W_G = (bf16*)(ws + WS_WG); c.W_UQ = (bf16*)(ws + WS_WUQ); c.W_UKV = (bf16*)(ws + WS_WUKV);
    c.W_BR = (bf16*)(ws + WS_WBR); c.W_OUT = (bf16*)(ws + WS_WOUT); c.W_GU = (bf16*)(ws + WS_WGU); c.W_DN = (bf16*)(ws + WS_WDN);
    c.XB = (bf16*)(ws + WS_XB); c.AV = (bf16*)(ws + WS_AV); c.AO = (bf16*)(ws + WS_AO); c.BQ = (bf16*)(ws + WS_BQ); c.BKV = (bf16*)(ws + WS_BKV);
    c.AQK = (bf16*)(ws + WS_AQK); c.CQKV = (bf16*)(ws + WS_CQKV); c.QM = (bf16*)(ws + WS_QM); c.KN = (bf16*)(ws + WS_KN); c.VM = (bf16*)(ws + WS_VM);
    c.KR = (bf16*)(ws + WS_KR); c.P1 = (bf16*)(ws + WS_P1); c.GTall = (bf16*)(ws + WS_GT); c.MERGED = (bf16*)(ws + WS_MERGED);
    c.MIX = (float*)(ws + WS_MIX); c.U = (bf16*)(ws + WS_U); c.FD = (float*)(ws + WS_FD);
    c.gains = (const float*)args.in[2] + (size_t)layer * 4 * DM;
    c.w_in = (const float*)args.in[3] + (size_t)layer * DM * DIN;
    c.m_conv = (const float*)args.in[4] + (size_t)layer * 4 * 512;
    c.m_gbias = (const float*)args.in[5] + layer * 8;
    c.m_hnorm = (const float*)args.in[6] + layer * 512;
    c.cmp_pos = (const float*)args.in[7] + (size_t)layer * 2 * 2048;
    c.cmp_w1 = (const float*)args.in[8] + (size_t)layer * 2 * 2048 * 128;
    c.cmp_w2 = (const float*)args.in[9] + (size_t)layer * 2 * 128 * 64;
    c.q_norm = (const float*)args.in[10] + layer * 384;
    c.kv_norm = (const float*)args.in[11] + layer * 256;
    c.w_uq = (const float*)args.in[12] + (size_t)layer * 384 * 768;
    c.w_ukv = (const float*)args.in[13] + (size_t)layer * 256 * 1024;
    c.w_branch = (const float*)args.in[14] + (size_t)layer * 3 * 512 * 1024;
    c.w_out = (const float*)args.in[15] + (size_t)layer * DM * DM;
    c.w_fg = (const float*)args.in[16] + (size_t)layer * DM * DFF;
    c.w_fu = (const float*)args.in[17] + (size_t)layer * DM * DFF;
    c.w_fd = (const float*)args.in[18] + (size_t)layer * DFF * DM;
    return c;
}

#define PHASE_IDS int tid_o = threadIdx.x; asm volatile("" : "+v"(tid_o)); const int tid = tid_o, lane = tid & 63, wave = __builtin_amdgcn_readfirstlane(tid >> 6), gw = blk * 8 + wave; \
    LAS float* wscr = (LAS float*)(lds + wave * 16384); (void)wscr; (void)gw; (void)lane; (void)tid

enum { PH_P0 = 0, PH_A2, PH_B, PH_E, PH_F, PH_F2, PH_G, PH_H, PH_H2 };

template <int PH>
__device__ __forceinline__ void run_phase(const Args& args, int layer, unsigned char* lds_raw) {
    LAS unsigned char* lds = (LAS unsigned char*)lds_raw;
    const int G = gridDim.x, blk = blockIdx.x, NGW = G * 8;
    const Ctx c = make_ctx(args, layer);
    if constexpr (PH == PH_P0) {
        PHASE_IDS;
        constexpr int I_IN = (DM / 64) * (NZ / 32), I_G = (DM / 64) * (3072 / 32), I_UQ = (384 / 64) * (768 / 32), I_UKV = (256 / 64) * (1024 / 32);
        constexpr int I_BR = (512 / 64) * (1024 / 32), I_OUT = (DM / 64) * (DM / 32);
        constexpr int I_C1 = (2048 / 64) * (256 / 32);
        constexpr int NIT = I_IN + I_G + I_UQ + I_UKV + 3 * I_BR + I_OUT + 2 * I_C1;
#pragma unroll 1
        for (int it = gw; it < NIT; it += NGW) {
            int r = it;
            if (r < I_IN) { tr_item(MapIn{c.w_in}, DIN, c.gains, c.W_IN, DM, NZ / 32, r, wscr, lane); continue; } r -= I_IN;
            if (r < I_G) { tr_item(MapPlain{c.w_in, 3520, 1.f}, DIN, c.gains, c.W_G, DM, 3072 / 32, r, wscr, lane); continue; } r -= I_G;
            if (r < I_UQ) { tr_item(MapPlain{c.w_uq, 0, QSCALE_MLA}, 768, c.q_norm, c.W_UQ, 384, 768 / 32, r, wscr, lane); continue; } r -= I_UQ;
            if (r < I_UKV) { tr_item(MapPlain{c.w_ukv, 0, 1.f}, 1024, c.kv_norm, c.W_UKV, 256, 1024 / 32, r, wscr, lane); continue; } r -= I_UKV;
            if (r < 3 * I_BR) { const int br = r / I_BR; tr_item(MapPlain{c.w_branch + (size_t)br * 512 * 1024, 0, 1.f}, 1024, nullptr, c.W_BR + (size_t)br * 1024 * 512, 512, 1024 / 32, r % I_BR, wscr, lane); continue; } r -= 3 * I_BR;
            if (r < I_OUT) { tr_item(MapPlain{c.w_out, 0, 1.f}, DM, nullptr, c.W_OUT, DM, DM / 32, r, wscr, lane); continue; } r -= I_OUT;
            { const int kv = r / I_C1; tr_item(MapPad{c.cmp_w1 + (size_t)kv * 2048 * 128, 128}, 128, nullptr, c.W_C1 + (size_t)kv * 256 * 2048, 2048, 256 / 32, r % I_C1, wscr, lane); }
        }
#pragma unroll 1
        for (int o = gw; o < 256; o += NGW) {
            const int kv = o >> 7, j = o & 127; float a = 0.f;
            for (int k = lane; k < 2048; k += 64) a += c.cmp_pos[kv * 2048 + k] * c.cmp_w1[((size_t)kv * 2048 + k) * 128 + j];
            a = wave_sum(a); if (lane == 0) c.B1[o] = a;
        }
        if (layer == 0) {
#pragma unroll 1
            for (int i = blk * 512 + tid; i < T * 16; i += G * 512) {
                const int t = i >> 4, d = i & 15;
                const double f4 = (d & 3) == 0 ? 1.0 : (d & 3) == 1 ? 0.5623413251903491 : (d & 3) == 2 ? 0.31622776601683794 : 0.1778279410038923;
                const double f1 = (d >> 2) == 0 ? 1.0 : (d >> 2) == 1 ? 0.1 : (d >> 2) == 2 ? 0.01 : 0.001;
                const double ang = (double)c.positions[t] * (f4 * f1);
                const double q = rint(ang * 0.6366197723675814);
                const double y = fma(-q, 6.123233995736766e-17, fma(-q, 1.5707963267948966, ang));
                const double y2 = y * y;
                const double sy = y * (1.0 + y2 * (-1.0 / 6 + y2 * (1.0 / 120 + y2 * (-1.0 / 5040 + y2 * (1.0 / 362880 + y2 * (-1.0 / 39916800))))));
                const double cy = 1.0 + y2 * (-0.5 + y2 * (1.0 / 24 + y2 * (-1.0 / 720 + y2 * (1.0 / 40320 + y2 * (-1.0 / 3628800 + y2 * (1.0 / 479001600))))));
                const int qi = (int)q & 3;
                const double cs = qi == 0 ? cy : qi == 1 ? -sy : qi == 2 ? -cy : sy;
                const double sn = qi == 0 ? sy : qi == 1 ? cy : qi == 2 ? -sy : -cy;
                c.ROPE[2 * (size_t)i] = (float)cs; c.ROPE[2 * (size_t)i + 1] = (float)sn;
            }
#pragma unroll 1
            for (int m = gw; m < T; m += NGW) row_resnorm(c.x_in + (size_t)m * DM, nullptr, nullptr, nullptr, c.XB + (size_t)m * DM, lane);
        }
    }
    if constexpr (PH == PH_A2) {
        pg8::Gemm g{c.XB, c.W_IN}; pg8::StaticOrder S; S.init(T, NZ, G, blk);
        EpiInProj E{c.AQK, c.AV, c.AO, c.BQ, c.BKV, c.CQKV, c.KR, c.SM, c.SSQ, c.ROPE, c.m_gbias};
        pg8::gemm_phase<DM, DM, DM, 128>(lds, g, S, E);
    }
    if constexpr (PH == PH_B) {
        { pg8::Gemm g{c.CQKV, c.W_UQ}; pg8::StaticOrder S; S.init(T, 768, G, blk); EpiMlaQ E{c.QM, c.SSQ, c.ROPE}; pg8::gemm_phase<384, 640, 384, 128>(lds, g, S, E); }
        { pg8::Gemm g{c.CQKV + 384, c.W_UKV}; pg8::StaticOrder S; S.init(T, 1024, G, blk); EpiMlaKV E{c.KN, c.VM, c.SSQ}; pg8::gemm_phase<256, 640, 256, 128>(lds, g, S, E); }
        { pg8::Gemm g{c.BKV, c.W_C1}; RangeOrder S{8, G - 16, 8, blk}; EpiCompress E{c.B1, c.cmp_w2, c.KCB}; pg8::gemm_phase<2048, 1024, 2048, 128>(lds, g, S, E); }
        { pg8::Gemm g{c.BKV + (size_t)NB * 2 * SEQ * 64, c.W_C1 + (size_t)256 * 2048}; RangeOrder S{8, G - 8, 8, blk}; EpiCompress E{c.B1 + 128, c.cmp_w2 + 128 * 64, c.KCB + (size_t)8 * 256 * 64}; pg8::gemm_phase<2048, 1024, 2048, 128>(lds, g, S, E); }
    }
    if constexpr (PH == PH_E) {
        pg8::StaticOrder S; S.init(T, DM, G, blk);
        bf16* GT = c.GTall + (size_t)blk * 65536;
        { pg8::Gemm g{c.XB, c.W_G}; EpiGate E{GT}; pg8::gemm_phase<DM, DM, DM, 128>(lds, g, S, E); }
        { pg8::Gemm g{c.AV, c.W_BR}; EpiBranch E{GT, c.MERGED, 1}; pg8::gemm_phase<512, 512, 512, 128>(lds, g, S, E); }
        { pg8::Gemm g{c.XB, c.W_G + (size_t)1024 * 1024}; EpiGate E{GT}; pg8::gemm_phase<DM, DM, DM, 128>(lds, g, S, E); }
        { pg8::Gemm g{c.BQ, c.W_BR + (size_t)1024 * 512}; EpiBranch E{GT, c.MERGED, 0}; pg8::gemm_phase<512, 512, 512, 128>(lds, g, S, E); }
        { pg8::Gemm g{c.XB, c.W_G + (size_t)2 * 1024 * 1024}; EpiGate E{GT}; pg8::gemm_phase<DM, DM, DM, 128>(lds, g, S, E); }
        { pg8::Gemm g{c.QM, c.W_BR + (size_t)2 * 1024 * 512}; EpiBranch E{GT, c.MERGED, 0}; pg8::gemm_phase<512, 768, 512, 192>(lds, g, S, E); }
    }
    if constexpr (PH == PH_F) {
        {
            PHASE_IDS;
            constexpr int I_GU = (DM / 64) * (2 * DFF / 32), I_DN = (DFF / 64) * (DM / 32);
#pragma unroll 1
            for (int it = gw; it < I_GU + I_DN; it += NGW) {
                if (it < I_GU) {
                    const int n0 = 32 * (it % (2 * DFF / 32)), j = n0 >> 8, w = n0 & 255;
                    if (w < 128) tr_item(MapPlain{c.w_fg, 128 * j + w - n0, 1.f}, DFF, c.gains + 2 * DM, c.W_GU, DM, 2 * DFF / 32, it, wscr, lane);
                    else tr_item(MapPlain{c.w_fu, 128 * j + (w - 128) - n0, 1.f}, DFF, c.gains + 2 * DM, c.W_GU, DM, 2 * DFF / 32, it, wscr, lane);
                }
                else tr_item(MapPlain{c.w_fd, 0, 1.f}, DM, nullptr, c.W_DN, DFF, DM / 32, it - I_GU, wscr, lane);
            }
        }
        __syncthreads();
        pg8::Gemm g{c.MERGED, c.W_OUT}; pg8::StaticOrder S; S.init(T, DM, G, blk); EpiF32 E{c.MIX, DM};
        pg8::gemm_phase<DM, DM, DM, 128>(lds, g, S, E);
    }
    if constexpr (PH == PH_F2) {
        PHASE_IDS;
#pragma unroll 1
        for (int m = gw; m < T; m += NGW) row_resnorm((layer == 0 ? c.x_in : c.XS) + (size_t)m * DM, c.MIX + (size_t)m * DM, c.gains + DM, c.XS + (size_t)m * DM, c.XB + (size_t)m * DM, lane);
    }
    if constexpr (PH == PH_G) {
        pg8::Gemm g{c.XB, c.W_GU}; pg8::StaticOrder S; S.init(T, 2 * DFF, G, blk); EpiSwiGLU E{c.U};
        pg8::gemm_phase<DM, DM, DM, 128>(lds, g, S, E);
    }
    if constexpr (PH == PH_H) {
        pg8::Gemm g{c.U, c.W_DN}; pg8::StaticOrder S; S.init(T, DM, G, blk); EpiF32 E{c.FD, DM};
        pg8::gemm_phase<DFF, DFF, DFF, 128>(lds, g, S, E);
    }
    if constexpr (PH == PH_H2) {
        PHASE_IDS;
#pragma unroll 1
        for (int m = gw; m < T; m += NGW) row_resnorm(c.XS + (size_t)m * DM, c.FD + (size_t)m * DM, c.gains + 3 * DM, c.XS + (size_t)m * DM, c.XB + (size_t)m * DM, lane);
    }
}
template <int PH>
__global__ void __launch_bounds__(512, 2) k_phase(Args args, int layer) {
    extern __shared__ __attribute__((aligned(16))) unsigned char lds_raw[];
    run_phase<PH>(args, layer, lds_raw);
}

namespace att {
typedef float f32x16 __attribute__((ext_vector_type(16)));
typedef short s16x4 __attribute__((ext_vector_type(4)));
constexpr int VST = 192;
__device__ __forceinline__ int crow(int r, int hi) { return (r & 3) + 8 * (r >> 2) + 4 * hi; }
__device__ __forceinline__ s16x4 vtr(const LAS unsigned char* p) { return __builtin_bit_cast(s16x4, __builtin_amdgcn_ds_read_tr16_b64_v4i16((LAS s16x4*)p)); }
__device__ __forceinline__ bf16x8 pack8f(const f32x16& p, int b) {
    u32x4 w; w.x = pk2(p[b], p[b + 1]); w.y = pk2(p[b + 2], p[b + 3]); w.z = pk2(p[b + 4], p[b + 5]); w.w = pk2(p[b + 6], p[b + 7]);
    return __builtin_bit_cast(bf16x8, w);
}
struct Pass {
    f32x16 o[2]; float l;
};
template <int DQK, int MODE>
__device__ __forceinline__ Pass attn_pass(LAS unsigned char* lds, const bf16x8* qf, const bf16* K1, int ld1, const bf16* K2, int ld2, const bf16* V, int ldv,
                                          unsigned long long tmask, int qpos, unsigned long long sel, int q0) {
    constexpr int KST = DQK == 96 ? 208 : 144;
    constexpr int KBYTES = 64 * KST, VBYTES = 64 * VST, BUF = KBYTES + VBYTES;
    int tid_o = threadIdx.x; asm volatile("" : "+v"(tid_o));
    const int tid = tid_o, lane = tid & 63, hi = lane >> 5, r32 = lane & 31;
    Pass R; R.o[0] = f32x16{}; R.o[1] = f32x16{}; float m = -INFINITY, l = 0.f;
    const int skey = tid >> 3, sch = tid & 7;
    u32x4 kreg, vreg, k2reg;
    unsigned mlo = (unsigned)tmask, mhi = (unsigned)(tmask >> 32);
    auto next_tile = [&]() -> int {
        int j;
        if (mlo) { j = __builtin_ctz(mlo); mlo &= mlo - 1; } else if (mhi) { j = 32 + __builtin_ctz(mhi); mhi &= mhi - 1; } else j = -1;
        return j;
    };
    int jcur = next_tile();
    if (jcur < 0) { R.l = 0.f; return R; }
    auto gload = [&](int j) {
        kreg = *(const u32x4*)(K1 + (size_t)(j * 64 + skey) * ld1 + sch * 8);
        vreg = *(const u32x4*)(V + (size_t)(j * 64 + skey) * ldv + sch * 8);
        if (DQK == 96) { if (tid < 256) k2reg = *(const u32x4*)(K2 + (size_t)(j * 64 + (tid >> 2)) * ld2 + (tid & 3) * 8); }
    };
    auto lstore = [&](int buf) {
        LAS unsigned char* kb = lds + buf * BUF; LAS unsigned char* vb = kb + KBYTES;
        *(LAS u32x4*)(kb + skey * KST + sch * 16) = kreg;
        *(LAS u32x4*)(vb + skey * VST + sch * 16) = vreg;
        if (DQK == 96) { if (tid < 256) *(LAS u32x4*)(kb + (tid >> 2) * KST + 128 + (tid & 3) * 16) = k2reg; }
    };
    gload(jcur); lstore(0);
    __syncthreads();
    int buf = 0;
    const int vlane = (4 * hi + ((lane & 15) >> 2)) * VST + (16 * ((lane >> 4) & 1) + 4 * (lane & 3)) * 2;
    while (jcur >= 0) {
        const int jnext = next_tile();
        if (jnext >= 0) gload(jnext);
        const LAS unsigned char* kb = lds + buf * BUF; const LAS unsigned char* vb = kb + KBYTES;
        f32x16 p0 = f32x16{}, p1 = f32x16{};
#pragma unroll
        for (int s = 0; s < DQK / 16; ++s) {
            const bf16x8 k0 = *(const LAS bf16x8*)(kb + r32 * KST + s * 32 + hi * 16);
            const bf16x8 k1 = *(const LAS bf16x8*)(kb + (32 + r32) * KST + s * 32 + hi * 16);
            p0 = __builtin_amdgcn_mfma_f32_32x32x16_bf16(k0, qf[s], p0, 0, 0, 0);
            p1 = __builtin_amdgcn_mfma_f32_32x32x16_bf16(k1, qf[s], p1, 0, 0, 0);
        }
        bool rowok = true;
        if (MODE == 1) rowok = (sel >> jcur) & 1ull;
        bool need;
        if (MODE == 0) need = (jcur * 64 + 63 > q0);
        else if (MODE == 1) need = (jcur * 64 + 63 > q0);
        else need = (jcur * 64 + 63 > q0) || (jcur * 64 + 512 <= q0 + 63);
        if (need) {
            const int kbase = jcur * 64 + 4 * hi;
#pragma unroll
            for (int r = 0; r < 16; ++r) {
                const int k0i = kbase + (r & 3) + 8 * (r >> 2), k1i = k0i + 32;
                bool ok0 = (k0i <= qpos), ok1 = (k1i <= qpos);
                if (MODE == 2) { ok0 = ok0 && (qpos - k0i < 512); ok1 = ok1 && (qpos - k1i < 512); }
                if (!ok0) p0[r] = -INFINITY;
                if (!ok1) p1[r] = -INFINITY;
            }
        }
        float rm = fmaxf(p0[0], p1[0]);
#pragma unroll
        for (int r = 1; r < 16; ++r) rm = fmaxf(rm, fmaxf(p0[r], p1[r]));
        if (MODE == 1) rm = rowok ? rm : -INFINITY;
        rm = fmaxf(rm, __shfl_xor(rm, 32));
        const float mn = fmaxf(m, rm);
        const float ms = (mn == -INFINITY) ? 0.f : mn;
        const float alpha = ex2(m - ms);
        m = mn;
        float ps = 0.f;
#pragma unroll
        for (int r = 0; r < 16; ++r) { p0[r] = ex2(p0[r] - ms); p1[r] = ex2(p1[r] - ms); ps += p0[r] + p1[r]; }
        if (MODE == 1) ps = rowok ? ps : 0.f;
        l = l * alpha + ps;
        if (!__all(alpha == 1.0f)) {
#pragma unroll
            for (int r = 0; r < 16; ++r) { R.o[0][r] *= alpha; R.o[1][r] *= alpha; }
        }
        bf16x8 pb[4];
        pb[0] = pack8f(p0, 0); pb[1] = pack8f(p0, 8); pb[2] = pack8f(p1, 0); pb[3] = pack8f(p1, 8);
        if (MODE == 1) { if (!rowok) { pb[0] = bf16x8{}; pb[1] = bf16x8{}; pb[2] = bf16x8{}; pb[3] = bf16x8{}; } }
#pragma unroll
        for (int db = 0; db < 2; ++db)
#pragma unroll
            for (int ks = 0; ks < 4; ++ks) {
                const LAS unsigned char* vp = vb + ks * 16 * VST + db * 64 + vlane;
                const s16x4 lo = vtr(vp), hh = vtr(vp + 8 * VST);
                const bf16x8 vf = (bf16x8){lo[0], lo[1], lo[2], lo[3], hh[0], hh[1], hh[2], hh[3]};
                R.o[db] = __builtin_amdgcn_mfma_f32_32x32x16_bf16(vf, pb[ks], R.o[db], 0, 0, 0);
            }
        if (jnext >= 0) lstore(buf ^ 1);
        __syncthreads();
        buf ^= 1; jcur = jnext;
    }
    R.l = l + __shfl_xor(l, 32);
    return R;
}
}

constexpr int ATT_LDS = 2 * (64 * 208 + 64 * att::VST);

template <bool DUMMY = false>
__device__ __forceinline__ void mla_attn_phase(const Ctx& c, LAS unsigned char* lds) {
    const int blk = blockIdx.x;
    const int bh = blk >> 3, b = bh >> 3, h = bh & 7;
    const bf16* Kh = c.KN + (size_t)(b * 8 + h) * SEQ * 64; const bf16* Vh = c.VM + (size_t)(b * 8 + h) * SEQ * 64; const bf16* Krh = c.KR + (size_t)b * SEQ * 32;
#pragma unroll 1
    for (int u = 0; u < 2; ++u) {
        int tid_o = threadIdx.x; asm volatile("" : "+v"(tid_o));
        const int tid = tid_o, lane = tid & 63, wave = tid >> 6, hi = lane >> 5, r32 = lane & 31;
        const int qb = u == 0 ? (blk & 7) : 15 - (blk & 7);
        const int q0 = qb * 256, qpos = q0 + wave * 32 + r32;
        bf16* qrow = c.QM + ((size_t)b * SEQ + qpos) * 768 + h * 96;
        bf16x8 qf[6];
#pragma unroll
        for (int s = 0; s < 6; ++s) qf[s] = *(const bf16x8*)(qrow + s * 16 + hi * 8);
        const int nt = (q0 + 256) / 64;
        const unsigned long long tmask = nt >= 64 ? ~0ull : ((1ull << nt) - 1ull);
        const att::Pass R = att::attn_pass<96, 0>(lds, qf, Kh, 64, Krh, 32, Vh, 64, tmask, qpos, 0ull, q0);
        const float inv = 1.0f / R.l;
        if (DUMMY) qrow = (bf16*)(c.XS == nullptr ? nullptr : (unsigned char*)c.CL + (17u << 20)) + (size_t)(qpos & 1023) * 768 + h * 96;
#pragma unroll
        for (int db = 0; db < 2; ++db)
#pragma unroll
            for (int g4 = 0; g4 < 4; ++g4) {
                u32x2 w; w.x = pk2(R.o[db][4 * g4] * inv, R.o[db][4 * g4 + 1] * inv); w.y = pk2(R.o[db][4 * g4 + 2] * inv, R.o[db][4 * g4 + 3] * inv);
                *(u32x2*)(qrow + db * 32 + 8 * g4 + 4 * hi) = w;
            }
    }
}
template <bool DUMMY = false>
__device__ __forceinline__ void nsa_attn_phase(const Ctx& c, LAS unsigned char* lds) {
    const int blk = blockIdx.x;
    const int bg = blk >> 5, b = bg >> 1, gg = bg & 1;
    const bf16* Ks = c.BKV + (size_t)((2 * NB + b) * 2 + gg) * SEQ * 64; const bf16* Vs = c.BKV + (size_t)((3 * NB + b) * 2 + gg) * SEQ * 64;
    const bf16* Kw = c.BKV + (size_t)((4 * NB + b) * 2 + gg) * SEQ * 64; const bf16* Vw = c.BKV + (size_t)((5 * NB + b) * 2 + gg) * SEQ * 64;
#pragma unroll 1
    for (int u = 0; u < 2; ++u) {
        int tid_o = threadIdx.x; asm volatile("" : "+v"(tid_o));
        const int tid = tid_o, lane = tid & 63, wave = tid >> 6, hi = lane >> 5, r32 = lane & 31;
        const int tt = u == 0 ? (blk & 31) : 63 - (blk & 31);
        const int q0 = tt * 64, row = wave * 32 + r32, qpos = q0 + (row >> 2), hh = gg * 4 + (row & 3);
        const size_t t = (size_t)b * SEQ + qpos;
        bf16* qrow = c.BQ + t * 512 + hh * 64;
        bf16x8 qf[4];
#pragma unroll
        for (int s = 0; s < 4; ++s) qf[s] = *(const bf16x8*)(qrow + s * 16 + hi * 8);
        const unsigned long long sel = c.SEL[t * 2 + gg];
        unsigned long long um = sel;
#pragma unroll
        for (int o = 1; o < 64; o <<= 1) { const unsigned lo = __shfl_xor((unsigned)um, o), hx = __shfl_xor((unsigned)(um >> 32), o); um |= ((unsigned long long)hx << 32) | lo; }
        LAS unsigned long long* ux = (LAS unsigned long long*)(lds + ATT_LDS);
        if (lane == 0) ux[wave] = um;
        __syncthreads();
        unsigned long long uall = 0ull;
#pragma unroll
        for (int w = 0; w < 8; ++w) uall |= ux[w];
        const unsigned ulo = __builtin_amdgcn_readfirstlane((unsigned)uall), uhi = __builtin_amdgcn_readfirstlane((unsigned)(uall >> 32));
        const unsigned long long tm_sel = (((unsigned long long)uhi << 32) | ulo) & (tt >= 63 ? ~0ull : ((1ull << (tt + 1)) - 1ull));
        const att::Pass Rs = att::attn_pass<64, 1>(lds, qf, Ks, 64, nullptr, 0, Vs, 64, tm_sel, qpos, sel, q0);
        const float gs = c.SM[t * 32 + 8 + hh * 3 + 1], gwn = c.SM[t * 32 + 8 + hh * 3 + 2];
        const float fs = Rs.l > 0.f ? gs / Rs.l : 0.f;
        att::f32x16 res[2];
#pragma unroll
        for (int db = 0; db < 2; ++db)
#pragma unroll
            for (int r = 0; r < 16; ++r) res[db][r] = Rs.o[db][r] * fs;
        const int j0 = tt >= 8 ? tt - 8 : 0;
        const unsigned long long tm_win = (tt >= 63 ? ~0ull : ((1ull << (tt + 1)) - 1ull)) & ~((1ull << j0) - 1ull);
        const att::Pass Rw = att::attn_pass<64, 2>(lds, qf, Kw, 64, nullptr, 0, Vw, 64, tm_win, qpos, 0ull, q0);
        const float fw = Rw.l > 0.f ? gwn / Rw.l : 0.f;
        const bf16* p1row = c.P1 + t * 512 + hh * 64;
        if (DUMMY) qrow = (bf16*)((unsigned char*)c.CL + (17u << 20)) + (size_t)(qpos & 1023) * 512 + hh * 64;
#pragma unroll
        for (int db = 0; db < 2; ++db)
#pragma unroll
            for (int g4 = 0; g4 < 4; ++g4) {
                const u32x2 pw = *(const u32x2*)(p1row + db * 32 + 8 * g4 + 4 * hi);
                const float y0 = res[db][4 * g4] + Rw.o[db][4 * g4] * fw + bflo(pw.x), y1 = res[db][4 * g4 + 1] + Rw.o[db][4 * g4 + 1] * fw + bfhi(pw.x);
                const float y2 = res[db][4 * g4 + 2] + Rw.o[db][4 * g4 + 2] * fw + bflo(pw.y), y3 = res[db][4 * g4 + 3] + Rw.o[db][4 * g4 + 3] * fw + bfhi(pw.y);
                u32x2 w; w.x = pk2(y0, y1); w.y = pk2(y2, y3);
                *(u32x2*)(qrow + db * 32 + 8 * g4 + 4 * hi) = w;
            }
        __syncthreads();
    }
}
__device__ __forceinline__ void cmp_attn_phase(const Ctx& c, LAS unsigned char* lds) {
    using att::f32x16;
    constexpr int KST = 144, VST = att::VST, KOFF = 0, VOFF = 256 * KST, GOFF = VOFF + 256 * VST, LOFF = GOFF + 64 * 64 * 4;
    const int blk = blockIdx.x;
    const int bg = blk >> 5, b = bg >> 1, gg = bg & 1;
    const bf16* Kc = c.KCB + (size_t)(0 * 8 + bg) * 256 * 64; const bf16* Vc = c.KCB + (size_t)(1 * 8 + bg) * 256 * 64;
#pragma unroll 1
    for (int u = 0; u < 2; ++u) {
        int tid_o = threadIdx.x; asm volatile("" : "+v"(tid_o));
        const int tid = tid_o, lane = tid & 63, wave = tid >> 6, hi = lane >> 5, r32 = lane & 31;
        const int tt = u == 0 ? (blk & 31) : 63 - (blk & 31);
        const int q0 = tt * 64, row = wave * 32 + r32, qpos = q0 + (row >> 2), hh = gg * 4 + (row & 3);
        const size_t t = (size_t)b * SEQ + qpos;
        const bf16* qrow = c.BQ + t * 512 + hh * 64;
        bf16x8 qf[4];
#pragma unroll
        for (int s = 0; s < 4; ++s) qf[s] = *(const bf16x8*)(qrow + s * 16 + hi * 8);
        int ntile = ((q0 + 32) >> 4) / 64 + 1; if (ntile > 4) ntile = 4;
        for (int idx = tid; idx < ntile * 512; idx += 512) {
            const int key = idx >> 3, ch = idx & 7;
            *(LAS u32x4*)(lds + KOFF + key * KST + ch * 16) = *(const u32x4*)(Kc + (size_t)key * 64 + ch * 8);
            *(LAS u32x4*)(lds + VOFF + key * VST + ch * 16) = *(const u32x4*)(Vc + (size_t)key * 64 + ch * 8);
        }
        LAS float* Gs = (LAS float*)(lds + GOFF); LAS float* Ls = (LAS float*)(lds + LOFF);
#pragma unroll
        for (int i = 0; i < 8; ++i) { Gs[tid + 512 * i] = 0.f; Ls[tid + 512 * i] = 0.f; }
        __syncthreads();
        float m = -INFINITY, l = 0.f;
#pragma unroll 1
        for (int pass = 0; pass < 2; ++pass) {
            const float ms = (m == -INFINITY) ? 0.f : m;
            float inv = 0.f;
            if (pass == 1) { const float lt = l + __shfl_xor(l, 32); inv = lt > 0.f ? 1.0f / lt : 0.f; }
            f32x16 o0 = f32x16{}, o1 = f32x16{};
#pragma unroll 1
            for (int kt = 0; kt < ntile; ++kt) {
                const LAS unsigned char* kb = lds + KOFF + kt * 64 * KST;
                f32x16 p0 = f32x16{}, p1 = f32x16{};
#pragma unroll
                for (int s = 0; s < 4; ++s) {
                    const bf16x8 k0 = *(const LAS bf16x8*)(kb + r32 * KST + s * 32 + hi * 16);
                    const bf16x8 k1 = *(const LAS bf16x8*)(kb + (32 + r32) * KST + s * 32 + hi * 16);
                    p0 = __builtin_amdgcn_mfma_f32_32x32x16_bf16(k0, qf[s], p0, 0, 0, 0);
                    p1 = __builtin_amdgcn_mfma_f32_32x32x16_bf16(k1, qf[s], p1, 0, 0, 0);
                }
                const int nb0 = kt * 64 + 4 * hi;
#pragma unroll
                for (int r = 0; r < 16; ++r) {
                    const int n0 = nb0 + (r & 3) + 8 * (r >> 2), n1 = n0 + 32;
                    if (!((16 * n0 + 31 <= qpos) && n0 < 255)) p0[r] = -INFINITY;
                    if (!((16 * n1 + 31 <= qpos) && n1 < 255)) p1[r] = -INFINITY;
                }
                if (pass == 0) {
                    float rm = fmaxf(p0[0], p1[0]);
#pragma unroll
                    for (int r = 1; r < 16; ++r) rm = fmaxf(rm, fmaxf(p0[r], p1[r]));
                    rm = fmaxf(rm, __shfl_xor(rm, 32));
                    const float mn = fmaxf(m, rm); const float msn = (mn == -INFINITY) ? 0.f : mn;
                    const float alpha = ex2(m - msn); m = mn;
                    float ps = 0.f;
#pragma unroll
                    for (int r = 0; r < 16; ++r) ps += ex2(p0[r] - msn) + ex2(p1[r] - msn);
                    l = l * alpha + ps;
                } else {
#pragma unroll
                    for (int r = 0; r < 16; ++r) { p0[r] = ex2(p0[r] - ms) * inv; p1[r] = ex2(p1[r] - ms) * inv; }
#pragma unroll
                    for (int hf = 0; hf < 2; ++hf)
#pragma unroll
                        for (int g = 0; g < 4; ++g) {
                            const f32x16& p = hf == 0 ? p0 : p1;
                            float G = (p[4 * g] + p[4 * g + 1]) + (p[4 * g + 2] + p[4 * g + 3]), L = p[4 * g + 3];
                            G += __shfl_xor(G, 1); G += __shfl_xor(G, 2); L += __shfl_xor(L, 1); L += __shfl_xor(L, 2);
                            if ((lane & 3) == 0) { const int j = 16 * kt + 8 * hf + 2 * g + hi; Gs[(row >> 2) * 64 + j] = G; Ls[(row >> 2) * 64 + j] = L; }
                        }
                    bf16x8 pb[4];
                    pb[0] = att::pack8f(p0, 0); pb[1] = att::pack8f(p0, 8); pb[2] = att::pack8f(p1, 0); pb[3] = att::pack8f(p1, 8);
                    const int vlane = (4 * hi + ((lane & 15) >> 2)) * VST + (16 * ((lane >> 4) & 1) + 4 * (lane & 3)) * 2;
                    const LAS unsigned char* vb = lds + VOFF + kt * 64 * VST;
#pragma unroll
                    for (int ks = 0; ks < 4; ++ks) {
                        const LAS unsigned char* vp = vb + ks * 16 * VST + vlane;
                        const att::s16x4 lo0 = att::vtr(vp), hh0 = att::vtr(vp + 8 * VST), lo1 = att::vtr(vp + 64), hh1 = att::vtr(vp + 64 + 8 * VST);
                        const bf16x8 vf0 = (bf16x8){lo0[0], lo0[1], lo0[2], lo0[3], hh0[0], hh0[1], hh0[2], hh0[3]};
                        const bf16x8 vf1 = (bf16x8){lo1[0], lo1[1], lo1[2], lo1[3], hh1[0], hh1[1], hh1[2], hh1[3]};
                        o0 = __builtin_amdgcn_mfma_f32_32x32x16_bf16(vf0, pb[ks], o0, 0, 0, 0);
                        o1 = __builtin_amdgcn_mfma_f32_32x32x16_bf16(vf1, pb[ks], o1, 0, 0, 0);
                    }
                }
            }
            if (pass == 1) {
                const float gc = c.SM[t * 32 + 8 + hh * 3 + 0];
                bf16* prow = c.P1 + t * 512 + hh * 64;
#pragma unroll
                for (int g4 = 0; g4 < 4; ++g4) {
                    u32x2 w; w.x = pk2(o0[4 * g4] * gc, o0[4 * g4 + 1] * gc); w.y = pk2(o0[4 * g4 + 2] * gc, o0[4 * g4 + 3] * gc);
                    *(u32x2*)(prow + 8 * g4 + 4 * hi) = w;
                    u32x2 w2; w2.x = pk2(o1[4 * g4] * gc, o1[4 * g4 + 1] * gc); w2.y = pk2(o1[4 * g4 + 2] * gc, o1[4 * g4 + 3] * gc);
                    *(u32x2*)(prow + 32 + 8 * g4 + 4 * hi) = w2;
                }
            }
        }
        __syncthreads();
#pragma unroll 1
        for (int i = 0; i < 8; ++i) {
            const int tok = wave * 8 + i, s = q0 + tok;
            const float imp = Gs[tok * 64 + lane] + (lane > 0 ? Ls[tok * 64 + lane - 1] : 0.f);
            const int cur = s >> 6;
            const bool vj = lane <= cur; const bool forced = (lane == 0) || (lane == cur) || (lane == cur - 1);
            const float score = vj ? imp + (forced ? 1e4f : 0.f) : -1.0f;
            int cnt = 0;
#pragma unroll 8
            for (int i2 = 0; i2 < 64; ++i2) { const float si = rdlane(score, i2); cnt += ((si > score) || (si == score && i2 < lane)) ? 1 : 0; }
            const bool selb = (cnt < 16) && (score > -0.5f);
            const unsigned long long mask = __ballot(selb);
            if (lane == 0) c.SEL[((size_t)b * SEQ + s) * 2 + gg] = mask;
        }
        __syncthreads();
    }
}
namespace ml {
using att::f32x16; using att::s16x4;
constexpr int QST = 144, KTST = 192, VST2 = 320, CST = 144;
__device__ __forceinline__ float scan_add(float v, int lane) {
#pragma unroll
    for (int o = 1; o < 64; o <<= 1) { const float u = __shfl_up(v, o); if (lane >= o) v += u; }
    return v;
}
__device__ __forceinline__ float scan_max(float v, int lane) {
#pragma unroll
    for (int o = 1; o < 64; o <<= 1) { const float u = __shfl_up(v, o); if (lane >= o) v = fmaxf(v, u); }
    return v;
}
__device__ __forceinline__ void conv8(const bf16* AQK, const float* m_conv, int b, int s, int ch0, float scale, float (&out)[8]) {
    float a[8] = {0.f, 0.f, 0.f, 0.f, 0.f, 0.f, 0.f, 0.f};
#pragma unroll
    for (int kk = 0; kk < 4; ++kk) {
        const int sp = s - 3 + kk;
        if (sp >= 0) {
            const u32x4 xv = *(const u32x4*)(AQK + ((size_t)b * SEQ + sp) * 512 + ch0);
            const f32x4 w0 = *(const f32x4*)(m_conv + kk * 512 + ch0), w1 = *(const f32x4*)(m_conv + kk * 512 + ch0 + 4);
            a[0] += w0[0] * bflo(xv.x); a[1] += w0[1] * bfhi(xv.x); a[2] += w0[2] * bflo(xv.y); a[3] += w0[3] * bfhi(xv.y);
            a[4] += w1[0] * bflo(xv.z); a[5] += w1[1] * bfhi(xv.z); a[6] += w1[2] * bflo(xv.w); a[7] += w1[3] * bfhi(xv.w);
        }
    }
#pragma unroll
    for (int e = 0; e < 8; ++e) out[e] = siluf_(a[e]) * scale;
}
__device__ __forceinline__ void ml1_phase(const Ctx& c, LAS unsigned char* lds) {
    constexpr int KOFF = 0, VOFF = 64 * KTST, SOFF = VOFF + 64 * VST2;
#pragma unroll 1
    for (int unit = blockIdx.x; unit < 1024; unit += gridDim.x) {
        int tid_o = threadIdx.x; asm volatile("" : "+v"(tid_o));
        const int tid = tid_o, lane = tid & 63, wave = tid >> 6, hi = lane >> 5, r32 = lane & 31;
        const int bh = unit >> 6, ch = unit & 63, b = bh >> 2, h = bh & 3, s0 = ch * 64;
        LAS float* wv = (LAS float*)(lds + SOFF);
        if (wave == 0) {
            const size_t t = (size_t)b * SEQ + s0 + lane;
            const float lf = c.SM[t * 32 + 4 + h], li = c.SM[t * 32 + h];
            const float bc = scan_add(lf, lane); const float g = li - bc;
            const float gmax = wave_max(g); const float bL = rdlane(bc, 63);
            wv[lane] = __expf(g - gmax);
            if (lane == 0) { c.MLOC[unit] = bL + gmax; c.BLV[unit] = bL; }
        }
        {
            const int tk = tid >> 3, cc = (tid & 7) * 16;
            const bf16* vsrc = c.AV + ((size_t)b * SEQ + s0 + tk) * 512 + h * 128 + cc;
            *(LAS u32x4*)(lds + VOFF + tk * VST2 + cc * 2) = *(const u32x4*)vsrc;
            *(LAS u32x4*)(lds + VOFF + tk * VST2 + cc * 2 + 16) = *(const u32x4*)(vsrc + 8);
        }
        __syncthreads();
        {
            const int tk = tid >> 3, cc = (tid & 7) * 8;
            float kf[8]; conv8(c.AQK, c.m_conv, b, s0 + tk, 256 + h * 64 + cc, 1.0f, kf);
            const float w = wv[tk];
            u32x4 o; o.x = pk2(kf[0] * w, kf[1] * w); o.y = pk2(kf[2] * w, kf[3] * w); o.z = pk2(kf[4] * w, kf[5] * w); o.w = pk2(kf[6] * w, kf[7] * w);
            *(LAS u32x4*)(lds + KOFF + tk * KTST + cc * 2) = o;
        }
        __syncthreads();
        if (tid < 64) {
            float a = 0.f;
#pragma unroll 8
            for (int tk = 0; tk < 64; ++tk) a += bf2f(*(const LAS unsigned short*)(lds + KOFF + tk * KTST + tid * 2));
            c.NL[(size_t)unit * 64 + tid] = a;
        }
        const int vb = wave >> 1, kb2 = wave & 1;
        const int tro = (8 * hi + ((lane & 15) >> 2)), tco = (16 * ((lane >> 4) & 1) + 4 * (lane & 3)) * 2;
        f32x16 acc = f32x16{};
#pragma unroll
        for (int ks = 0; ks < 4; ++ks) {
            const LAS unsigned char* vp = lds + VOFF + (16 * ks + tro) * VST2 + vb * 64 + tco;
            const LAS unsigned char* kp = lds + KOFF + (16 * ks + tro) * KTST + kb2 * 64 + tco;
            const s16x4 a0 = att::vtr(vp), a1 = att::vtr(vp + 4 * VST2), b0 = att::vtr(kp), b1 = att::vtr(kp + 4 * KTST);
            const bf16x8 af = (bf16x8){a0[0], a0[1], a0[2], a0[3], a1[0], a1[1], a1[2], a1[3]};
            const bf16x8 bf = (bf16x8){b0[0], b0[1], b0[2], b0[3], b1[0], b1[1], b1[2], b1[3]};
            acc = __builtin_amdgcn_mfma_f32_32x32x16_bf16(af, bf, acc, 0, 0, 0);
        }
        bf16* dst = c.CL + (size_t)unit * 8192 + kb2 * 32 + r32;
#pragma unroll
        for (int r = 0; r < 16; ++r) dst[(size_t)(vb * 32 + att::crow(r, hi)) * 64] = (bf16)f2bf(acc[r]);
        __syncthreads();
    }
}
__device__ __forceinline__ void ml2_phase(const Ctx& c) {
    const int gt = blockIdx.x * 512 + threadIdx.x;
    const int NT = gridDim.x * 512;
#pragma unroll 1
    for (int e0 = gt; e0 < 16 * 8192 + 16 * 64; e0 += NT) {
        const bool isn = e0 >= 16 * 8192;
        const int bh = isn ? (e0 - 16 * 8192) >> 6 : e0 >> 13, e = isn ? (e0 & 63) : (e0 & 8191);
        float m = 0.f, C = 0.f;
#pragma unroll 4
        for (int ch = 0; ch < 64; ++ch) {
            const int unit = bh * 64 + ch;
            const float ml = c.MLOC[unit], bl = c.BLV[unit];
            float cl;
            if (isn) { float* p = c.NL + (size_t)unit * 64 + e; cl = *p; *p = C; }
            else { bf16* p = c.CL + (size_t)unit * 8192 + e; cl = bf2f(*p); *p = (bf16)f2bf(C); }
            if (e == 0 && !isn) c.MS[unit] = m;
            const float mn = fmaxf(bl + m, ml);
            C = __expf(bl + m - mn) * C + __expf(ml - mn) * cl; m = mn;
        }
    }
}
template <bool DUMMY = false>
__device__ __forceinline__ void ml3_phase(const Ctx& c, LAS unsigned char* lds) {
    constexpr int QOFF = 0, KOFF = 64 * QST, VOFF = KOFF + 64 * QST, COFF = VOFF + 64 * VST2, SOFF = COFF + 128 * CST;
#pragma unroll 1
    for (int unit = blockIdx.x; unit < 1024; unit += gridDim.x) {
        int tid_o = threadIdx.x; asm volatile("" : "+v"(tid_o));
        const int tid = tid_o, lane = tid & 63, wave = tid >> 6, hi = lane >> 5, r32 = lane & 31;
        const int bh = unit >> 6, ch = unit & 63, b = bh >> 2, h = bh & 3, s0 = ch * 64;
        LAS float* gS = (LAS float*)(lds + SOFF); LAS float* bS = gS + 64; LAS float* MS_ = gS + 128; LAS float* nS = gS + 192; LAS float* red = gS + 256;
        const float mc = c.MS[unit];
        if (wave == 0) {
            const size_t t = (size_t)b * SEQ + s0 + lane;
            const float lf = c.SM[t * 32 + 4 + h], li = c.SM[t * 32 + h];
            const float bc = scan_add(lf, lane); const float g = li - bc;
            const float pm = scan_max(g, lane);
            gS[lane] = g; bS[lane] = bc; MS_[lane] = fmaxf(mc, pm);
            nS[lane] = c.NL[(size_t)unit * 64 + lane];
        }
        {
            const int tk = tid >> 3, cc = (tid & 7) * 16;
            const bool isk = cc >= 64; const int c0 = isk ? 256 + h * 64 + (cc - 64) : h * 64 + cc;
            float f0[8], f1[8];
            conv8(c.AQK, c.m_conv, b, s0 + tk, c0, isk ? 1.0f : 0.125f, f0); conv8(c.AQK, c.m_conv, b, s0 + tk, c0 + 8, isk ? 1.0f : 0.125f, f1);
            u32x4 o0, o1; o0.x = pk2(f0[0], f0[1]); o0.y = pk2(f0[2], f0[3]); o0.z = pk2(f0[4], f0[5]); o0.w = pk2(f0[6], f0[7]);
            o1.x = pk2(f1[0], f1[1]); o1.y = pk2(f1[2], f1[3]); o1.z = pk2(f1[4], f1[5]); o1.w = pk2(f1[6], f1[7]);
            LAS unsigned char* dstp = lds + (isk ? KOFF : QOFF) + tk * QST + (isk ? cc - 64 : cc) * 2;
            *(LAS u32x4*)dstp = o0; *(LAS u32x4*)(dstp + 16) = o1;
            const bf16* vsrc = c.AV + ((size_t)b * SEQ + s0 + tk) * 512 + h * 128 + cc;
            *(LAS u32x4*)(lds + VOFF + tk * VST2 + cc * 2) = *(const u32x4*)vsrc;
            *(LAS u32x4*)(lds + VOFF + tk * VST2 + cc * 2 + 16) = *(const u32x4*)(vsrc + 8);
            const int vv = tid >> 2, kc = (tid & 3) * 16;
            const bf16* csrc = c.CL + (size_t)unit * 8192 + vv * 64 + kc;
            *(LAS u32x4*)(lds + COFF + vv * CST + kc * 2) = *(const u32x4*)csrc;
            *(LAS u32x4*)(lds + COFF + vv * CST + kc * 2 + 16) = *(const u32x4*)(csrc + 8);
        }
        __syncthreads();
        const int vb = wave >> 1, tb = wave & 1;
        const int tl = tb * 32 + r32;
        bf16x8 qf[4];
#pragma unroll
        for (int s = 0; s < 4; ++s) qf[s] = *(const LAS bf16x8*)(lds + QOFF + tl * QST + s * 32 + hi * 16);
        f32x16 p0 = f32x16{}, p1 = f32x16{};
#pragma unroll
        for (int s = 0; s < 4; ++s) {
            const bf16x8 k0 = *(const LAS bf16x8*)(lds + KOFF + r32 * QST + s * 32 + hi * 16);
            const bf16x8 k1 = *(const LAS bf16x8*)(lds + KOFF + (32 + r32) * QST + s * 32 + hi * 16);
            p0 = __builtin_amdgcn_mfma_f32_32x32x16_bf16(k0, qf[s], p0, 0, 0, 0);
            p1 = __builtin_amdgcn_mfma_f32_32x32x16_bf16(k1, qf[s], p1, 0, 0, 0);
        }
        const float Mt = MS_[tl], bt = bS[tl];
        float dsum = 0.f;
#pragma unroll
        for (int r = 0; r < 16; ++r) {
            const int sa = att::crow(r, hi), sb = sa + 32;
            const float wa = sa <= tl ? __expf(gS[sa] - Mt) : 0.f, wb = sb <= tl ? __expf(gS[sb] - Mt) : 0.f;
            p0[r] *= wa; p1[r] *= wb; dsum += p0[r] + p1[r];
        }
        dsum += __shfl_xor(dsum, 32);
        f32x16 acc = f32x16{};
#pragma unroll
        for (int s = 0; s < 4; ++s) {
            const bf16x8 cf = *(const LAS bf16x8*)(lds + COFF + (vb * 32 + r32) * CST + s * 32 + hi * 16);
            acc = __builtin_amdgcn_mfma_f32_32x32x16_bf16(cf, qf[s], acc, 0, 0, 0);
        }
        const float at = __expf(mc - Mt);
#pragma unroll
        for (int r = 0; r < 16; ++r) acc[r] *= at;
        float nq = 0.f;
#pragma unroll
        for (int s = 0; s < 4; ++s)
#pragma unroll
            for (int e = 0; e < 8; ++e) nq += nS[16 * s + 8 * hi + e] * bf2f((unsigned short)qf[s][e]);
        nq += __shfl_xor(nq, 32);
        bf16x8 pb[4];
        pb[0] = att::pack8f(p0, 0); pb[1] = att::pack8f(p0, 8); pb[2] = att::pack8f(p1, 0); pb[3] = att::pack8f(p1, 8);
        const int vlane = (4 * hi + ((lane & 15) >> 2)) * VST2 + (16 * ((lane >> 4) & 1) + 4 * (lane & 3)) * 2;
#pragma unroll
        for (int ks = 0; ks < 4; ++ks) {
            const LAS unsigned char* vp = lds + VOFF + ks * 16 * VST2 + vb * 64 + vlane;
            const s16x4 lo = att::vtr(vp), hh = att::vtr(vp + 8 * VST2);
            const bf16x8 vf = (bf16x8){lo[0], lo[1], lo[2], lo[3], hh[0], hh[1], hh[2], hh[3]};
            acc = __builtin_amdgcn_mfma_f32_32x32x16_bf16(vf, pb[ks], acc, 0, 0, 0);
        }
        const float den = at * nq + dsum;
        const float rdn = 1.0f / fmaxf(fabsf(den), __expf(-(bt + Mt)));
        float ss = 0.f;
#pragma unroll
        for (int r = 0; r < 16; ++r) { acc[r] *= rdn; ss += acc[r] * acc[r]; }
        ss += __shfl_xor(ss, 32);
        if (hi == 0) red[vb * 64 + tl] = ss;
        __syncthreads();
        const float rstd = rsqrtf((red[tl] + red[64 + tl] + red[128 + tl] + red[192 + tl]) * (1.0f / 128.0f) + EPS);
        const size_t t = (size_t)b * SEQ + s0 + tl;
#pragma unroll
        for (int g4 = 0; g4 < 4; ++g4) {
            const int v0 = vb * 32 + 8 * g4 + 4 * hi;
            const u32x2 aw = *(const u32x2*)(c.AO + t * 512 + h * 128 + v0);
            const f32x4 hn = *(const f32x4*)(c.m_hnorm + h * 128 + v0);
            u32x2 w; w.x = pk2(acc[4 * g4] * rstd * hn[0] * bflo(aw.x), acc[4 * g4 + 1] * rstd * hn[1] * bfhi(aw.x));
            w.y = pk2(acc[4 * g4 + 2] * rstd * hn[2] * bflo(aw.y), acc[4 * g4 + 3] * rstd * hn[3] * bfhi(aw.y));
            *(u32x2*)((DUMMY ? (bf16*)((unsigned char*)c.CL + (17u << 20)) + (size_t)((s0 + tl) & 1023) * 512 : c.AV + t * 512) + h * 128 + v0) = w;
        }
        __syncthreads();
    }
}
}
template <int WHICH>
__global__ void __launch_bounds__(512, 2) k_ml(Args args, int layer) {
    extern __shared__ __attribute__((aligned(16))) unsigned char lds_raw[];
    const Ctx c = make_ctx(args, layer);
    if (WHICH == 0) ml::ml1_phase(c, (LAS unsigned char*)lds_raw); else if (WHICH == 1) ml::ml2_phase(c); else ml::ml3_phase(c, (LAS unsigned char*)lds_raw);
}

template <int WHICH>
__global__ void __launch_bounds__(512, 2) k_attn(Args args, int layer) {
    extern __shared__ __attribute__((aligned(16))) unsigned char lds_raw[];
    const Ctx c = make_ctx(args, layer);
    if (WHICH == 0) mla_attn_phase(c, (LAS unsigned char*)lds_raw); else if (WHICH == 1) nsa_attn_phase(c, (LAS unsigned char*)lds_raw); else cmp_attn_phase(c, (LAS unsigned char*)lds_raw);
}

#define XB_TMO      128
#define XB_XCNT(j)  (256  + 64 * (j))
#define XB_XSUB(j)  (1280 + 64 * (j))
#define XB_XGEN(j)  (2304 + 64 * (j))
#define XB_TOP      3328
#define XB_TOPGEN   3392
#define XCD_BAR_WORDS 3456
#define XB_SPIN_CAP (1u << 22)
__device__ __forceinline__ unsigned xb_ld(unsigned* p)              { return __hip_atomic_load(p, __ATOMIC_RELAXED, __HIP_MEMORY_SCOPE_AGENT); }
__device__ __forceinline__ unsigned xb_add(unsigned* p, unsigned v) { return __hip_atomic_fetch_add(p, v, __ATOMIC_RELAXED, __HIP_MEMORY_SCOPE_AGENT); }
__device__ __forceinline__ unsigned xb_xcc_id() { return (unsigned)__builtin_amdgcn_s_getreg((3 << 11) | 20) & 0xFu; }
#define XB_SPIN(cond, bar) do { unsigned _sp = 0; while (cond) { __builtin_amdgcn_s_sleep(1); \
    if ((++_sp & 255u) == 0u) { if (xb_ld(&(bar)[XB_TMO])) break; if (_sp > XB_SPIN_CAP) { atomicAdd(&(bar)[XB_TMO], 1u); break; } } } } while (0)
struct XcdBarrier { unsigned* bar; unsigned x; volatile LAS unsigned* st; };
__device__ __forceinline__ XcdBarrier xcd_barrier_post(unsigned* bar, volatile LAS unsigned* st) {
    XcdBarrier b; b.bar = bar; b.x = xb_xcc_id(); b.st = st;
    if (threadIdx.x == 0) (void)xb_add(&bar[XB_XCNT(b.x)], 1u);
    return b;
}
__device__ __forceinline__ void xcd_barrier_complete(unsigned* bar, unsigned x, unsigned& nloc, unsigned& nx) {
    const unsigned G = gridDim.x * gridDim.y * gridDim.z;
    unsigned sum, cnt, mine, sp = 0u;
    for (;;) {
        sum = 0u; cnt = 0u; mine = 0u;
#pragma unroll
        for (unsigned j = 0; j < 16; ++j) { const unsigned c = xb_ld(&bar[XB_XCNT(j)]); sum += c; cnt += (c > 0u) ? 1u : 0u; mine = (j == x) ? c : mine; }
        if (sum == G) break;
        __builtin_amdgcn_s_sleep(1);
        if ((++sp & 255u) == 0u) { if (xb_ld(&bar[XB_TMO])) break; if (sp > XB_SPIN_CAP) { atomicAdd(&bar[XB_TMO], 1u); break; } }
    }
    nloc = mine > 0u ? mine : 1u; nx = cnt > 0u ? cnt : 1u;
}
__device__ __forceinline__ void xcd_barrier(const XcdBarrier& b) {
    asm volatile("s_waitcnt vmcnt(0)" ::: "memory");
    __syncthreads();
    if (threadIdx.x == 0) {
        unsigned* bar = b.bar;
        __builtin_amdgcn_s_waitcnt(0);
        unsigned nloc = b.st[0], nx = b.st[1];
        if (nloc == 0u) { xcd_barrier_complete(bar, b.x, nloc, nx); b.st[0] = nloc; b.st[1] = nx; }
        const unsigned old = xb_add(&bar[XB_XSUB(b.x)], 1u);
        const unsigned gen = old / nloc;
        if (old + 1u == (gen + 1u) * nloc) {
            __builtin_amdgcn_fence(__ATOMIC_RELEASE, "agent");
            asm volatile("s_waitcnt vmcnt(0)" ::: "memory");
            const unsigned og = xb_add(&bar[XB_TOP], 1u);
            const unsigned tg = og / nx;
            if (og + 1u == (tg + 1u) * nx) xb_add(&bar[XB_TOPGEN], 1u);
            else XB_SPIN(xb_ld(&bar[XB_TOPGEN]) == tg, bar);
            __builtin_amdgcn_fence(__ATOMIC_ACQUIRE, "agent");
            xb_add(&bar[XB_XGEN(b.x)], 1u);
            asm volatile("s_waitcnt vmcnt(0)" ::: "memory");
        } else {
            XB_SPIN(xb_ld(&bar[XB_XGEN(b.x)]) == gen, bar);
            __builtin_amdgcn_fence(__ATOMIC_ACQUIRE, "agent");
            asm volatile("s_waitcnt vmcnt(0)" ::: "memory");
        }
    }
    __syncthreads();
}

template <int LAYER>
__device__ __forceinline__ void mega_layer(const Args& args, unsigned char* lds_raw, cg::grid_group& grid, const XcdBarrier& xbar) {
    LAS unsigned char* lds = (LAS unsigned char*)lds_raw;
#ifdef DBL_P0
    run_phase<PH_P0>(args, LAYER, lds_raw);
#endif
    run_phase<PH_P0>(args, LAYER, lds_raw); if (LAYER == 0) grid.sync(); else xcd_barrier(xbar);
#ifdef DBL_A2
    run_phase<PH_A2>(args, LAYER, lds_raw);
#endif
    run_phase<PH_A2>(args, LAYER, lds_raw); xcd_barrier(xbar);
#ifdef DBL_B
    run_phase<PH_B>(args, LAYER, lds_raw);
#endif
#ifdef DBL_ML1
    { const Ctx c = make_ctx(args, LAYER); ml::ml1_phase(c, lds); }
#endif
    run_phase<PH_B>(args, LAYER, lds_raw);
    { const Ctx c = make_ctx(args, LAYER); ml::ml1_phase(c, lds); }
    xcd_barrier(xbar);
#ifdef DBL_MLA
    { const Ctx c = make_ctx(args, LAYER); mla_attn_phase<true>(c, lds); }
#endif
#ifdef DBL_CMP
    { const Ctx c = make_ctx(args, LAYER); cmp_attn_phase(c, lds); }
#endif
    { const Ctx c = make_ctx(args, LAYER); mla_attn_phase(c, lds); }
    { const Ctx c = make_ctx(args, LAYER); cmp_attn_phase(c, lds); }
    { const Ctx c = make_ctx(args, LAYER); ml::ml2_phase(c); }
    xcd_barrier(xbar);
#ifdef DBL_NSA
    { const Ctx c = make_ctx(args, LAYER); nsa_attn_phase<true>(c, lds); }
#endif
#ifdef DBL_ML3
    { const Ctx c = make_ctx(args, LAYER); ml::ml3_phase<true>(c, lds); }
#endif
    { const Ctx c = make_ctx(args, LAYER); nsa_attn_phase(c, lds); }
    { const Ctx c = make_ctx(args, LAYER); ml::ml3_phase(c, lds); }
    xcd_barrier(xbar);
#ifdef DBL_E
    run_phase<PH_E>(args, LAYER, lds_raw);
#endif
    run_phase<PH_E>(args, LAYER, lds_raw); xcd_barrier(xbar);
#ifdef DBL_F
    run_phase<PH_F>(args, LAYER, lds_raw);
#endif
    run_phase<PH_F>(args, LAYER, lds_raw); xcd_barrier(xbar);
    run_phase<PH_F2>(args, LAYER, lds_raw); xcd_barrier(xbar);
#ifdef DBL_G
    run_phase<PH_G>(args, LAYER, lds_raw);
#endif
    run_phase<PH_G>(args, LAYER, lds_raw); xcd_barrier(xbar);
#ifdef DBL_H
    run_phase<PH_H>(args, LAYER, lds_raw);
#endif
    run_phase<PH_H>(args, LAYER, lds_raw); xcd_barrier(xbar);
    run_phase<PH_H2>(args, LAYER, lds_raw);
    if (LAYER == 0) xcd_barrier(xbar);
}
__global__ void __launch_bounds__(512, 2) mega_fwd(Args args) {
    extern __shared__ __attribute__((aligned(16))) unsigned char lds_raw[];
    cg::grid_group grid = cg::this_grid();
    volatile LAS unsigned* st = (volatile LAS unsigned*)((LAS unsigned char*)lds_raw + (LDS_BYTES - 64));
    if (threadIdx.x < 2) st[threadIdx.x] = 0u;
    __syncthreads();
    const XcdBarrier xbar = xcd_barrier_post((unsigned*)args.ws, st);
    mega_layer<0>(args, lds_raw, grid, xbar);
    mega_layer<1>(args, lds_raw, grid, xbar);
}

__global__ void __launch_bounds__(256) k_compress(Args args, int layer) {
    __shared__ float hbuf[2 * 128];
    const Ctx c = make_ctx(args, layer);
    const int tid = threadIdx.x;
    for (int it = blockIdx.x; it < 2040; it += gridDim.x) {
        const int r = it * 2 + (tid >> 7), j = tid & 127;
        const int kv = r / 2040, rem = r % 2040, bg = rem / 255, n = rem % 255, b = bg >> 1, gg = bg & 1;
        const bf16* xr = c.BKV + ((size_t)(((kv * NB + b) * 2 + gg) * SEQ + 16 * n)) * 64;
        const float* w1 = c.cmp_w1 + (size_t)kv * 2048 * 128 + j; const float* ps = c.cmp_pos + kv * 2048;
        float acc = 0.f;
#pragma unroll 8
        for (int k = 0; k < 2048; ++k) acc += (bf2f(xr[k]) + ps[k]) * w1[(size_t)k * 128];
        __syncthreads();
        hbuf[(tid >> 7) * 128 + j] = siluf_(acc);
        __syncthreads();
        if (tid < 128) {
            const int rr = tid >> 6, d = tid & 63; const int r2 = it * 2 + rr;
            const int kv2 = r2 / 2040, rem2 = r2 % 2040, bg2 = rem2 / 255, n2 = rem2 % 255;
            const float* w2 = c.cmp_w2 + (size_t)kv2 * 128 * 64 + d; float o = 0.f;
#pragma unroll 8
            for (int jj = 0; jj < 128; ++jj) o += hbuf[rr * 128 + jj] * w2[jj * 64];
            c.KCMP[((size_t)((kv2 * 8 + bg2) * 256 + n2)) * 64 + d] = o;
            c.KCB[((size_t)((kv2 * 8 + bg2) * 256 + n2)) * 64 + d] = (bf16)f2bf(o);
            if (n2 == 254) c.KCB[((size_t)((kv2 * 8 + bg2) * 256 + 255)) * 64 + d] = 0;
        }
    }
}
__global__ void __launch_bounds__(256) k_mla_naive(Args args, int layer) {
    __shared__ float qsh[4][4 * 96];
    const Ctx c = make_ctx(args, layer);
    const int tid = threadIdx.x, lane = tid & 63, wave = tid >> 6;
    float* qs = qsh[wave];
    const int NGW = gridDim.x * 4, gw = blockIdx.x * 4 + wave;
    for (int task0 = gw; task0 < 32768; task0 += NGW) {
        const int bh = task0 & 31, tq0 = task0 >> 5, tq = (bh & 1) ? 1023 - tq0 : tq0;
        const int b = bh >> 3, h = bh & 7, s0 = tq * 4; const size_t t0 = (size_t)b * SEQ + s0;
        for (int e = lane; e < 4 * 96; e += 64) qs[e] = bf2f(c.QM[(t0 + e / 96) * 768 + h * 96 + (e % 96)]);
        float m[4], l[4], o[4];
#pragma unroll
        for (int r = 0; r < 4; ++r) { m[r] = -INFINITY; l[r] = 0.f; o[r] = 0.f; }
        const bf16* Kh = c.KN + (size_t)(b * 8 + h) * SEQ * 64; const bf16* Vh = c.VM + (size_t)(b * 8 + h) * SEQ * 64; const bf16* Krh = c.KR + (size_t)b * SEQ * 32;
        const int nkb = (s0 + 3) / 64 + 1;
        for (int kb = 0; kb < nkb; ++kb) {
            const int key = kb * 64 + lane; bool valid[4];
#pragma unroll
            for (int r = 0; r < 4; ++r) valid[r] = key <= s0 + r;
            nattn_block<4, true>(qs, Kh + (size_t)kb * 64 * 64, 64, Krh + (size_t)kb * 64 * 32, 32, Vh + (size_t)kb * 64 * 64, 64, valid, m, l, o, lane);
        }
#pragma unroll
        for (int r = 0; r < 4; ++r) c.QM[(t0 + r) * 768 + h * 96 + lane] = (bf16)f2bf(o[r] / l[r]);
    }
}
__global__ void __launch_bounds__(256) k_cmp_naive(Args args, int layer) {
    __shared__ float qsh[4][256 + 256];
    const Ctx c = make_ctx(args, layer);
    const int tid = threadIdx.x, lane = tid & 63, wave = tid >> 6;
    float* qs = qsh[wave]; float* psb = qs + 256;
    const int NGW = gridDim.x * 4, gw = blockIdx.x * 4 + wave;
    for (int task = gw; task < 32768; task += NGW) {
        const int bg = task >> 12, s = task & 4095, b = bg >> 1, gg = bg & 1; const size_t t = (size_t)b * SEQ + s;
        for (int e = lane; e < 256; e += 64) qs[e] = bf2f(c.BQ[t * 512 + gg * 256 + e]);
        const float* Kc = c.KCMP + (size_t)(0 * 8 + bg) * 256 * 64; const float* Vc = c.KCMP + (size_t)(1 * 8 + bg) * 256 * 64;
        float sc[4][4]; float mx[4] = {-INFINITY, -INFINITY, -INFINITY, -INFINITY};
#pragma unroll
        for (int kb = 0; kb < 4; ++kb) {
            const int n = kb * 64 + lane; const bool valid = (n < 255) && (16 * n + 31 <= s);
            const float* kr = Kc + (size_t)n * 64; float a[4] = {0.f, 0.f, 0.f, 0.f};
            for (int d0 = 0; d0 < 64; d0 += 4) {
                const f32x4 kd = *(const f32x4*)(kr + d0);
#pragma unroll
                for (int e = 0; e < 4; ++e)
#pragma unroll
                    for (int h = 0; h < 4; ++h) a[h] += qs[h * 64 + d0 + e] * kd[e];
            }
#pragma unroll
            for (int h = 0; h < 4; ++h) { sc[kb][h] = valid ? a[h] : -INFINITY; mx[h] = fmaxf(mx[h], sc[kb][h]); }
        }
        float o[4] = {0.f, 0.f, 0.f, 0.f}; float psum[4] = {0.f, 0.f, 0.f, 0.f};
#pragma unroll
        for (int h = 0; h < 4; ++h) {
            const float mh = wave_max(mx[h]);
            float e[4]; float ls = 0.f;
#pragma unroll
            for (int kb = 0; kb < 4; ++kb) { e[kb] = (mh == -INFINITY || sc[kb][h] == -INFINITY) ? 0.f : exp2f(sc[kb][h] - mh); ls += e[kb]; }
            ls = wave_sum(ls); const float inv = ls > 0.f ? 1.0f / ls : 0.f;
#pragma unroll
            for (int kb = 0; kb < 4; ++kb) { sc[kb][h] = e[kb] * inv; psum[kb] += sc[kb][h]; }
        }
#pragma unroll
        for (int kb = 0; kb < 4; ++kb) {
            for (int key = 0; key < 64; ++key) {
                const int n = kb * 64 + key; if (16 * n + 31 > s) break;
                const float vv = Vc[(size_t)n * 64 + lane];
#pragma unroll
                for (int h = 0; h < 4; ++h) o[h] += rdlane(sc[kb][h], key) * vv;
            }
        }
#pragma unroll
        for (int kb = 0; kb < 4; ++kb) psb[kb * 64 + lane] = psum[kb];
        __builtin_amdgcn_wave_barrier();
        float imp = 0.f;
#pragma unroll
        for (int q = -1; q < 4; ++q) { const int n = 4 * lane + q; if (n >= 0 && n < 255) imp += psb[n]; }
        const int cur = s >> 6;
        const bool vj = lane <= cur; const bool forced = (lane == 0) || (lane == cur) || (lane == cur - 1);
        const float score = vj ? imp + (forced ? 1e4f : 0.f) : -1.0f;
        int cnt = 0;
        for (int i2 = 0; i2 < 64; ++i2) { const float si = rdlane(score, i2); cnt += ((si > score) || (si == score && i2 < lane)) ? 1 : 0; }
        const bool selb = (cnt < 16) && (score > -0.5f);
        const unsigned long long mask = __ballot(selb);
        if (lane == 0) c.SEL[t * 2 + gg] = mask;
#pragma unroll
        for (int h = 0; h < 4; ++h) c.P1[t * 512 + (gg * 4 + h) * 64 + lane] = (bf16)f2bf(c.SM[t * 32 + 8 + (gg * 4 + h) * 3 + 0] * o[h]);
        __builtin_amdgcn_wave_barrier();
    }
}
__global__ void __launch_bounds__(256) k_selwin_naive(Args args, int layer) {
    __shared__ float qsh[4][256];
    const Ctx c = make_ctx(args, layer);
    const int tid = threadIdx.x, lane = tid & 63, wave = tid >> 6;
    float* qs = qsh[wave];
    const int NGW = gridDim.x * 4, gw = blockIdx.x * 4 + wave;
    for (int task = gw; task < 32768; task += NGW) {
        const int bg = task & 7, s = task >> 3, b = bg >> 1, gg = bg & 1; const size_t t = (size_t)b * SEQ + s;
        for (int e = lane; e < 256; e += 64) qs[e] = bf2f(c.BQ[t * 512 + gg * 256 + e]);
        const unsigned long long mk = c.SEL[t * 2 + gg];
        const unsigned mlo = __builtin_amdgcn_readfirstlane((unsigned)mk), mhi = __builtin_amdgcn_readfirstlane((unsigned)(mk >> 32));
        const bf16* Ks = c.BKV + (size_t)((2 * NB + b) * 2 + gg) * SEQ * 64; const bf16* Vs = c.BKV + (size_t)((3 * NB + b) * 2 + gg) * SEQ * 64;
        const bf16* Kw = c.BKV + (size_t)((4 * NB + b) * 2 + gg) * SEQ * 64; const bf16* Vw = c.BKV + (size_t)((5 * NB + b) * 2 + gg) * SEQ * 64;
        float m[4], l[4], o[4], osel[4];
#pragma unroll
        for (int r = 0; r < 4; ++r) { m[r] = -INFINITY; l[r] = 0.f; o[r] = 0.f; }
        for (int j = 0; j < 64; ++j) {
            const unsigned bit = j < 32 ? (mlo >> j) & 1u : (mhi >> (j - 32)) & 1u;
            if (!bit) continue;
            const bool vk = (j * 64 + lane) <= s; bool valid[4] = {vk, vk, vk, vk};
            nattn_block<4, false>(qs, Ks + (size_t)j * 64 * 64, 64, nullptr, 0, Vs + (size_t)j * 64 * 64, 64, valid, m, l, o, lane);
        }
#pragma unroll
        for (int r = 0; r < 4; ++r) { osel[r] = l[r] > 0.f ? o[r] / l[r] : 0.f; m[r] = -INFINITY; l[r] = 0.f; o[r] = 0.f; }
        const int jb0 = (s >= 511 ? s - 511 : 0) >> 6, jb1 = s >> 6;
        for (int j = jb0; j <= jb1; ++j) {
            const int key = j * 64 + lane; const bool vk = (key <= s) && (s - key < 512); bool valid[4] = {vk, vk, vk, vk};
            nattn_block<4, false>(qs, Kw + (size_t)j * 64 * 64, 64, nullptr, 0, Vw + (size_t)j * 64 * 64, 64, valid, m, l, o, lane);
        }
#pragma unroll
        for (int r = 0; r < 4; ++r) {
            const int hh = gg * 4 + r; const float ow = l[r] > 0.f ? o[r] / l[r] : 0.f;
            const float y = bf2f(c.P1[t * 512 + hh * 64 + lane]) + c.SM[t * 32 + 8 + hh * 3 + 1] * osel[r] + c.SM[t * 32 + 8 + hh * 3 + 2] * ow;
            c.BQ[t * 512 + hh * 64 + lane] = (bf16)f2bf(y);
        }
        __builtin_amdgcn_wave_barrier();
    }
}
__global__ void __launch_bounds__(128) k_mlstm_naive(Args args, int layer) {
    __shared__ float qk[128]; __shared__ float red[2];
    const Ctx c = make_ctx(args, layer);
    const int tid = threadIdx.x, lane = tid & 63, wave = tid >> 6;
    const int b = blockIdx.x >> 2, h = blockIdx.x & 3;
    float C[64], nv[64];
#pragma unroll
    for (int d = 0; d < 64; ++d) { C[d] = 0.f; nv[d] = 0.f; }
    float mstate = 0.f;
    const int ch = tid < 64 ? h * 64 + tid : 256 + h * 64 + (tid - 64);
    float cw[4];
#pragma unroll
    for (int kk = 0; kk < 4; ++kk) cw[kk] = c.m_conv[kk * 512 + ch];
    const float hn = c.m_hnorm[h * 128 + tid];
    for (int s = 0; s < SEQ; ++s) {
        const size_t t = (size_t)b * SEQ + s;
        {
            float a = 0.f;
#pragma unroll
            for (int kk = 0; kk < 4; ++kk) { const int sp = s - 3 + kk; if (sp >= 0) a += cw[kk] * bf2f(c.AQK[((size_t)b * SEQ + sp) * 512 + ch]); }
            float y = siluf_(a); if (tid < 64) y *= 0.125f;
            qk[tid] = y;
        }
        __syncthreads();
        const float li = c.SM[t * 32 + h], lf = c.SM[t * 32 + 4 + h];
        const float mn = fmaxf(lf + mstate, li); const float fp = expf(lf + mstate - mn), ip = expf(li - mn); mstate = mn;
        const float v = bf2f(c.AV[t * 512 + h * 128 + tid]); const float iv = ip * v;
        float num = 0.f, den = 0.f;
#pragma unroll
        for (int d = 0; d < 64; ++d) { const float kd = qk[64 + d], qd = qk[d]; C[d] = fp * C[d] + iv * kd; nv[d] = fp * nv[d] + ip * kd; num += C[d] * qd; den += nv[d] * qd; }
        const float hv = num / fmaxf(fabsf(den), expf(-mn));
        const float ss = wave_sum(hv * hv); if (lane == 0) red[wave] = ss;
        __syncthreads();
        const float rstd = rsqrtf((red[0] + red[1]) * (1.0f / 128.0f) + EPS);
        const float y = hv * rstd * hn * bf2f(c.AO[t * 512 + h * 128 + tid]);
        c.AV[t * 512 + h * 128 + tid] = (bf16)f2bf(y);
    }
}

extern "C" void kernel_launch(void* const* d_in, const int* in_sizes, int n_in, void* d_out, int out_size, void* d_ws, size_t ws_size, hipStream_t stream) {
    static int grid = 0;
    if (grid == 0) {
        if (n_in != 19 || out_size != T * DM || ws_size < WS_END) { fprintf(stderr, "kernel_launch: unexpected problem: n_in %d out %d ws %zu\n", n_in, out_size, ws_size); grid = -1; return; }
        int dev = 0, cus = 0;
        (void)hipGetDevice(&dev); (void)hipDeviceGetAttribute(&cus, hipDeviceAttributeMultiprocessorCount, dev);
        bool ok = true;
#define SETLDS(k) ok = ok && (hipFuncSetAttribute((const void*)k, hipFuncAttributeMaxDynamicSharedMemorySize, LDS_BYTES) == hipSuccess)
        SETLDS(k_phase<PH_P0>); SETLDS(k_phase<PH_A2>); SETLDS(k_phase<PH_B>); SETLDS(k_phase<PH_E>); SETLDS(k_phase<PH_F>); SETLDS(k_phase<PH_F2>); SETLDS(k_phase<PH_G>); SETLDS(k_phase<PH_H>); SETLDS(k_phase<PH_H2>); SETLDS(k_attn<0>); SETLDS(k_attn<1>); SETLDS(k_attn<2>); SETLDS(k_ml<0>); SETLDS(k_ml<1>); SETLDS(k_ml<2>); SETLDS(mega_fwd);
        { int per_cu = 0; (void)hipOccupancyMaxActiveBlocksPerMultiprocessor(&per_cu, (const void*)mega_fwd, 512, LDS_BYTES); (void)hipGetLastError(); if (per_cu < 1) { fprintf(stderr, "kernel_launch: occupancy query reports %d workgroups per CU\n", per_cu); grid = -1; return; } }
        if (!ok) { fprintf(stderr, "kernel_launch: hipFuncSetAttribute failed\n"); grid = -1; return; }
        grid = cus;
        if (grid != 256) { fprintf(stderr, "kernel_launch: built for 256 CUs, found %d\n", grid); grid = -1; return; }
    }
    if (grid < 0) return;
    Args a{};
    for (int i = 0; i < 19; ++i) a.in[i] = d_in[i];
    a.out = (float*)d_out; a.ws = (unsigned char*)d_ws;
#ifdef MK_MULTI
    for (int layer = 0; layer < 2; ++layer) {
        hipLaunchKernelGGL(k_phase<PH_P0>, dim3(grid), dim3(512), LDS_BYTES, stream, a, layer);
        hipLaunchKernelGGL(k_phase<PH_A2>, dim3(grid), dim3(512), LDS_BYTES, stream, a, layer);
        hipLaunchKernelGGL(k_phase<PH_B>, dim3(grid), dim3(512), LDS_BYTES, stream, a, layer);
        hipLaunchKernelGGL(k_attn<0>, dim3(grid), dim3(512), LDS_BYTES, stream, a, layer);
        hipLaunchKernelGGL(k_attn<2>, dim3(grid), dim3(512), LDS_BYTES, stream, a, layer);
        hipLaunchKernelGGL(k_attn<1>, dim3(grid), dim3(512), LDS_BYTES, stream, a, layer);
        hipLaunchKernelGGL(k_ml<0>, dim3(grid), dim3(512), LDS_BYTES, stream, a, layer);
        hipLaunchKernelGGL(k_ml<1>, dim3(grid), dim3(512), LDS_BYTES, stream, a, layer);
        hipLaunchKernelGGL(k_ml<2>, dim3(grid), dim3(512), LDS_BYTES, stream, a, layer);
        hipLaunchKernelGGL(k_phase<PH_E>, dim3(grid), dim3(512), LDS_BYTES, stream, a, layer);
        hipLaunchKernelGGL(k_phase<PH_F>, dim3(grid), dim3(512), LDS_BYTES, stream, a, layer);
        hipLaunchKernelGGL(k_phase<PH_F2>, dim3(grid), dim3(512), LDS_BYTES, stream, a, layer);
        hipLaunchKernelGGL(k_phase<PH_G>, dim3(grid), dim3(512), LDS_BYTES, stream, a, layer);
        hipLaunchKernelGGL(k_phase<PH_H>, dim3(grid), dim3(512), LDS_BYTES, stream, a, layer);
        hipLaunchKernelGGL(k_phase<PH_H2>, dim3(grid), dim3(512), LDS_BYTES, stream, a, layer);
    }
#else
    if (hipMemsetAsync(d_ws, 0, 16384, stream) != hipSuccess) { fprintf(stderr, "kernel_launch: memset of the barrier words failed\n"); return; }
    void* params[] = {&a};
    hipError_t e = hipLaunchCooperativeKernel((const void*)mega_fwd, dim3(grid), dim3(512), params, LDS_BYTES, stream);
    if (e != hipSuccess) fprintf(stderr, "kernel_launch: cooperative launch failed: %s (grid %d)\n", hipGetErrorString(e), grid);
#endif
}
```
